# Optimizing an MI355X kernel written in HIP

```python
import jax, jax.numpy as jnp
from jax import lax
import numpy as np

D_MODEL = 1024
BATCH = 4
SEQ = 8192
DEPTH = 4

N_MEM = 256
D_FF = 2816
EPS = 1e-6
GLA_HEADS = 4
GLA_DK = D_MODEL // 2 // GLA_HEADS
GLA_DV = D_MODEL // GLA_HEADS
GLA_GATE_RANK = 16
GLA_GATE_TAU = 16.0
GLA_CHUNK = 64
MLA_HEADS = 8
MLA_Q_RANK = 384
MLA_KV_RANK = 256
MLA_NOPE = 128
MLA_ROPE = 64
MLA_DV = 128
ROPE_BASE = 10000.0
Q_BLOCK = 128
MEM_HEADS = 4
MEM_DH = 128
MEM_Q_WIDTH = MEM_HEADS * MEM_DH
MIX_WIDTH = D_MODEL + MEM_Q_WIDTH
GLA_WIDTHS = (GLA_HEADS * GLA_DK, GLA_HEADS * GLA_DK, GLA_HEADS * GLA_DV,
              GLA_GATE_RANK, GLA_HEADS * GLA_DV, MEM_Q_WIDTH)
GLA_IN = sum(GLA_WIDTHS)
GLA_SPLITS = tuple(int(c) for c in np.cumsum(GLA_WIDTHS)[:-1])
MLA_WIDTHS = (MLA_Q_RANK, MLA_KV_RANK, MLA_ROPE, MEM_Q_WIDTH)
MLA_IN = sum(MLA_WIDTHS)
MLA_SPLITS = tuple(int(c) for c in np.cumsum(MLA_WIDTHS)[:-1])
N_GLA = (DEPTH + 1) // 2
N_MLA = DEPTH // 2

kernel_name = "hybrid_gla_mla_macaron_memory_trunk"


def rmsnorm(x, g):
    xf = x.astype(jnp.float32)
    y = xf * lax.rsqrt(jnp.mean(xf * xf, axis=-1, keepdims=True) + EPS)
    return (y * g.astype(jnp.float32)).astype(x.dtype)


def swiglu(h, w_gate, w_up, w_down):
    return (jax.nn.silu(h @ w_gate) * (h @ w_up)) @ w_down


def rope_tables(seq, dim):
    inv = 1.0 / (ROPE_BASE ** (jnp.arange(0, dim, 2, dtype=jnp.float32) / dim))
    ang = jnp.arange(seq, dtype=jnp.float32)[:, None] * inv[None, :]
    return jnp.cos(ang)[:, None, :], jnp.sin(ang)[:, None, :]


def apply_rope(t, cos, sin):
    t1, t2 = jnp.split(t, 2, axis=-1)
    c = cos.astype(t.dtype)
    s = sin.astype(t.dtype)
    return jnp.concatenate([t1 * c - t2 * s, t1 * s + t2 * c], axis=-1)


def gla_attention(q, k, v, log_a):
    B, S, H, DK = q.shape
    DV = v.shape[-1]
    C = GLA_CHUNK
    N = S // C
    f32 = jnp.float32

    def to_chunks(t):
        return t.reshape(B, N, C, H, t.shape[-1]).transpose(0, 1, 3, 2, 4)

    qc = to_chunks(q.astype(f32)) * (DK ** -0.5)
    kc = to_chunks(k.astype(f32))
    vc = to_chunks(v.astype(f32))
    bc = jnp.cumsum(to_chunks(log_a.astype(f32)), axis=3)
    b_last = bc[:, :, :, C - 1:C, :]
    b_ref = bc[:, :, :, C // 2 - 1:C // 2, :]

    scores = jnp.einsum('bnhid,bnhjd->bnhij', qc * jnp.exp(bc - b_ref), kc * jnp.exp(b_ref - bc))
    causal = jnp.tril(jnp.ones((C, C), dtype=bool))
    scores = jnp.where(causal, scores, 0.0)
    o_intra = jnp.einsum('bnhij,bnhjv->bnhiv', scores, vc)

    u = jnp.einsum('bnhjd,bnhjv->bnhdv', kc * jnp.exp(b_last - bc), vc)
    decay = jnp.exp(b_last[:, :, :, 0, :])

    def step(s, inp):
        d_n, u_n = inp
        return d_n[..., None] * s + u_n, s

    s0 = jnp.zeros((B, H, DK, DV), f32)
    _, s_prev = lax.scan(step, s0, (decay.transpose(1, 0, 2, 3), u.transpose(1, 0, 2, 3, 4)))
    s_prev = s_prev.transpose(1, 0, 2, 3, 4)
    o_inter = jnp.einsum('bnhid,bnhdv->bnhiv', qc * jnp.exp(bc), s_prev)
    o = (o_intra + o_inter).transpose(0, 1, 3, 2, 4).reshape(B, S, H, DV)
    return o.astype(v.dtype)


def causal_block_attention(q, k, v, scale):
    B, H, S, _ = q.shape
    nb = S // Q_BLOCK
    qb = q.reshape(B, H, nb, Q_BLOCK, q.shape[-1]).transpose(2, 0, 1, 3, 4)
    kpos = jnp.arange(S)

    def one_block(args):
        i, q_i = args
        s = jnp.einsum('bhqd,bhkd->bhqk', q_i, k).astype(jnp.float32) * scale
        qpos = i * Q_BLOCK + jnp.arange(Q_BLOCK)
        s = jnp.where(kpos[None, :] <= qpos[:, None], s, -jnp.inf)
        p = jax.nn.softmax(s, axis=-1).astype(v.dtype)
        return jnp.einsum('bhqk,bhkd->bhqd', p, v)

    o = lax.map(one_block, (jnp.arange(nb), qb))
    return o.transpose(1, 2, 0, 3, 4).reshape(B, H, S, v.shape[-1])


def mla_attention(c_q, c_kv, k_r, q_norm, kv_norm, w_uq, w_ukv,
                  qn_norm, qr_norm, kn_norm, kr_norm, cos, sin):
    B, S, _ = c_q.shape
    q = (rmsnorm(c_q, q_norm) @ w_uq).reshape(B, S, MLA_HEADS, MLA_NOPE + MLA_ROPE)
    kv = (rmsnorm(c_kv, kv_norm) @ w_ukv).reshape(B, S, MLA_HEADS, MLA_NOPE + MLA_DV)
    q_nope = rmsnorm(q[..., :MLA_NOPE], qn_norm)
    q_rope = apply_rope(rmsnorm(q[..., MLA_NOPE:], qr_norm), cos, sin)
    k_nope = rmsnorm(kv[..., :MLA_NOPE], kn_norm)
    v = kv[..., MLA_NOPE:]
    k_rope = apply_rope(rmsnorm(k_r, kr_norm)[:, :, None, :], cos, sin)
    k_rope = jnp.broadcast_to(k_rope, (B, S, MLA_HEADS, MLA_ROPE))
    qh = jnp.concatenate([q_nope, q_rope], axis=-1).transpose(0, 2, 1, 3)
    kh = jnp.concatenate([k_nope, k_rope], axis=-1).transpose(0, 2, 1, 3)
    vh = v.transpose(0, 2, 1, 3)
    o = causal_block_attention(qh, kh, vh, (MLA_NOPE + MLA_ROPE) ** -0.5)
    return o.transpose(0, 2, 1, 3).reshape(B, S, MLA_HEADS * MLA_DV)


def memory_cross_attention(q_mem, mem_h, w_kv, q_gain, k_gain):
    B, S, _ = q_mem.shape
    M = mem_h.shape[1]
    k, v = jnp.split(mem_h @ w_kv, 2, axis=-1)
    q = rmsnorm(q_mem.reshape(B, S, MEM_HEADS, MEM_DH), q_gain)
    k = rmsnorm(k.reshape(B, M, MEM_HEADS, MEM_DH), k_gain)
    v = v.reshape(B, M, MEM_HEADS, MEM_DH)
    s = jnp.einsum('bshd,bmhd->bhsm', q, k).astype(jnp.float32) * (MEM_DH ** -0.5)
    p = jax.nn.softmax(s, axis=-1).astype(v.dtype)
    return jnp.einsum('bhsm,bmhd->bshd', p, v).reshape(B, S, MEM_HEADS * MEM_DH)


def setup_inputs(seed: int = 0) -> dict:
    key = jax.random.key(seed)
    ks = iter(jax.random.split(key, 48))

    def w(shape, fan_in):
        return jax.random.normal(next(ks), shape, jnp.float32) * (fan_in ** -0.5)

    def gain(shape):
        return 1.0 + 0.02 * jax.random.normal(next(ks), shape, jnp.float32)

    def bias(shape, scale):
        return scale * jax.random.normal(next(ks), shape, jnp.float32)

    return {
        "x": jax.random.normal(next(ks), (BATCH, SEQ, D_MODEL), jnp.float32),
        "mem": jax.random.normal(next(ks), (BATCH, N_MEM, D_MODEL), jnp.float32),
        "ffn1_norm": gain((DEPTH, D_MODEL)),
        "ffn1_w_gate": w((DEPTH, D_MODEL, D_FF), D_MODEL),
        "ffn1_w_up": w((DEPTH, D_MODEL, D_FF), D_MODEL),
        "ffn1_w_down": w((DEPTH, D_FF, D_MODEL), D_FF),
        "ffn2_norm": gain((DEPTH, D_MODEL)),
        "ffn2_w_gate": w((DEPTH, D_MODEL, D_FF), D_MODEL),
        "ffn2_w_up": w((DEPTH, D_MODEL, D_FF), D_MODEL),
        "ffn2_w_down": w((DEPTH, D_FF, D_MODEL), D_FF),
        "mix_norm": gain((DEPTH, D_MODEL)),
        "w_out": w((DEPTH, MIX_WIDTH, D_MODEL), MIX_WIDTH),
        "mem_norm": gain((DEPTH, D_MODEL)),
        "mem_w_kv": w((DEPTH, D_MODEL, 2 * MEM_Q_WIDTH), D_MODEL),
        "memq_norm": gain((DEPTH, MEM_DH)),
        "memk_norm": gain((DEPTH, MEM_DH)),
        "gla_w_in": w((N_GLA, D_MODEL, GLA_IN), D_MODEL),
        "gla_w_alpha": w((N_GLA, GLA_GATE_RANK, GLA_HEADS * GLA_DK), GLA_GATE_RANK),
        "gla_b_alpha": bias((N_GLA, GLA_HEADS * GLA_DK), 0.1),
        "gla_out_norm": gain((N_GLA, GLA_DV)),
        "mla_w_in": w((N_MLA, D_MODEL, MLA_IN), D_MODEL),
        "mla_q_norm": gain((N_MLA, MLA_Q_RANK)),
        "mla_kv_norm": gain((N_MLA, MLA_KV_RANK)),
        "mla_w_uq": w((N_MLA, MLA_Q_RANK, MLA_HEADS * (MLA_NOPE + MLA_ROPE)), MLA_Q_RANK),
        "mla_w_ukv": w((N_MLA, MLA_KV_RANK, MLA_HEADS * (MLA_NOPE + MLA_DV)), MLA_KV_RANK),
        "mla_qn_norm": gain((N_MLA, MLA_NOPE)),
        "mla_qr_norm": gain((N_MLA, MLA_ROPE)),
        "mla_kn_norm": gain((N_MLA, MLA_NOPE)),
        "mla_kr_norm": gain((N_MLA, MLA_ROPE)),
    }


def reference(x, mem, ffn1_norm, ffn1_w_gate, ffn1_w_up, ffn1_w_down,
              ffn2_norm, ffn2_w_gate, ffn2_w_up, ffn2_w_down,
              mix_norm, w_out, mem_norm, mem_w_kv, memq_norm, memk_norm,
              gla_w_in, gla_w_alpha, gla_b_alpha, gla_out_norm,
              mla_w_in, mla_q_norm, mla_kv_norm, mla_w_uq, mla_w_ukv,
              mla_qn_norm, mla_qr_norm, mla_kn_norm, mla_kr_norm):
    B, S, _ = x.shape
    cos, sin = rope_tables(S, MLA_ROPE)
    for i in range(DEPTH):
        x = x + 0.5 * swiglu(rmsnorm(x, ffn1_norm[i]), ffn1_w_gate[i], ffn1_w_up[i], ffn1_w_down[i])
        h = rmsnorm(x, mix_norm[i])
        j = i // 2
        if i % 2 == 0:
            q, k, v, a_low, r, q_mem = jnp.split(h @ gla_w_in[j], GLA_SPLITS, axis=-1)
            log_a = jax.nn.log_sigmoid(a_low @ gla_w_alpha[j] + gla_b_alpha[j]) / GLA_GATE_TAU
            o = gla_attention(q.reshape(B, S, GLA_HEADS, GLA_DK),
                              k.reshape(B, S, GLA_HEADS, GLA_DK),
                              v.reshape(B, S, GLA_HEADS, GLA_DV),
                              log_a.reshape(B, S, GLA_HEADS, GLA_DK))
            o = rmsnorm(o, gla_out_norm[j]).reshape(B, S, GLA_HEADS * GLA_DV) * jax.nn.silu(r)
        else:
            c_q, c_kv, k_r, q_mem = jnp.split(h @ mla_w_in[j], MLA_SPLITS, axis=-1)
            o = mla_attention(c_q, c_kv, k_r, mla_q_norm[j], mla_kv_norm[j], mla_w_uq[j], mla_w_ukv[j],
                              mla_qn_norm[j], mla_qr_norm[j], mla_kn_norm[j], mla_kr_norm[j], cos, sin)
        o_mem = memory_cross_attention(q_mem, rmsnorm(mem, mem_norm[i]), mem_w_kv[i],
                                       memq_norm[i], memk_norm[i])
        x = x + jnp.concatenate([o, o_mem], axis=-1) @ w_out[i]
        x = x + 0.5 * swiglu(rmsnorm(x, ffn2_norm[i]), ffn2_w_gate[i], ffn2_w_up[i], ffn2_w_down[i])
    return x
```

```cpp
#define FAST_GLA 1
#define FAST_MLA_PREP 1
#define FAST_MLA_ATT 1
#include <hip/hip_runtime.h>
#include <cstdio>
#include <cstdint>

typedef unsigned short bf16;
typedef short bf16x8 __attribute__((ext_vector_type(8)));
typedef float f32x4 __attribute__((ext_vector_type(4)));

constexpr int BATCH = 4, SEQ = 8192, DM = 1024, DEPTH = 4, NMEM = 256, FF = 2816;
constexpr int M = BATCH * SEQ;
constexpr float EPS = 1e-6f;
constexpr int GLA_IN = 3600, MLA_IN = 1216;
constexpr int PG = 3584;
constexpr int PG_Q = 0, PG_K = 512, PG_R = 1024, PG_V = 2048, PG_QM = 3072;
constexpr int PM = 1280;
constexpr int PM_CQ = 0, PM_CKV = 384, PM_KR = 640, PM_QM = 704;
constexpr int QW = 1536, KVW = 2048, OCW = 1536;

constexpr size_t MiB = 1u << 20;
constexpr size_t WS_CTL = 0;
constexpr size_t WS_ROPE = 28 * MiB;
constexpr size_t WS_MEMKV = 3 * MiB;
constexpr size_t WS_MEMH = 11 * MiB;
constexpr size_t WS_ALOW = 19 * MiB;
constexpr size_t WS_GV = 21 * MiB;
constexpr size_t WS_KR = 24 * MiB;
constexpr size_t WS_WB = 32 * MiB;
constexpr size_t WS_XN = 84 * MiB;
constexpr size_t WS_BIG = 148 * MiB;
constexpr size_t WS_H = WS_BIG;
constexpr size_t WS_PG = WS_BIG;
constexpr size_t WS_US = 372 * MiB;
constexpr size_t WS_PM = 180 * MiB;
constexpr size_t WS_Q = 260 * MiB;
constexpr size_t WS_KV = 356 * MiB;
constexpr size_t WS_END = 500 * MiB;

__device__ __forceinline__ float bf2f(bf16 b) { return __uint_as_float(((unsigned)b) << 16); }
__device__ __forceinline__ bf16 f2bf(float f) { unsigned u = __float_as_uint(f); return (bf16)((u + 0x7fffu + ((u >> 16) & 1u)) >> 16); }
__device__ __forceinline__ float wave_sum(float v) {
#pragma unroll
    for (int o = 1; o < 64; o <<= 1) v += __shfl_xor(v, o);
    return v;
}
__device__ __forceinline__ float silu_f(float x) { return x / (1.f + __expf(-x)); }

struct ColMap { int t0, a0, t1, a1, t2, a2, a3, nvalid; };
__device__ __forceinline__ int cm_src(const ColMap& c, int n) { return n + (n < c.t0 ? c.a0 : n < c.t1 ? c.a1 : n < c.t2 ? c.a2 : c.a3); }
static ColMap cm_identity(int nvalid) { ColMap c; c.t0 = 1 << 30; c.a0 = 0; c.t1 = 1 << 30; c.a1 = 0; c.t2 = 1 << 30; c.a2 = 0; c.a3 = 0; c.nvalid = nvalid; return c; }

template <int EPI>
__global__ __launch_bounds__(256) void nv_gemm(const bf16* __restrict__ A, int lda, const float* __restrict__ W, const float* __restrict__ W2, int ldw, ColMap cm,
                                               int K, void* Cv, int ldc, float scale, int nstore) {
    __shared__ __attribute__((aligned(16))) bf16 sA[64][40];
    __shared__ __attribute__((aligned(16))) bf16 sB[64][40];
    __shared__ __attribute__((aligned(16))) bf16 sB2[64][40];
    const int tid = threadIdx.x, lane = tid & 63, wid = tid >> 6;
    const int m0 = blockIdx.y * 64, n0 = blockIdx.x * 64;
    const int wm = (wid >> 1) * 32, wn = (wid & 1) * 32;
    f32x4 acc[2][2], acc2[2][2];
#pragma unroll
    for (int i = 0; i < 2; ++i)
#pragma unroll
        for (int j = 0; j < 2; ++j) { acc[i][j] = (f32x4){0.f, 0.f, 0.f, 0.f}; acc2[i][j] = (f32x4){0.f, 0.f, 0.f, 0.f}; }
    const int ar = tid >> 2, ac = (tid & 3) * 8;
    const int bk = tid >> 3, bn = (tid & 7) * 8;
    const int ncol = n0 + bn; const bool nval = ncol < cm.nvalid; const int src = cm_src(cm, ncol);
    for (int k0 = 0; k0 < K; k0 += 32) {
        const bf16x8 av = *(const bf16x8*)(A + (size_t)(m0 + ar) * lda + k0 + ac);
        f32x4 w0 = (f32x4){0.f, 0.f, 0.f, 0.f}, w1 = w0, u0 = w0, u1 = w0;
        if (nval) { const float* wp = W + (size_t)(k0 + bk) * ldw + src; w0 = *(const f32x4*)wp; w1 = *(const f32x4*)(wp + 4);
            if (EPI == 1) { const float* up = W2 + (size_t)(k0 + bk) * ldw + src; u0 = *(const f32x4*)up; u1 = *(const f32x4*)(up + 4); } }
        *(bf16x8*)&sA[ar][ac] = av;
#pragma unroll
        for (int j = 0; j < 4; ++j) { sB[bn + j][bk] = f2bf(w0[j]); sB[bn + 4 + j][bk] = f2bf(w1[j]); }
        if (EPI == 1) {
#pragma unroll
            for (int j = 0; j < 4; ++j) { sB2[bn + j][bk] = f2bf(u0[j]); sB2[bn + 4 + j][bk] = f2bf(u1[j]); } }
        __syncthreads();
        bf16x8 a[2], b[2], b2[2];
#pragma unroll
        for (int i = 0; i < 2; ++i) { a[i] = *(const bf16x8*)&sA[wm + i * 16 + (lane & 15)][(lane >> 4) * 8]; b[i] = *(const bf16x8*)&sB[wn + i * 16 + (lane & 15)][(lane >> 4) * 8];
            if (EPI == 1) b2[i] = *(const bf16x8*)&sB2[wn + i * 16 + (lane & 15)][(lane >> 4) * 8]; }
#pragma unroll
        for (int i = 0; i < 2; ++i)
#pragma unroll
            for (int j = 0; j < 2; ++j) { acc[i][j] = __builtin_amdgcn_mfma_f32_16x16x32_bf16(a[i], b[j], acc[i][j], 0, 0, 0);
                if (EPI == 1) acc2[i][j] = __builtin_amdgcn_mfma_f32_16x16x32_bf16(a[i], b2[j], acc2[i][j], 0, 0, 0); }
        __syncthreads();
    }
#pragma unroll
    for (int i = 0; i < 2; ++i)
#pragma unroll
        for (int j = 0; j < 2; ++j)
#pragma unroll
            for (int r = 0; r < 4; ++r) {
                const int row = m0 + wm + i * 16 + (lane >> 4) * 4 + r, col = n0 + wn + j * 16 + (lane & 15);
                const float v = acc[i][j][r];
                if (EPI == 0) ((bf16*)Cv)[(size_t)row * ldc + col] = f2bf(v);
                if (EPI == 1) ((bf16*)Cv)[(size_t)row * ldc + col] = f2bf(silu_f(v) * acc2[i][j][r]);
                if (EPI == 2) { float* p = (float*)Cv + (size_t)row * ldc + col; *p = *p + scale * v; }
                if (EPI == 3) { if (col < nstore) ((float*)Cv)[(size_t)row * ldc + col] = v; }
            }
}

__global__ __launch_bounds__(256) void nv_rmsnorm(const float* __restrict__ X, const float* __restrict__ g, bf16* __restrict__ out, int rows) {
    const int lane = threadIdx.x & 63, row = blockIdx.x * 4 + (threadIdx.x >> 6);
    if (row >= rows) return;
    const f32x4* xr = (const f32x4*)(X + (size_t)row * DM) + lane; f32x4 v[4]; float s = 0.f;
#pragma unroll
    for (int j = 0; j < 4; ++j) { v[j] = xr[64 * j]; s += v[j].x * v[j].x + v[j].y * v[j].y + v[j].z * v[j].z + v[j].w * v[j].w; }
    const float rstd = 1.0f / sqrtf(wave_sum(s) * (1.f / DM) + EPS);
#pragma unroll
    for (int j = 0; j < 4; ++j) { const f32x4 gg = ((const f32x4*)g)[lane + 64 * j]; bf16* o = out + (size_t)row * DM + (lane + 64 * j) * 4;
        o[0] = f2bf(v[j].x * rstd * gg.x); o[1] = f2bf(v[j].y * rstd * gg.y); o[2] = f2bf(v[j].z * rstd * gg.z); o[3] = f2bf(v[j].w * rstd * gg.w); }
}

__global__ void nv_rope_table(float* cs) {
    const int i = blockIdx.x * blockDim.x + threadIdx.x; if (i >= SEQ * 32) return;
    const int pos = i >> 5, f = i & 31;
    const float ex = (float)(2 * f) / 64.0f;
    const float inv = (float)(1.0 / pow(10000.0, (double)ex));
    const float ang = (float)pos * inv;
    cs[i] = (float)cos((double)ang); cs[SEQ * 32 + i] = (float)sin((double)ang);
}

__global__ __launch_bounds__(256) void nv_headnorm128(bf16* __restrict__ buf, int ld, int col0, int hstride, int nheads, const float* __restrict__ g, int rows) {
    const int lane = threadIdx.x & 63, idx = blockIdx.x * 4 + (threadIdx.x >> 6);
    if (idx >= rows * nheads) return;
    const int row = idx / nheads, h = idx % nheads;
    bf16* p = buf + (size_t)row * ld + col0 + h * hstride + lane * 2;
    const float a = bf2f(p[0]), b = bf2f(p[1]);
    const float rstd = 1.0f / sqrtf(wave_sum(a * a + b * b) * (1.f / 128.f) + EPS);
    p[0] = f2bf(a * rstd * g[lane * 2]); p[1] = f2bf(b * rstd * g[lane * 2 + 1]);
}

__global__ __launch_bounds__(256) void nv_mla_rowprep(bf16* __restrict__ P, const float* __restrict__ gq, const float* __restrict__ gkv, const float* __restrict__ gkr,
                                                      const float* __restrict__ rope, bf16* __restrict__ KR) {
    const int lane = threadIdx.x & 63, row = blockIdx.x * 4 + (threadIdx.x >> 6);
    bf16* p = P + (size_t)row * PM;
    float q[6]; float s = 0.f;
#pragma unroll
    for (int j = 0; j < 6; ++j) { q[j] = bf2f(p[PM_CQ + lane + 64 * j]); s += q[j] * q[j]; }
    float rstd = 1.0f / sqrtf(wave_sum(s) * (1.f / 384.f) + EPS);
#pragma unroll
    for (int j = 0; j < 6; ++j) p[PM_CQ + lane + 64 * j] = f2bf(q[j] * rstd * gq[lane + 64 * j]);
    float c[4]; s = 0.f;
#pragma unroll
    for (int j = 0; j < 4; ++j) { c[j] = bf2f(p[PM_CKV + lane + 64 * j]); s += c[j] * c[j]; }
    rstd = 1.0f / sqrtf(wave_sum(s) * (1.f / 256.f) + EPS);
#pragma unroll
    for (int j = 0; j < 4; ++j) p[PM_CKV + lane + 64 * j] = f2bf(c[j] * rstd * gkv[lane + 64 * j]);
    float k = bf2f(p[PM_KR + lane]);
    rstd = 1.0f / sqrtf(wave_sum(k * k) * (1.f / 64.f) + EPS);
    k = k * rstd * gkr[lane];
    const float other = __shfl_xor(k, 32);
    const int pos = row % SEQ, f = lane & 31;
    const float cs = rope[pos * 32 + f], sn = rope[SEQ * 32 + pos * 32 + f];
    const float o = lane < 32 ? (k * cs - other * sn) : (other * sn + k * cs);
    KR[(size_t)row * 64 + lane] = f2bf(o);
}

__global__ __launch_bounds__(256) void nv_mla_headprep(bf16* __restrict__ Q, bf16* __restrict__ KV, const float* __restrict__ gqn, const float* __restrict__ gqr, const float* __restrict__ gkn,
                                                       const float* __restrict__ rope) {
    const int lane = threadIdx.x & 63, idx = blockIdx.x * 4 + (threadIdx.x >> 6);
    const int row = idx >> 3, h = idx & 7;
    bf16* q = Q + (size_t)row * QW + h * 192;
    { const float a = bf2f(q[lane * 2]), b = bf2f(q[lane * 2 + 1]);
      const float rstd = 1.0f / sqrtf(wave_sum(a * a + b * b) * (1.f / 128.f) + EPS);
      q[lane * 2] = f2bf(a * rstd * gqn[lane * 2]); q[lane * 2 + 1] = f2bf(b * rstd * gqn[lane * 2 + 1]); }
    { float k = bf2f(q[128 + lane]);
      const float rstd = 1.0f / sqrtf(wave_sum(k * k) * (1.f / 64.f) + EPS);
      k = k * rstd * gqr[lane];
      const float other = __shfl_xor(k, 32);
      const int pos = row % SEQ, f = lane & 31;
      const float cs = rope[pos * 32 + f], sn = rope[SEQ * 32 + pos * 32 + f];
      q[128 + lane] = f2bf(lane < 32 ? (k * cs - other * sn) : (other * sn + k * cs)); }
    bf16* kk = KV + (size_t)row * KVW + h * 256;
    { const float a = bf2f(kk[lane * 2]), b = bf2f(kk[lane * 2 + 1]);
      const float rstd = 1.0f / sqrtf(wave_sum(a * a + b * b) * (1.f / 128.f) + EPS);
      kk[lane * 2] = f2bf(a * rstd * gkn[lane * 2]); kk[lane * 2 + 1] = f2bf(b * rstd * gkn[lane * 2 + 1]); }
}

template <int DQK, bool CAUSAL>
__global__ __launch_bounds__(64) void nv_attn(const bf16* __restrict__ Q, int ldq, int qhs, const bf16* __restrict__ Kn, int ldkn, int knhs, const bf16* __restrict__ Kr, int ldkr,
                                              const bf16* __restrict__ V, int ldv, int vhs, bf16* __restrict__ O, int ldo, int ohs, int nheads, int sq, int skv, float scale, const float* __restrict__ qgain) {
    __shared__ float sQ[64][DQK + 1];
    const int lane = threadIdx.x;
    const int qb = blockIdx.x, h = blockIdx.y, b = blockIdx.z;
    const int q0 = qb * 64;
    const size_t qrow = (size_t)b * sq + q0 + lane;
    { const bf16* qp = Q + qrow * ldq + h * qhs; float s = 0.f;
      for (int d = 0; d < DQK; ++d) { const float v = bf2f(qp[d]); sQ[lane][d] = v; s += v * v; }
      if (qgain) { const float rstd = 1.0f / sqrtf(s * (1.f / DQK) + EPS); for (int d = 0; d < DQK; ++d) sQ[lane][d] = sQ[lane][d] * rstd * qgain[d]; } }
    float acc[128];
#pragma unroll
    for (int d = 0; d < 128; ++d) acc[d] = 0.f;
    float mx = -1e30f, l = 0.f;
    const int jend = CAUSAL ? (q0 + 64) : skv;
    for (int j = 0; j < jend; ++j) {
        const size_t krow = (size_t)b * skv + j;
        const bf16* kn = Kn + krow * ldkn + h * knhs;
        float s = 0.f;
#pragma unroll 8
        for (int d = 0; d < 128; ++d) s += sQ[lane][d] * bf2f(kn[d]);
        if (DQK > 128) { const bf16* kr = Kr + krow * ldkr;
#pragma unroll 8
            for (int d = 0; d < DQK - 128; ++d) s += sQ[lane][128 + d] * bf2f(kr[d]); }
        s *= scale;
        const bool ok = !CAUSAL || (j <= q0 + lane);
        if (ok) {
            const float mn = fmaxf(mx, s), al = __expf(mx - mn), p = __expf(s - mn);
            l = l * al + p; mx = mn;
            const bf16* vp = V + krow * ldv + h * vhs;
#pragma unroll
            for (int d = 0; d < 128; ++d) acc[d] = acc[d] * al + p * bf2f(vp[d]);
        }
    }
    const float inv = 1.0f / l;
    bf16* op = O + qrow * ldo + h * ohs;
#pragma unroll
    for (int d = 0; d < 128; ++d) op[d] = f2bf(acc[d] * inv);
}

__global__ __launch_bounds__(256) void nv_gla_alpha(const float* __restrict__ alow, const float* __restrict__ wa, const float* __restrict__ ba, float* __restrict__ alpha) {
    const size_t i = (size_t)blockIdx.x * 256 + threadIdx.x; const int m = (int)(i >> 9), c = (int)(i & 511);
    float z = ba[c];
#pragma unroll
    for (int r = 0; r < 16; ++r) z += alow[(size_t)m * 16 + r] * wa[r * 512 + c];
    const float ls = fminf(z, 0.f) - log1pf(expf(-fabsf(z)));
    alpha[i] = expf(ls * (1.f / 16.f));
}
__global__ __launch_bounds__(256) void nv_gla_rec(bf16* __restrict__ P, const float* __restrict__ alpha, const float* __restrict__ gout) {
    __shared__ float red[2][4];
    const int dv = threadIdx.x, h = blockIdx.x & 3, b = blockIdx.x >> 2, lane = dv & 63, wv = dv >> 6;
    float S[128];
#pragma unroll
    for (int d = 0; d < 128; ++d) S[d] = 0.f;
    const float g = gout[dv];
    const float scale = 0.08838834764831845f;
    for (int t = 0; t < SEQ; ++t) {
        const size_t row = (size_t)b * SEQ + t;
        bf16* p = P + row * PG;
        const bf16* q = p + PG_Q + h * 128; const bf16* k = p + PG_K + h * 128; const float* al = alpha + row * 512 + h * 128;
        const float v = bf2f(p[PG_V + h * 256 + dv]);
        float o = 0.f;
#pragma unroll
        for (int d = 0; d < 128; ++d) { S[d] = al[d] * S[d] + bf2f(k[d]) * v; o += bf2f(q[d]) * S[d]; }
        o *= scale;
        float ss = wave_sum(o * o);
        if (lane == 0) red[t & 1][wv] = ss;
        __syncthreads();
        ss = red[t & 1][0] + red[t & 1][1] + red[t & 1][2] + red[t & 1][3];
        const float rstd = 1.0f / sqrtf(ss * (1.f / 256.f) + EPS);
        const float r = bf2f(p[PG_R + h * 256 + dv]);
        p[PG_V + h * 256 + dv] = f2bf(o * rstd * g * silu_f(r));
    }
}

#define LAS __attribute__((address_space(3)))
#define GAS __attribute__((address_space(1)))
typedef unsigned u32x4 __attribute__((ext_vector_type(4)));
typedef unsigned u32x2 __attribute__((ext_vector_type(2)));
typedef float f32x2 __attribute__((ext_vector_type(2)));
typedef GAS unsigned gu32;
#define RLX_AGENT __ATOMIC_RELAXED, __HIP_MEMORY_SCOPE_AGENT
#define LDS_WAIT() asm volatile("s_waitcnt lgkmcnt(0)" ::: "memory")
#define VM_WAIT() asm volatile("s_waitcnt vmcnt(0)" ::: "memory")
__device__ __forceinline__ unsigned cvt_pk_bf16(float lo, float hi) { unsigned r; asm volatile("v_cvt_pk_bf16_f32 %0, %1, %2" : "=v"(r) : "v"(lo), "v"(hi)); return r; }
__device__ __forceinline__ float fast_silu(float x) { return x * __builtin_amdgcn_rcpf(1.0f + __builtin_amdgcn_exp2f(-1.4426950408889634f * x)); }

namespace pg8 {
constexpr int BM = 256, BK = 64, HALF = 128, HTB = HALF * BK * 2  , STAGE_BYTES = 8 * HTB, NXCD = 8, WGM = 8;
__host__ __device__ __forceinline__ int lds_byte(int r, int c) { const int st = (r >> 4) * 2 + (c >> 5), rr = r & 15, cc = c & 31, ob = rr * 64 + cc * 2; return st * 1024 + (ob ^ (((ob >> 9) & 1) << 5)); }
__host__ __device__ __forceinline__ void stage_rc(int b, int& R, int& C) { const int st = b / 1024, sb = b % 1024, swz = sb ^ (((sb >> 9) & 1) << 5); R = (st >> 1) * 16 + swz / 64; C = (st & 1) * 32 + (swz % 64) / 2; }
__host__ __device__ __forceinline__ int perm32(int rho) { const int n = rho >> 4, i = rho & 15; return 8 * (i >> 2) + 4 * n + (i & 3); }

struct Unit { int pm, pn; };
struct Gemm { const bf16* A; const bf16* Bt; int M, N, K, lda, ldb; };

struct StaticOrder {
    int nM, nN, nwg, G, c, rev;
    __device__ void init(int M_, int N_, int G_, int c_, int rev_ = 0) { nM = M_ / BM; nN = N_ / BM; nwg = nM * nN; G = G_; c = c_; rev = rev_; }
    __device__ bool next(int i, Unit& u) const {
        const int R = (nwg - c + G - 1) / G;
        if (i >= R) return false;
        const long L = (long)(rev ? R - 1 - i : i) * G + c;
        int wgid = (int)L; { const int q = nwg / NXCD, r = nwg % NXCD, xcd = wgid % NXCD, off = wgid / NXCD; wgid = (xcd < r ? xcd * (q + 1) : r * (q + 1) + (xcd - r) * q) + off; }
        const int nig = WGM * nN, gid = wgid / nig, fm = gid * WGM, gsz = (nM - fm) < WGM ? (nM - fm) : WGM;
        u.pm = fm + ((wgid % nig) % gsz); u.pn = (wgid % nig) / gsz; return true;
    }
};
struct DiagOrder {
    int G, c, nb;
    __device__ bool next(int i, Unit& u) const { const int L = i * G + c; if (L >= nb * 16) return false; const int blk = L >> 4, r = L & 15; u.pm = blk * 4 + (r >> 2); u.pn = blk * 4 + (r & 3); return true; }
};

__device__ __forceinline__ float rstd_of(float ss) { return __builtin_amdgcn_rsqf(ss * (1.f / 1024.f) + EPS); }
#ifndef RS_DIRECT
#define RS_DIRECT 0
#endif
#if RS_DIRECT
#define TABV(idx) ({ const f32x4 t_ = *(const f32x4*)(rsg + (idx) * 4); (t_.x + t_.y) + (t_.z + t_.w); })
#else
#define TABV(idx) ({ const f32x4 t_ = *(const LAS f32x4*)(tab + (idx) * 4); (t_.x + t_.y) + (t_.z + t_.w); })
#endif
template <bool RS> struct EpiBf16 {
    static constexpr bool PERM = true, USE_RS = RS;
    bf16* O; int ldc; int pn_mask;
    __device__ __forceinline__ void operator()(const f32x4 (&acc)[2][2][4][2], const Unit& u, int wr, int wc, int fr, int fq, const LAS float* tab, const float* rsg) const {
        const int row0 = u.pm * BM + wr * 64 + fr, col0 = (u.pn & pn_mask) * BM + wc * 32 + 8 * fq;
#pragma unroll
        for (int ai = 0; ai < 2; ++ai)
#pragma unroll
            for (int m = 0; m < 4; ++m) { bf16* rowp = O + (size_t)(row0 + ai * HALF + m * 16) * ldc + col0;
                const float rs = RS ? rstd_of(TABV(ai * HALF + wr * 64 + m * 16 + fr)) : 1.f;
#pragma unroll
                for (int bj = 0; bj < 2; ++bj) { const f32x4 v0 = acc[ai][bj][m][0] * rs, v1 = acc[ai][bj][m][1] * rs;
                    u32x4 w; w.x = cvt_pk_bf16(v0[0], v0[1]); w.y = cvt_pk_bf16(v0[2], v0[3]); w.z = cvt_pk_bf16(v1[0], v1[1]); w.w = cvt_pk_bf16(v1[2], v1[3]);
                    *(u32x4*)(rowp + bj * HALF) = w; } }
    }
};
struct EpiGlaIn {
    static constexpr bool PERM = true, USE_RS = true;
    bf16* O; float* alow;
    __device__ __forceinline__ void operator()(const f32x4 (&acc)[2][2][4][2], const Unit& u, int wr, int wc, int fr, int fq, const LAS float* tab, const float* rsg) const {
        const int row0 = u.pm * BM + wr * 64 + fr;
        if (u.pn == 14) {
            if (wc == 0 && fq < 2) {
#pragma unroll
                for (int ai = 0; ai < 2; ++ai)
#pragma unroll
                    for (int m = 0; m < 4; ++m) { const float rs = rstd_of(TABV(ai * HALF + wr * 64 + m * 16 + fr)); float* ap = alow + (size_t)(row0 + ai * HALF + m * 16) * 16 + 8 * fq;
                        *(f32x4*)ap = acc[ai][0][m][0] * rs; *(f32x4*)(ap + 4) = acc[ai][0][m][1] * rs; } }
            return;
        }
        const int col0 = u.pn * BM + wc * 32 + 8 * fq;
#pragma unroll
        for (int ai = 0; ai < 2; ++ai)
#pragma unroll
            for (int m = 0; m < 4; ++m) { bf16* rowp = O + (size_t)(row0 + ai * HALF + m * 16) * PG + col0;
                const float rs = rstd_of(TABV(ai * HALF + wr * 64 + m * 16 + fr));
#pragma unroll
                for (int bj = 0; bj < 2; ++bj) { const f32x4 v0 = acc[ai][bj][m][0] * rs, v1 = acc[ai][bj][m][1] * rs;
                    u32x4 w; w.x = cvt_pk_bf16(v0[0], v0[1]); w.y = cvt_pk_bf16(v0[2], v0[3]); w.z = cvt_pk_bf16(v1[0], v1[1]); w.w = cvt_pk_bf16(v1[2], v1[3]);
                    *(u32x4*)(rowp + bj * HALF) = w; } }
    }
};
struct EpiSwiGLU {
    static constexpr bool PERM = true, USE_RS = true;
    bf16* O; int ldc;
    __device__ __forceinline__ void operator()(const f32x4 (&acc)[2][2][4][2], const Unit& u, int wr, int wc, int fr, int fq, const LAS float* tab, const float* rsg) const {
        const int row0 = u.pm * BM + wr * 64 + fr, col0 = u.pn * HALF + wc * 32 + 8 * fq;
        float ss[2][4];
#pragma unroll
        for (int ai = 0; ai < 2; ++ai)
#pragma unroll
            for (int m = 0; m < 4; ++m) ss[ai][m] = TABV(ai * HALF + wr * 64 + m * 16 + fr);
#pragma unroll
        for (int ai = 0; ai < 2; ++ai)
#pragma unroll
            for (int m = 0; m < 4; ++m) { bf16* rowp = O + (size_t)(row0 + ai * HALF + m * 16) * ldc + col0;
                const float v = ss[ai][m] * (1.f / 1024.f) + EPS, c = -1.4426950408889634f * __builtin_amdgcn_rsqf(v);
                float h[8];
#pragma unroll
                for (int n = 0; n < 2; ++n)
#pragma unroll
                    for (int j = 0; j < 4; ++j) { const float g = acc[ai][0][m][n][j], up = acc[ai][1][m][n][j];
                        h[n * 4 + j] = (g * up) * __builtin_amdgcn_rcpf(__builtin_fmaf(__builtin_amdgcn_exp2f(g * c), v, v)); }
                u32x4 w; w.x = cvt_pk_bf16(h[0], h[1]); w.y = cvt_pk_bf16(h[2], h[3]); w.z = cvt_pk_bf16(h[4], h[5]); w.w = cvt_pk_bf16(h[6], h[7]);
                *(u32x4*)rowp = w; }
    }
};
struct EpiKV {
    static constexpr bool PERM = true, USE_RS = false;
    bf16* O; int ldc; const float* gkn; LAS float* part;
    __device__ __forceinline__ void operator()(const f32x4 (&acc)[2][2][4][2], const Unit& u, int wr, int wc, int fr, int fq, const LAS float*, const float*) const {
        const int row0 = u.pm * BM + wr * 64 + fr, col0 = u.pn * BM + wc * 32 + 8 * fq;
#pragma unroll
        for (int ai = 0; ai < 2; ++ai)
#pragma unroll
            for (int m = 0; m < 4; ++m) { const f32x4 a = acc[ai][0][m][0], b = acc[ai][0][m][1];
                float ss = ((a[0] * a[0] + a[1] * a[1]) + (a[2] * a[2] + a[3] * a[3])) + ((b[0] * b[0] + b[1] * b[1]) + (b[2] * b[2] + b[3] * b[3]));
                ss += __shfl_xor(ss, 16); ss += __shfl_xor(ss, 32);
                if (fq == 0) part[(ai * HALF + wr * 64 + m * 16 + fr) * 4 + wc] = ss; }
        asm volatile("s_waitcnt lgkmcnt(0)" ::: "memory"); __builtin_amdgcn_s_barrier(); asm volatile("" ::: "memory");
        const f32x4 g0 = *(const f32x4*)(gkn + wc * 32 + 8 * fq), g1 = *(const f32x4*)(gkn + wc * 32 + 8 * fq + 4);
#pragma unroll
        for (int ai = 0; ai < 2; ++ai)
#pragma unroll
            for (int m = 0; m < 4; ++m) { bf16* rowp = O + (size_t)(row0 + ai * HALF + m * 16) * ldc + col0;
                const f32x4 pp = *(const LAS f32x4*)(part + (ai * HALF + wr * 64 + m * 16 + fr) * 4);
                const float rs = __builtin_amdgcn_rsqf(((pp.x + pp.y) + (pp.z + pp.w)) * (1.f / 128.f) + EPS);
                { const f32x4 v0 = acc[ai][0][m][0] * rs * g0, v1 = acc[ai][0][m][1] * rs * g1;
                  u32x4 w; w.x = cvt_pk_bf16(v0[0], v0[1]); w.y = cvt_pk_bf16(v0[2], v0[3]); w.z = cvt_pk_bf16(v1[0], v1[1]); w.w = cvt_pk_bf16(v1[2], v1[3]); *(u32x4*)rowp = w; }
                { const f32x4 v0 = acc[ai][1][m][0], v1 = acc[ai][1][m][1];
                  u32x4 w; w.x = cvt_pk_bf16(v0[0], v0[1]); w.y = cvt_pk_bf16(v0[2], v0[3]); w.z = cvt_pk_bf16(v1[0], v1[1]); w.w = cvt_pk_bf16(v1[2], v1[3]); *(u32x4*)(rowp + HALF) = w; } }
    }
};
struct EpiResid {
    static constexpr bool PERM = true, USE_RS = false;
    bf16* XB; float* OUT; float* RS4; LAS float* part; int ldc; float scale;
    __device__ __forceinline__ void operator()(const f32x4 (&acc)[2][2][4][2], const Unit& u, int wr, int wc, int fr, int fq, const LAS float*, const float*) const {
        const int row0 = u.pm * BM + wr * 64 + fr, col0 = u.pn * BM + wc * 32 + 8 * fq;
#pragma unroll
        for (int ai = 0; ai < 2; ++ai) {
            const size_t off = (size_t)(row0 + ai * HALF) * ldc + col0;
            u32x4 xv[4][2];
#pragma unroll
            for (int m = 0; m < 4; ++m)
#pragma unroll
                for (int bj = 0; bj < 2; ++bj) xv[m][bj] = *(const u32x4*)(XB + off + (size_t)(m * 16) * ldc + bj * HALF);
#pragma unroll
            for (int m = 0; m < 4; ++m) { float ss = 0.f;
#pragma unroll
                for (int bj = 0; bj < 2; ++bj) { const u32x4 w = xv[m][bj]; const size_t o2 = off + (size_t)(m * 16) * ldc + bj * HALF;
                    f32x4 n0, n1;
                    n0[0] = __uint_as_float(w.x << 16) + acc[ai][bj][m][0][0] * scale; n0[1] = __uint_as_float(w.x & 0xffff0000u) + acc[ai][bj][m][0][1] * scale;
                    n0[2] = __uint_as_float(w.y << 16) + acc[ai][bj][m][0][2] * scale; n0[3] = __uint_as_float(w.y & 0xffff0000u) + acc[ai][bj][m][0][3] * scale;
                    n1[0] = __uint_as_float(w.z << 16) + acc[ai][bj][m][1][0] * scale; n1[1] = __uint_as_float(w.z & 0xffff0000u) + acc[ai][bj][m][1][1] * scale;
                    n1[2] = __uint_as_float(w.w << 16) + acc[ai][bj][m][1][2] * scale; n1[3] = __uint_as_float(w.w & 0xffff0000u) + acc[ai][bj][m][1][3] * scale;
                    if (OUT) { *(f32x4*)(OUT + o2) = n0; *(f32x4*)(OUT + o2 + 4) = n1; }
                    else { u32x4 o; o.x = cvt_pk_bf16(n0[0], n0[1]); o.y = cvt_pk_bf16(n0[2], n0[3]); o.z = cvt_pk_bf16(n1[0], n1[1]); o.w = cvt_pk_bf16(n1[2], n1[3]); *(u32x4*)(XB + o2) = o;
                        ss += ((n0[0] * n0[0] + n0[1] * n0[1]) + (n0[2] * n0[2] + n0[3] * n0[3])) + ((n1[0] * n1[0] + n1[1] * n1[1]) + (n1[2] * n1[2] + n1[3] * n1[3])); } }
                if (!OUT) { ss += __shfl_xor(ss, 16); ss += __shfl_xor(ss, 32); if (fq == 0) part[(ai * HALF + wr * 64 + m * 16 + fr) * 4 + wc] = ss; } }
            asm volatile("" ::: "memory"); }
        if (!OUT) {
            asm volatile("s_waitcnt lgkmcnt(0)" ::: "memory"); __builtin_amdgcn_s_barrier(); asm volatile("" ::: "memory");
            const int t = (wr * 4 + wc) * 64 + fq * 16 + fr;
            if (t < 256) { const f32x4 pp = *(const LAS f32x4*)(part + t * 4); RS4[((size_t)u.pm * BM + t) * 4 + u.pn] = (pp.x + pp.y) + (pp.z + pp.w); }
        }
    }
};

template <class Epi, class Sched, bool ALIGN_EPI = false, bool SP2 = false>
__device__ __forceinline__ void gemm_phase(LAS unsigned char* lds, const Gemm g, const Sched& S, const Epi& E, const float* rs = nullptr, LAS unsigned char* rstab = nullptr, const bool skip_epi = false) {
    int tid_ = threadIdx.x; asm volatile("" : "+v"(tid_));
    const int tid = tid_, wid = __builtin_amdgcn_readfirstlane(tid >> 6), lane = tid & 63, wr = wid >> 2, wc = wid & 3, fr = lane & 15, fq = lane >> 4;
    const int K = g.K, nt = K / BK, lda = g.lda, ldb = g.ldb;
    unsigned voffA[2], voffB[2];
#pragma unroll
    for (int i = 0; i < 2; ++i) { int R, C; stage_rc(tid * 16 + i * 8192, R, C); const int Rb = Epi::PERM ? ((R & ~31) + perm32(R & 31)) : R;
        voffA[i] = (unsigned)(R * lda + C) * 2u; voffB[i] = (unsigned)(Rb * ldb + C) * 2u; }
    const size_t kstep = (size_t)(BK * 2);
    const size_t hstepA = (size_t)HALF * lda * 2, hstepB = (size_t)HALF * ldb * 2;
    const size_t tstepA = 2 * hstepA, tstepB = 2 * hstepB;
    const unsigned ldsw = (unsigned)wid * 1024u;
    const int aoff = lds_byte(wr * 64 + fr, fq * 8), boff = lds_byte(wc * 32 + fr, fq * 8);
#define PG8_SA(b, h) (((b) * 2 + (h)) * HTB)
#define PG8_SB(b, h) ((4 + (b) * 2 + (h)) * HTB)
#define PG8_STAGE(bufoff, gbase, voff) do { _Pragma("unroll") for (int _i = 0; _i < 2; ++_i) \
        __builtin_amdgcn_global_load_lds((const unsigned*)((const char*)(gbase) + (voff)[_i]), (LAS unsigned*)(lds + (bufoff) + ldsw + _i * 8192), 16, 0, 0); } while (0)
#define PG8_LDA(dst, b, h) do { _Pragma("unroll") for (int m = 0; m < 4; ++m) _Pragma("unroll") for (int k = 0; k < 2; ++k) dst[m][k] = *(const LAS bf16x8*)(lds + PG8_SA(b, h) + aoff + m * 2048 + k * 1024); } while (0)
#define PG8_LDB(dst, b, h) do { _Pragma("unroll") for (int n = 0; n < 2; ++n) _Pragma("unroll") for (int k = 0; k < 2; ++k) dst[n][k] = *(const LAS bf16x8*)(lds + PG8_SB(b, h) + boff + n * 2048 + k * 1024); } while (0)
#define PG8_MMA(ai, bj, At, Bt) do { __builtin_amdgcn_s_setprio(1); _Pragma("unroll") for (int m = 0; m < 4; ++m) _Pragma("unroll") for (int n = 0; n < 2; ++n) _Pragma("unroll") for (int k = 0; k < 2; ++k) \
        acc[ai][bj][m][n] = __builtin_amdgcn_mfma_f32_16x16x32_bf16(Bt[n][k], At[m][k], acc[ai][bj][m][n], 0, 0, 0); __builtin_amdgcn_s_setprio(0); } while (0)
#define PG8_WAIT_V(n) asm volatile("s_waitcnt vmcnt(" #n ")" ::: "memory")
#define PG8_WAIT_L(n) asm volatile("s_waitcnt lgkmcnt(" #n ")" ::: "memory")
#define PG8_BAR __builtin_amdgcn_s_barrier()
#define PG8_SCHED __builtin_amdgcn_sched_barrier(0)
    Unit cur, nxt; int ui = 0;
    if (!S.next(0, cur)) return;
    f32x4 acc[2][2][4][2];
#pragma unroll
    for (int a = 0; a < 2; ++a)
#pragma unroll
        for (int b = 0; b < 2; ++b)
#pragma unroll
            for (int m = 0; m < 4; ++m)
#pragma unroll
                for (int n = 0; n < 2; ++n) acc[a][b][m][n] = (f32x4){0.f, 0.f, 0.f, 0.f};
    bf16x8 At[4][2], B0[2][2], B1[2][2];
    const char* cA = (const char*)g.A + (size_t)cur.pm * tstepA; const char* cB = (const char*)g.Bt + (size_t)cur.pn * tstepB;
#define PG8_RSDMA(unit, par) do { if (Epi::USE_RS && wid < 4) __builtin_amdgcn_global_load_lds((const unsigned*)(rs + ((size_t)(unit).pm * BM + wid * 64 + lane) * 4), (LAS unsigned*)(rstab + (par) * 4096 + wid * 1024), 16, 0, 0); } while (0)
    PG8_RSDMA(cur, 0);
    if constexpr (SP2) {
        PG8_STAGE(PG8_SB(0, 0), cB, voffB); PG8_STAGE(PG8_SB(0, 1), cB + hstepB, voffB); PG8_STAGE(PG8_SA(0, 0), cA, voffA); PG8_STAGE(PG8_SA(0, 1), cA + hstepA, voffA);
        if (wr == 1) PG8_BAR;
        PG8_WAIT_V(2); PG8_BAR;
        PG8_STAGE(PG8_SB(1, 0), cB + kstep, voffB); PG8_STAGE(PG8_SA(1, 0), cA + kstep, voffA); PG8_STAGE(PG8_SB(1, 1), cB + hstepB + kstep, voffB);
        PG8_WAIT_V(6); PG8_BAR;
    } else {
        PG8_STAGE(PG8_SB(0, 0), cB, voffB); PG8_STAGE(PG8_SA(0, 0), cA, voffA); PG8_STAGE(PG8_SB(0, 1), cB + hstepB, voffB); PG8_STAGE(PG8_SA(0, 1), cA + hstepA, voffA);
        if (wr == 1) PG8_BAR;
        PG8_WAIT_V(4); PG8_BAR;
        PG8_STAGE(PG8_SB(1, 0), cB + kstep, voffB); PG8_STAGE(PG8_SA(1, 0), cA + kstep, voffA); PG8_STAGE(PG8_SB(1, 1), cB + hstepB + kstep, voffB);
        PG8_WAIT_V(6); PG8_BAR;
    }
    for (;;) {
        const bool has_next = S.next(ui + 1, nxt);
        const char* nA = has_next ? (const char*)g.A + (size_t)nxt.pm * tstepA : cA; const char* nB = has_next ? (const char*)g.Bt + (size_t)nxt.pn * tstepB : cB;
        for (int t = 0; t < nt; t += 2) {
            const bool last = (t == nt - 2);
            const char* a1 = cA + (size_t)(t + 1) * kstep;
            const char* a2 = last ? nA : cA + (size_t)(t + 2) * kstep; const char* b2 = last ? nB : cB + (size_t)(t + 2) * kstep;
            const char* a3 = a2 + kstep; const char* b3 = b2 + kstep;
            if (last && has_next) PG8_RSDMA(nxt, (ui + 1) & 1);
            if constexpr (SP2) {
            PG8_LDB(B0, 0, 0); PG8_LDB(B1, 0, 1); PG8_SCHED; PG8_LDA(At, 0, 0); PG8_STAGE(PG8_SA(1, 1), a1 + hstepA, voffA);
            PG8_WAIT_V(8); PG8_WAIT_L(0); PG8_BAR; PG8_MMA(0, 0, At, B0); PG8_MMA(0, 1, At, B1); PG8_BAR; PG8_SCHED;
            PG8_LDA(At, 0, 1); PG8_STAGE(PG8_SB(0, 0), b2, voffB); PG8_STAGE(PG8_SB(0, 1), b2 + hstepB, voffB); PG8_STAGE(PG8_SA(0, 0), a2, voffA);
            PG8_WAIT_V(8); PG8_WAIT_L(0); PG8_BAR; PG8_MMA(1, 0, At, B0); PG8_MMA(1, 1, At, B1); PG8_BAR; PG8_SCHED;
            PG8_LDB(B0, 1, 0); PG8_LDB(B1, 1, 1); PG8_SCHED; PG8_LDA(At, 1, 0); PG8_STAGE(PG8_SA(0, 1), a2 + hstepA, voffA);
            PG8_WAIT_V(8); PG8_WAIT_L(0); PG8_BAR; PG8_MMA(0, 0, At, B0); PG8_MMA(0, 1, At, B1); PG8_BAR; PG8_SCHED;
            PG8_LDA(At, 1, 1); PG8_STAGE(PG8_SB(1, 0), b3, voffB); PG8_STAGE(PG8_SB(1, 1), b3 + hstepB, voffB); PG8_STAGE(PG8_SA(1, 0), a3, voffA);
            PG8_WAIT_V(8); PG8_WAIT_L(0); PG8_BAR; PG8_MMA(1, 0, At, B0); PG8_MMA(1, 1, At, B1); PG8_BAR; PG8_SCHED;
            } else {
            PG8_LDB(B0, 0, 0); PG8_SCHED; PG8_LDA(At, 0, 0); PG8_STAGE(PG8_SA(1, 1), a1 + hstepA, voffA);
            PG8_WAIT_L(8); PG8_BAR; PG8_WAIT_L(0); PG8_MMA(0, 0, At, B0); PG8_BAR; PG8_SCHED;
            PG8_LDB(B1, 0, 1); PG8_STAGE(PG8_SB(0, 0), b2, voffB);
            PG8_BAR; PG8_WAIT_L(0); PG8_MMA(0, 1, At, B1); PG8_BAR;
            PG8_LDA(At, 0, 1); PG8_STAGE(PG8_SA(0, 0), a2, voffA);
            PG8_BAR; PG8_WAIT_L(0); PG8_MMA(1, 0, At, B0); PG8_BAR; PG8_SCHED;
            PG8_STAGE(PG8_SB(0, 1), b2 + hstepB, voffB);
            PG8_WAIT_V(6); PG8_BAR; PG8_MMA(1, 1, At, B1); PG8_BAR;
            PG8_LDB(B0, 1, 0); PG8_SCHED; PG8_LDA(At, 1, 0); PG8_STAGE(PG8_SA(0, 1), a2 + hstepA, voffA);
            PG8_WAIT_L(8); PG8_BAR; PG8_WAIT_L(0); PG8_MMA(0, 0, At, B0); PG8_BAR; PG8_SCHED;
            PG8_LDB(B1, 1, 1); PG8_STAGE(PG8_SB(1, 0), b3, voffB);
            PG8_BAR; PG8_WAIT_L(0); PG8_MMA(0, 1, At, B1); PG8_BAR;
            PG8_LDA(At, 1, 1); PG8_STAGE(PG8_SA(1, 0), a3, voffA);
            PG8_BAR; PG8_WAIT_L(0); PG8_MMA(1, 0, At, B0); PG8_BAR; PG8_SCHED;
            PG8_STAGE(PG8_SB(1, 1), b3 + hstepB, voffB);
            PG8_WAIT_V(6); PG8_BAR; PG8_MMA(1, 1, At, B1); PG8_BAR;
            }
        }
        if constexpr (ALIGN_EPI) { if (wr == 0) PG8_BAR; }
        if (!skip_epi) E(acc, cur, wr, wc, fr, fq, (const LAS float*)(rstab + (ui & 1) * 4096), rs + (size_t)cur.pm * BM * 4);
        if (!has_next) break;
#pragma unroll
        for (int a = 0; a < 2; ++a)
#pragma unroll
            for (int b = 0; b < 2; ++b)
#pragma unroll
                for (int m = 0; m < 4; ++m)
#pragma unroll
                    for (int n = 0; n < 2; ++n) acc[a][b][m][n] = (f32x4){0.f, 0.f, 0.f, 0.f};
        cur = nxt; cA = nA; cB = nB; ++ui;
        if constexpr (ALIGN_EPI) { if (wr == 1) PG8_BAR; }
    }
    PG8_WAIT_V(0);
    if constexpr (!ALIGN_EPI) { if (wr == 0) PG8_BAR; }
    PG8_BAR;
#undef PG8_RSDMA
#undef PG8_SA
#undef PG8_SB
#undef PG8_STAGE
#undef PG8_LDA
#undef PG8_LDB
#undef PG8_MMA
#undef PG8_WAIT_V
#undef PG8_WAIT_L
#undef PG8_BAR
#undef PG8_SCHED
}
}
#ifndef PG8_SP2
#define PG8_SP2 true
#endif
#ifndef PG8_ALIGN
#define PG8_ALIGN true
#endif

#define XB_TMO      128
#define XB_XCNT(j)  (256  + 64 * (j))
#define XB_XSUB(j)  (1280 + 64 * (j))
#define XB_XGEN(j)  (2304 + 64 * (j))
#define XB_TOP      3328
#define XB_TOPGEN   3392
#define XCD_BAR_WORDS 3456
#define XB_SPIN_CAP (1u << 18)
__device__ __forceinline__ unsigned xb_ld(unsigned* p)              { return __hip_atomic_load(p, __ATOMIC_RELAXED, __HIP_MEMORY_SCOPE_AGENT); }
__device__ __forceinline__ unsigned xb_add(unsigned* p, unsigned v) { return __hip_atomic_fetch_add(p, v, __ATOMIC_RELAXED, __HIP_MEMORY_SCOPE_AGENT); }
__device__ __forceinline__ unsigned xb_xcc_id() { return (unsigned)__builtin_amdgcn_s_getreg((3 << 11) | 20) & 0xFu; }
#define XB_SPIN(cond, bar) do { unsigned _sp = 0; while (cond) { __builtin_amdgcn_s_sleep(1); \
    if ((++_sp & 255u) == 0u) { if (xb_ld(&(bar)[XB_TMO])) break; if (_sp > XB_SPIN_CAP) { atomicAdd(&(bar)[XB_TMO], 1u); break; } } } } while (0)
struct XcdBarrier { unsigned* bar; unsigned x; volatile LAS unsigned* st; };
__device__ __forceinline__ XcdBarrier xcd_barrier_post(unsigned* bar, volatile LAS unsigned* st) {
    XcdBarrier b; b.bar = bar; b.x = xb_xcc_id(); b.st = st;
    if (threadIdx.x == 0) (void)xb_add(&bar[XB_XCNT(b.x)], 1u);
    return b;
}
__device__ __forceinline__ void xcd_barrier_complete(unsigned* bar, unsigned x, unsigned& nloc, unsigned& nx) {
    const unsigned G = gridDim.x * gridDim.y * gridDim.z;
    unsigned sum, cnt, mine, sp = 0u;
    for (;;) {
        sum = 0u; cnt = 0u; mine = 0u;
#pragma unroll
        for (unsigned j = 0; j < 16; ++j) { const unsigned c = xb_ld(&bar[XB_XCNT(j)]); sum += c; cnt += (c > 0u) ? 1u : 0u; mine = (j == x) ? c : mine; }
        if (sum == G) break;
        __builtin_amdgcn_s_sleep(1);
        if ((++sp & 255u) == 0u) { if (xb_ld(&bar[XB_TMO])) break; if (sp > XB_SPIN_CAP) { atomicAdd(&bar[XB_TMO], 1u); break; } }
    }
    nloc = mine > 0u ? mine : 1u; nx = cnt > 0u ? cnt : 1u;
}
__device__ __forceinline__ void xcd_barrier(const XcdBarrier& b) {
    asm volatile("s_waitcnt vmcnt(0)" ::: "memory");
    __syncthreads();
    if (threadIdx.x == 0) {
        unsigned* bar = b.bar;
        __builtin_amdgcn_s_waitcnt(0);
        unsigned nloc = b.st[0], nx = b.st[1];
        if (nloc == 0u) { xcd_barrier_complete(bar, b.x, nloc, nx); b.st[0] = nloc; b.st[1] = nx; }
        const unsigned old = xb_add(&bar[XB_XSUB(b.x)], 1u);
        const unsigned gen = old / nloc;
        if (old + 1u == (gen + 1u) * nloc) {
            __builtin_amdgcn_fence(__ATOMIC_RELEASE, "agent");
            asm volatile("s_waitcnt vmcnt(0)" ::: "memory");
            const unsigned og = xb_add(&bar[XB_TOP], 1u);
            const unsigned tg = og / nx;
            if (og + 1u == (tg + 1u) * nx) xb_add(&bar[XB_TOPGEN], 1u);
            else XB_SPIN(xb_ld(&bar[XB_TOPGEN]) == tg, bar);
            __builtin_amdgcn_fence(__ATOMIC_ACQUIRE, "agent");
            xb_add(&bar[XB_XGEN(b.x)], 1u);
            asm volatile("s_waitcnt vmcnt(0)" ::: "memory");
        } else {
            XB_SPIN(xb_ld(&bar[XB_XGEN(b.x)]) == gen, bar);
            __builtin_amdgcn_fence(__ATOMIC_ACQUIRE, "agent");
            asm volatile("s_waitcnt vmcnt(0)" ::: "memory");
        }
    }
    __syncthreads();
}
namespace att {
typedef float f32x16 __attribute__((ext_vector_type(16)));
typedef short s16x4 __attribute__((ext_vector_type(4)));
constexpr int SHM_V = 16384, SHM_KN = 16384, SHM_KR = 8192;
constexpr int NKS = 3, NVS = 4;
constexpr int L_KN = 0, L_KR = L_KN + NKS * SHM_KN, L_V = L_KR + NKS * SHM_KR, L_WS = L_V + NVS * SHM_V, L_END = L_WS + 8 * 64 * 4;
static_assert(L_END <= 160 * 1024 - 1024, "attention LDS map");
constexpr float THR = 8.f;
#define KSWZ(row, chunk) ((row) * 256 + ((((chunk) ^ (row)) & 15) << 4))
#define KRSWZ(row, chunk) ((row) * 128 + ((((chunk) ^ ((row) >> 1)) & 7) << 4))
#define SBAR() __builtin_amdgcn_sched_barrier(0)
__device__ __forceinline__ int v_st(int k, int c) { const int kk = (k & ~0xC) | ((k & 4) << 1) | ((k & 8) >> 1); return ((kk >> 3) * 4 + (c >> 5)) * 512 + ((kk & 7) * 32 + (c & 31)) * 2; }
__device__ __forceinline__ int v_rd_base(int lane) { return ((lane & 3) << 3) | (((lane >> 2) & 3) << 6) | (((lane >> 4) & 1) << 5) | (((lane >> 5) & 1) << 8); }
constexpr int v_rd_off(int d0, int ks, int half) { return d0 * 512 + ks * 4096 + half * 2048; }
__device__ __forceinline__ int crow(int r, int hi) { return (r & 3) + 8 * (r >> 2) + 4 * hi; }
__device__ __forceinline__ bf16x8 pack8(f32x4 a, f32x4 b) { u32x4 w = {cvt_pk_bf16(a[0], a[1]), cvt_pk_bf16(a[2], a[3]), cvt_pk_bf16(b[0], b[1]), cvt_pk_bf16(b[2], b[3])}; return __builtin_bit_cast(bf16x8, w); }
__device__ __forceinline__ void mask_tile(f32x16& p0, f32x16& p1, int dq) {
    const float NEG = -__builtin_inff();
#pragma unroll
    for (int r = 0; r < 16; ++r) { const int c = (r & 3) + 8 * (r >> 2); if (dq - c < 0) p0[r] = NEG; if (dq - c - 32 < 0) p1[r] = NEG; }
}
__device__ __forceinline__ void partialSM(f32x16& p0, f32x16& p1, float& m_reg, float& mn, float& alpha, const float SCALE) {
    float pmax = p0[0];
#pragma unroll
    for (int r = 1; r < 16; ++r) pmax = fmaxf(pmax, p0[r]);
#pragma unroll
    for (int r = 0; r < 16; ++r) pmax = fmaxf(pmax, p1[r]);
    { auto rr = __builtin_amdgcn_permlane32_swap(__float_as_uint(pmax), __float_as_uint(pmax), false, false);
      pmax = fmaxf(__uint_as_float(rr[0]), __uint_as_float(rr[1])); }
    const float C2 = 1.4426950408889634f * SCALE;
    if (__builtin_expect(__all((pmax - m_reg) * SCALE <= THR), 1)) { mn = m_reg; alpha = 1.f; }
    else { mn = fmaxf(m_reg, pmax); alpha = __builtin_amdgcn_exp2f((m_reg - mn) * C2); m_reg = mn; }
    const float mnL = -mn * C2;
#pragma unroll
    for (int r = 0; r < 16; ++r) p0[r] = fmaf(p0[r], C2, mnL);
#pragma unroll
    for (int r = 0; r < 16; ++r) p1[r] = fmaf(p1[r], C2, mnL);
#pragma unroll
    for (int r = 0; r < 16; ++r) p0[r] = __builtin_amdgcn_exp2f(p0[r]);
}
__device__ __forceinline__ void finishSM(f32x16& p0, f32x16& p1, float alpha, float& l_reg, bf16x8& pa0, bf16x8& pa1, bf16x8& pa2, bf16x8& pa3) {
#pragma unroll
    for (int r = 0; r < 16; ++r) p1[r] = __builtin_amdgcn_exp2f(p1[r]);
    float ps = 0;
#pragma unroll
    for (int r = 0; r < 16; ++r) ps += p0[r];
#pragma unroll
    for (int r = 0; r < 16; ++r) ps += p1[r];
    { auto rr = __builtin_amdgcn_permlane32_swap(__float_as_uint(ps), __float_as_uint(ps), false, false);
      ps = __uint_as_float(rr[0]) + __uint_as_float(rr[1]); }
    l_reg = l_reg * alpha + ps;
#define PK4(P, B_, OUT) do { unsigned a0 = cvt_pk_bf16(P[B_+0], P[B_+1]), a1 = cvt_pk_bf16(P[B_+2], P[B_+3]);                          \
        unsigned b0 = cvt_pk_bf16(P[B_+4], P[B_+5]), b1 = cvt_pk_bf16(P[B_+6], P[B_+7]);                                             \
        auto r0 = __builtin_amdgcn_permlane32_swap(a0, b0, false, false); auto r1 = __builtin_amdgcn_permlane32_swap(a1, b1, false, false); \
        u32x4 w = {r0[0], r1[0], r0[1], r1[1]}; OUT = __builtin_bit_cast(bf16x8, w); } while (0)
    PK4(p0, 0, pa0); PK4(p0, 8, pa1); PK4(p1, 0, pa2); PK4(p1, 8, pa3);
#undef PK4
}
__device__ __forceinline__ void staticSM(f32x16& p0, f32x16& p1, float& l_reg, bf16x8& pa0, bf16x8& pa1, bf16x8& pa2, bf16x8& pa3) {
#pragma unroll
    for (int r = 0; r < 16; ++r) p0[r] = __builtin_amdgcn_exp2f(p0[r]);
#pragma unroll
    for (int r = 0; r < 16; ++r) p1[r] = __builtin_amdgcn_exp2f(p1[r]);
    float ps = 0;
#pragma unroll
    for (int r = 0; r < 16; ++r) ps += p0[r];
#pragma unroll
    for (int r = 0; r < 16; ++r) ps += p1[r];
    { auto rr = __builtin_amdgcn_permlane32_swap(__float_as_uint(ps), __float_as_uint(ps), false, false);
      ps = __uint_as_float(rr[0]) + __uint_as_float(rr[1]); }
    l_reg += ps;
#define PK4(P, B_, OUT) do { unsigned a0 = cvt_pk_bf16(P[B_+0], P[B_+1]), a1 = cvt_pk_bf16(P[B_+2], P[B_+3]);                          \
        unsigned b0 = cvt_pk_bf16(P[B_+4], P[B_+5]), b1 = cvt_pk_bf16(P[B_+6], P[B_+7]);                                             \
        auto r0 = __builtin_amdgcn_permlane32_swap(a0, b0, false, false); auto r1 = __builtin_amdgcn_permlane32_swap(a1, b1, false, false); \
        u32x4 w = {r0[0], r1[0], r0[1], r1[1]}; OUT = __builtin_bit_cast(bf16x8, w); } while (0)
    PK4(p0, 0, pa0); PK4(p0, 8, pa1); PK4(p1, 0, pa2); PK4(p1, 8, pa3);
#undef PK4
}
template <int NR>
__device__ __forceinline__ void qkt(f32x16& p0, f32x16& p1, const int (&kaddr)[8], const int (&raddr)[4], const bf16x8* qr, const float init) {
#pragma unroll
    for (int r = 0; r < 16; ++r) { p0[r] = init; p1[r] = init; }
    bf16x8 a0, a1, a2, a3, b0, b1, b2, b3;
#define KRD(dst, addr, off) asm volatile("ds_read_b128 %0, %1 offset:%2" : "=&v"(dst) : "v"(addr), "i"(off) : "memory")
#define KLD(d, x0, x1) do { if ((d) < 8) { KRD(x0, kaddr[(d) & 7], 0); KRD(x1, kaddr[(d) & 7], 8192); } else { KRD(x0, raddr[((d) - 8) & 3], 0); KRD(x1, raddr[((d) - 8) & 3], 4096); } } while (0)
#define KWAIT(n) do { asm volatile("s_waitcnt lgkmcnt(" #n ")" : "+v"(a0), "+v"(a1), "+v"(a2), "+v"(a3), "+v"(b0), "+v"(b1), "+v"(b2), "+v"(b3) :: "memory"); SBAR(); } while (0)
#define KMMA(d, x0, x1) do { p0 = __builtin_amdgcn_mfma_f32_32x32x16_bf16(x0, qr[d], p0, 0, 0, 0); p1 = __builtin_amdgcn_mfma_f32_32x32x16_bf16(x1, qr[d], p1, 0, 0, 0); } while (0)
    constexpr int NS = 8 + NR;
    KLD(0, a0, a1); KLD(1, a2, a3); KLD(2, b0, b1); KLD(3, b2, b3);
    KWAIT(4); KMMA(0, a0, a1); KMMA(1, a2, a3); KLD(4, a0, a1); KLD(5, a2, a3);
    KWAIT(4); KMMA(2, b0, b1); KMMA(3, b2, b3); KLD(6, b0, b1); KLD(7, b2, b3);
    if constexpr (NS > 8) {
        KWAIT(4); KMMA(4, a0, a1); KMMA(5, a2, a3); KLD(8, a0, a1); KLD(9, a2, a3);
        KWAIT(4); KMMA(6, b0, b1); KMMA(7, b2, b3); KLD(10, b0, b1); KLD(11, b2, b3);
        KWAIT(4); KMMA(8, a0, a1); KMMA(9, a2, a3);
        KWAIT(0); KMMA(10, b0, b1); KMMA(11, b2, b3);
    } else {
        KWAIT(4); KMMA(4, a0, a1); KMMA(5, a2, a3);
        KWAIT(0); KMMA(6, b0, b1); KMMA(7, b2, b3);
    }
#undef KMMA
#undef KWAIT
#undef KLD
#undef KRD
}
__device__ __forceinline__ void pv_tile(f32x16* o, int vb0  , bf16x8 pa0, bf16x8 pa1, bf16x8 pa2, bf16x8 pa3) {
#define TRRD(dst, off) asm volatile("ds_read_b64_tr_b16 %0, %1 offset:%2" : "=&v"(dst) : "v"(vb0), "i"(off) : "memory")
#define PV_LOAD(L, H, ks) do { constexpr int b_ = (ks) * 4096; \
        TRRD(L[0], b_); TRRD(H[0], b_ + 2048); TRRD(L[1], b_ + 512); TRRD(H[1], b_ + 512 + 2048); TRRD(L[2], b_ + 1024); TRRD(H[2], b_ + 1024 + 2048); TRRD(L[3], b_ + 1536); TRRD(H[3], b_ + 1536 + 2048); } while (0)
#define PV_WAIT(n) do { asm volatile("s_waitcnt lgkmcnt(" #n ")" : "+v"(la[0]), "+v"(ha[0]), "+v"(la[1]), "+v"(ha[1]), "+v"(la[2]), "+v"(ha[2]), "+v"(la[3]), "+v"(ha[3]), "+v"(lb[0]), "+v"(hb[0]), "+v"(lb[1]), "+v"(hb[1]), "+v"(lb[2]), "+v"(hb[2]), "+v"(lb[3]), "+v"(hb[3]) :: "memory"); SBAR(); } while (0)
#define PV_MMA(pa, L, H) do { _Pragma("unroll") for (int d0 = 0; d0 < 4; ++d0) \
        o[d0] = __builtin_amdgcn_mfma_f32_32x32x16_bf16(pa, (bf16x8){L[d0][0], L[d0][1], L[d0][2], L[d0][3], H[d0][0], H[d0][1], H[d0][2], H[d0][3]}, o[d0], 0, 0, 0); } while (0)
    s16x4 la[4], ha[4], lb[4], hb[4];
    PV_LOAD(la, ha, 0); PV_LOAD(lb, hb, 1);
    PV_WAIT(8); PV_MMA(pa0, la, ha);
    PV_LOAD(la, ha, 2);
    PV_WAIT(8); PV_MMA(pa1, lb, hb);
    PV_LOAD(lb, hb, 3);
    PV_WAIT(8); PV_MMA(pa2, la, ha);
    PV_WAIT(0); PV_MMA(pa3, lb, hb);
#undef PV_MMA
#undef PV_WAIT
#undef PV_LOAD
#undef TRRD
}

template <int NR, bool CAUSAL, int QMODE>
__device__ __forceinline__ void attn_block(LAS char* lds, const bf16* Q, int ldq, const bf16* Kn, int ldk, const bf16* Kr, const bf16* V, int ldv, bf16* O, int ldo,
                                           int NT, int P0, const float SCALE, const float BND  , const float* qgain, const float* qgain2, const float* rope, const bool dry = false) {
    int tid_ = threadIdx.x; asm volatile("" : "+v"(tid_));
    const int tid = tid_, wid = __builtin_amdgcn_readfirstlane(tid >> 6), lane = tid & 63, r32 = lane & 31, hi = lane >> 5;
#ifndef ATT_STAGGER
#define ATT_STAGGER 1
#endif
    const bool late = ATT_STAGGER && wid >= 4;
#ifndef ABL
#define ABL 0
#endif
#ifndef ATT_PRIO
#define ATT_PRIO 1
#endif
    const int abl = dry ? ABL : 0;
    constexpr int NOPS = 4 + (NR > 0 ? 1 : 0);
    int so_k[2], so_v[2], so_r = 0;
#pragma unroll
    for (int i = 0; i < 2; ++i) {
        const int p = 2 * wid + i;
        { const int row = 4 * p + (lane >> 4), c = (lane ^ row) & 15; so_k[i] = row * ldk + c * 8; }
        { const int st = 2 * p + (lane >> 5), kk = (st >> 2) * 8 + ((lane & 31) >> 2), key = (kk & ~0xC) | ((kk & 4) << 1) | ((kk & 8) >> 1), col = (st & 3) * 32 + (lane & 3) * 8; so_v[i] = key * ldv + col; }
    }
    if constexpr (NR > 0) { const int row = 8 * wid + (lane >> 3), c = ((lane & 7) ^ (row >> 1)) & 7; so_r = row * 64 + c * 8; }
#define DMA16(gp, loff) __builtin_amdgcn_global_load_lds((const unsigned*)(gp), (LAS unsigned*)(lds + (loff)), 16, 0, 0)
#define ISSUE(tile, ks_, vs_) do { const int k0_ = (tile) * 64; \
        DMA16(Kn + (size_t)k0_ * ldk + so_k[0], L_KN + (ks_) * SHM_KN + (2 * wid) * 1024); DMA16(Kn + (size_t)k0_ * ldk + so_k[1], L_KN + (ks_) * SHM_KN + (2 * wid + 1) * 1024); \
        if constexpr (NR > 0) DMA16(Kr + (size_t)k0_ * 64 + so_r, L_KR + (ks_) * SHM_KR + wid * 1024); \
        DMA16(V + (size_t)k0_ * ldv + so_v[0], L_V + (vs_) * SHM_V + (2 * wid) * 1024); DMA16(V + (size_t)k0_ * ldv + so_v[1], L_V + (vs_) * SHM_V + (2 * wid + 1) * 1024); } while (0)
    ISSUE(0, 0, 0); ISSUE(1, 1, 1);
    bf16x8 qr[8 + NR];
#pragma unroll
    for (int d0 = 0; d0 < 8 + NR; ++d0) qr[d0] = *(const bf16x8*)(Q + (size_t)(wid * 32 + r32) * ldq + d0 * 16 + hi * 8);
    if constexpr (QMODE >= 1) {
        float ss = 0.f;
#pragma unroll
        for (int d0 = 0; d0 < 8; ++d0)
#pragma unroll
            for (int e = 0; e < 8; ++e) { const float v = bf2f((bf16)qr[d0][e]); ss += v * v; }
        { auto rr = __builtin_amdgcn_permlane32_swap(__float_as_uint(ss), __float_as_uint(ss), false, false); ss = __uint_as_float(rr[0]) + __uint_as_float(rr[1]); }
        const float rstdc = (1.0f / sqrtf(ss * (1.f / 128.f) + EPS)) * (1.4426950408889634f * SCALE);
#pragma unroll
        for (int d0 = 0; d0 < 8; ++d0) { const f32x4 g0 = *(const f32x4*)(qgain + d0 * 16 + hi * 8), g1 = *(const f32x4*)(qgain + d0 * 16 + hi * 8 + 4); f32x4 a, b;
#pragma unroll
            for (int e = 0; e < 4; ++e) { a[e] = bf2f((bf16)qr[d0][e]) * rstdc * g0[e]; b[e] = bf2f((bf16)qr[d0][4 + e]) * rstdc * g1[e]; }
            qr[d0] = pack8(a, b); }
    }
    if constexpr (QMODE == 2 && NR == 4) {
        float ss = 0.f;
#pragma unroll
        for (int d0 = 8; d0 < 12; ++d0)
#pragma unroll
            for (int e = 0; e < 8; ++e) { const float v = bf2f((bf16)qr[d0][e]); ss += v * v; }
        { auto rr = __builtin_amdgcn_permlane32_swap(__float_as_uint(ss), __float_as_uint(ss), false, false); ss = __uint_as_float(rr[0]) + __uint_as_float(rr[1]); }
        const float rstd = (1.0f / sqrtf(ss * (1.f / 64.f) + EPS)) * (1.4426950408889634f * SCALE);
        const int pos = P0 + wid * 32 + r32;
#pragma unroll
        for (int dd = 0; dd < 2; ++dd) {
            const float* cp = rope + pos * 32 + dd * 16 + hi * 8; const float* sp = cp + SEQ * 32;
            const float* g1 = qgain2 + dd * 16 + hi * 8; const float* g2 = g1 + 32;
            f32x4 a, b, c, d;
#pragma unroll
            for (int e = 0; e < 8; ++e) { const float t1 = bf2f((bf16)qr[8 + dd][e]) * rstd * g1[e], t2 = bf2f((bf16)qr[10 + dd][e]) * rstd * g2[e], cs = cp[e], sn = sp[e];
                const float n1 = t1 * cs - t2 * sn, n2 = t1 * sn + t2 * cs;
                if (e < 4) { a[e] = n1; c[e] = n2; } else { b[e - 4] = n1; d[e - 4] = n2; } }
            qr[8 + dd] = pack8(a, b); qr[10 + dd] = pack8(c, d); }
    }
    LAS float* ws = (LAS float*)(lds + L_WS) + wid * 64; LAS float* li_l = ws; LAS float* al_l = ws + 32;
    float m_reg = -1e30f, l_reg = 0.f; f32x16 o[4] = {};
    int kbase[8], krbase[4];
#pragma unroll
    for (int d0 = 0; d0 < 8; ++d0) kbase[d0] = KSWZ(r32, 2 * d0 + hi);
#pragma unroll
    for (int dr = 0; dr < 4; ++dr) krbase[dr] = KRSWZ(r32, 2 * dr + hi);
    const int vrd = (int)(uintptr_t)lds + L_V + v_rd_base(lane), kn0 = (int)(uintptr_t)lds + L_KN, kr0 = (int)(uintptr_t)lds + L_KR;
    const int qlo = P0 + wid * 32, qm = qlo + r32 - 4 * hi;
#define RESC(a) do { if (__any((a) < 1.f)) { if (hi == 0) al_l[r32] = (a); asm volatile("s_waitcnt lgkmcnt(0)" ::: "memory");              \
        _Pragma("unroll") for (int d_ = 0; d_ < 4; ++d_) _Pragma("unroll") for (int r = 0; r < 16; ++r) o[d_][r] *= al_l[crow(r, hi)]; } } while (0)
    f32x16 p0, p1; float mn, al; bf16x8 pa0, pa1, pa2, pa3;
    const float pinit = 0.f;
    asm volatile("s_waitcnt vmcnt(0)" ::: "memory");
    int ks = 0, vs = 0;
    for (int t = 0; t < NT; ++t) {
        if constexpr (NOPS == 5) asm volatile("s_waitcnt vmcnt(5)" ::: "memory"); else asm volatile("s_waitcnt vmcnt(4)" ::: "memory");
        asm volatile("s_waitcnt lgkmcnt(0)" ::: "memory"); if (abl != 4 && abl != 5) __builtin_amdgcn_s_barrier(); asm volatile("" ::: "memory");
        if (abl != 5) { const int tn = (t + 2 < NT) ? t + 2 : NT - 1;
          int ks2 = ks + 2; if (ks2 >= NKS) ks2 -= NKS; int vs2 = vs + 2; if (vs2 >= NVS) vs2 -= NVS;
          ISSUE(tn, ks2, vs2); }
        const int kb_ = t * 64;
        if (late && t > 0 && abl != 2) { int vp = vs - 1; if (vp < 0) vp += NVS; SBAR(); __builtin_amdgcn_s_setprio(ATT_PRIO); pv_tile(o, vrd + vp * SHM_V, pa0, pa1, pa2, pa3); __builtin_amdgcn_s_setprio(0); }
        { int kaddr[8], raddr[4];
#pragma unroll
          for (int d0 = 0; d0 < 8; ++d0) kaddr[d0] = kn0 + ks * SHM_KN + kbase[d0];
#pragma unroll
          for (int dr = 0; dr < 4; ++dr) raddr[dr] = kr0 + ks * SHM_KR + krbase[dr];
          SBAR(); __builtin_amdgcn_s_setprio(ATT_PRIO); if (abl != 3) qkt<NR>(p0, p1, kaddr, raddr, qr, pinit); else { p0 = f32x16{}; p1 = f32x16{}; } __builtin_amdgcn_s_setprio(0); }
        if (CAUSAL && kb_ + 63 > qlo) mask_tile(p0, p1, qm - kb_);
        if (abl != 1) { if (BND > 0.f) staticSM(p0, p1, l_reg, pa0, pa1, pa2, pa3);
                        else { partialSM(p0, p1, m_reg, mn, al, 0.6931471805599453f); finishSM(p0, p1, al, l_reg, pa0, pa1, pa2, pa3); RESC(al); } }
        else { u32x4 w0 = {cvt_pk_bf16(p0[0], p0[1]), cvt_pk_bf16(p0[2], p0[3]), cvt_pk_bf16(p0[4], p0[5]), cvt_pk_bf16(p0[6], p0[7])}, w1 = {cvt_pk_bf16(p0[8], p0[9]), cvt_pk_bf16(p0[10], p0[11]), cvt_pk_bf16(p0[12], p0[13]), cvt_pk_bf16(p0[14], p0[15])},
                     w2 = {cvt_pk_bf16(p1[0], p1[1]), cvt_pk_bf16(p1[2], p1[3]), cvt_pk_bf16(p1[4], p1[5]), cvt_pk_bf16(p1[6], p1[7])}, w3 = {cvt_pk_bf16(p1[8], p1[9]), cvt_pk_bf16(p1[10], p1[11]), cvt_pk_bf16(p1[12], p1[13]), cvt_pk_bf16(p1[14], p1[15])};
               pa0 = __builtin_bit_cast(bf16x8, w0); pa1 = __builtin_bit_cast(bf16x8, w1); pa2 = __builtin_bit_cast(bf16x8, w2); pa3 = __builtin_bit_cast(bf16x8, w3); l_reg = 1.f; }
        SBAR();
        if (!late && abl != 2) { __builtin_amdgcn_s_setprio(ATT_PRIO); pv_tile(o, vrd + vs * SHM_V, pa0, pa1, pa2, pa3); __builtin_amdgcn_s_setprio(0); }
        if (++ks == NKS) ks = 0; if (++vs == NVS) vs = 0;
    }
    if (late) { int vp = vs - 1; if (vp < 0) vp += NVS; SBAR(); pv_tile(o, vrd + vp * SHM_V, pa0, pa1, pa2, pa3); }
    if (hi == 0) li_l[r32] = l_reg;
    asm volatile("s_waitcnt lgkmcnt(0)" ::: "memory");
    bf16* Ow = O + (size_t)(wid * 32) * ldo;
#pragma unroll
    for (int r = 0; r < 16; ++r) { const int orow = crow(r, hi); const float rli = __builtin_amdgcn_rcpf(li_l[orow]);
#pragma unroll
        for (int d0 = 0; d0 < 4; ++d0) { const float v = o[d0][r] * rli; const float vn = __shfl_xor(v, 1);
            if ((r32 & 1) == 0 && !dry) *(unsigned*)(Ow + (size_t)orow * ldo + d0 * 32 + r32) = cvt_pk_bf16(v, vn); } }
    asm volatile("s_waitcnt vmcnt(0) lgkmcnt(0)" ::: "memory"); __builtin_amdgcn_s_barrier(); asm volatile("" ::: "memory");
#undef DMA16
#undef ISSUE
#undef RESC
}
}
constexpr int NWAVES = 8;
constexpr int RING_OFF = 0, RING_BYTES = 131072;
constexpr int XTRA_OFF = RING_BYTES, XTRA_BYTES = 32256;
constexpr int MISC_OFF = XTRA_OFF + XTRA_BYTES;
constexpr int LDS_BYTES = MISC_OFF + 512;
static_assert(LDS_BYTES == 163840, "LDS map");

constexpr size_t WB_GU0 = 0, WB_D0 = 11 * MiB, WB_GU1 = WB_D0 + (size_t)DM * FF * 2, WB_D1 = WB_GU1 + 11 * MiB, WB_WO = 33 * MiB, WB_IN = 36 * MiB, WB_UQ = 43 * MiB, WB_UKV = 45 * MiB;
static_assert(WB_D1 + (size_t)DM * FF * 2 <= WB_WO && WB_UKV + 1 * MiB <= 52 * MiB && WS_WB + 52 * MiB <= WS_XN, "weight map");
constexpr size_t WS_MEMW = WS_BIG;

constexpr int CW_BAR = 4096;
constexpr size_t WS_RS = 78 * MiB;
constexpr size_t CTL_ZERO_BYTES = 1 * MiB;
static_assert(WS_WB + 46 * MiB <= WS_RS && WS_RS + 12 * (size_t)M * 16 <= WS_XN, "row sums sit between the weight copies and XN");

struct MArgs { const float* in[29]; float* out; unsigned char* ws; int lo, hi, region, pad; };
static_assert(sizeof(MArgs) == 264, "no padding in the argument struct");

struct Frame {
    LAS unsigned char* lds;
    int vcu, G;
    float* X; unsigned char* ws; bf16* OC;
};
#define PH_IDS() int tid_ = threadIdx.x; asm volatile("" : "+v"(tid_)); const int tid = tid_, lane = tid & 63, wave = __builtin_amdgcn_readfirstlane(tid >> 6); (void)tid; (void)lane; (void)wave

__device__ __forceinline__ void tr_item(const float* W, int ldw, int scol, int k0, bf16* WT, int K, int drow, LAS float* scr, int lane, int nv, const float* gain) {
    const int c = lane & 7;
    if (nv == 0) {
#pragma unroll
        for (int j = 0; j < 4; ++j) { const int n = (lane >> 3) + 8 * j; *(GAS u32x4*)(WT + (size_t)(drow + n) * K + k0 + 8 * c) = (u32x4){0u, 0u, 0u, 0u}; }
        return;
    }
    const int n4 = (lane & 7) * 4, kq = lane >> 3;
    const GAS float* Wg = (const GAS float*)W + (size_t)(k0 + kq) * ldw + scol + n4;
    const bool val = n4 < nv;
    f32x4 wv[8];
#pragma unroll
    for (int i = 0; i < 8; ++i) wv[i] = val ? *(const GAS f32x4*)(Wg + (size_t)(8 * i) * ldw) : (f32x4){0.f, 0.f, 0.f, 0.f};
#pragma unroll
    for (int i = 0; i < 8; ++i) { LAS float* d = scr + (kq + 8 * i) * 33 + n4; d[0] = wv[i].x; d[1] = wv[i].y; d[2] = wv[i].z; d[3] = wv[i].w; }
    f32x4 g0 = (f32x4){1.f, 1.f, 1.f, 1.f}, g1 = g0;
    if (gain) { g0 = *(const GAS f32x4*)(gain + k0 + 8 * c); g1 = *(const GAS f32x4*)(gain + k0 + 8 * c + 4); }
    LDS_WAIT(); asm volatile("" ::: "memory");
#pragma unroll
    for (int j = 0; j < 4; ++j) { const int n = (lane >> 3) + 8 * j; const LAS float* s = scr + (8 * c) * 33 + n;
        u32x4 o; o.x = cvt_pk_bf16(s[0 * 33] * g0[0], s[1 * 33] * g0[1]); o.y = cvt_pk_bf16(s[2 * 33] * g0[2], s[3 * 33] * g0[3]); o.z = cvt_pk_bf16(s[4 * 33] * g1[0], s[5 * 33] * g1[1]); o.w = cvt_pk_bf16(s[6 * 33] * g1[2], s[7 * 33] * g1[3]);
        *(GAS u32x4*)(WT + (size_t)(drow + n) * K + k0 + 8 * c) = o; }
    LDS_WAIT(); asm volatile("" ::: "memory");
}

__device__ __forceinline__ void norm_row(const float* xrow, const f32x4 (&gg)[4], bf16* orow, int lane, f32x4 (&v)[4]) {
    const GAS f32x4* xr = (const GAS f32x4*)xrow + lane; float s = 0.f;
#pragma unroll
    for (int j = 0; j < 4; ++j) { v[j] = xr[64 * j]; s += (v[j].x * v[j].x + v[j].y * v[j].y) + (v[j].z * v[j].z + v[j].w * v[j].w); }
    const float rstd = 1.0f / sqrtf(wave_sum(s) * (1.f / DM) + EPS);
    GAS u32x2* o8 = (GAS u32x2*)orow + lane;
#pragma unroll
    for (int j = 0; j < 4; ++j) { v[j] = v[j] * rstd * gg[j]; u32x2 w; w.x = cvt_pk_bf16(v[j].x, v[j].y); w.y = cvt_pk_bf16(v[j].z, v[j].w); o8[64 * j] = w; }
}

__device__ __forceinline__ void raw_row(const float* xrow, bf16* orow, float* rs_out, int lane) {
    const GAS f32x4* xr = (const GAS f32x4*)xrow + lane; f32x4 v[4]; float s = 0.f;
#pragma unroll
    for (int j = 0; j < 4; ++j) { v[j] = xr[64 * j]; s += (v[j].x * v[j].x + v[j].y * v[j].y) + (v[j].z * v[j].z + v[j].w * v[j].w); }
    s = wave_sum(s);
    GAS u32x2* o8 = (GAS u32x2*)orow + lane;
#pragma unroll
    for (int j = 0; j < 4; ++j) { u32x2 w; w.x = cvt_pk_bf16(v[j].x, v[j].y); w.y = cvt_pk_bf16(v[j].z, v[j].w); o8[64 * j] = w; }
    if (lane == 0) *(GAS f32x4*)rs_out = (f32x4){s, 0.f, 0.f, 0.f};
}
__device__ __forceinline__ void ph_prologue(Frame& F, const float* x, const float* mem, const float* mn, const float* memw) {
    PH_IDS();
    const int gt = F.vcu * 512 + tid, NT = F.G * 512, gw = F.vcu * NWAVES + wave, NGW = F.G * NWAVES;
    { bf16* XB = (bf16*)(F.ws + WS_XN); float* RS0 = (float*)(F.ws + WS_RS);
      for (int m = gw; m < M; m += NGW) raw_row(x + (size_t)m * DM, XB + (size_t)m * DM, RS0 + (size_t)m * 4, lane); }
    { float* cs = (float*)(F.ws + WS_ROPE);
      const int f = gt & 31; const float ex = (float)(2 * f) / 64.0f; const float inv = (float)(1.0 / pow(10000.0, (double)ex));
      for (int i = gt; i < SEQ * 32; i += NT) { const int pos = i >> 5; const float ang = (float)pos * inv; float sn, cn; sincosf(ang, &sn, &cn);
          cs[i] = cn; cs[SEQ * 32 + i] = sn; } }
    { bf16* MEMH = (bf16*)(F.ws + WS_MEMH);
      for (int r = gw; r < 4 * 1024; r += NGW) { const int l = r >> 10, row = r & 1023; f32x4 gg[4], v[4];
#pragma unroll
          for (int j = 0; j < 4; ++j) gg[j] = ((const f32x4*)(mn + l * DM))[lane + 64 * j];
          norm_row(mem + (size_t)row * DM, gg, MEMH + (size_t)r * DM, lane, v); } }
    { LAS float* scr = (LAS float*)(F.lds + RING_OFF + wave * 16384); bf16* MW = (bf16*)(F.ws + WS_MEMW);
      for (int it = gw; it < 4 * 512; it += NGW) { const int l = it >> 9, r = it & 511, kb = r >> 5, nb = r & 31;
          tr_item(memw + (size_t)l * DM * DM, DM, 32 * nb, 64 * kb, MW + (size_t)l * DM * DM, DM, 32 * nb, scr, lane, 32, nullptr); } }
}
__device__ __forceinline__ void ph_memknorm(Frame& F, const float* memk_norm) {
    PH_IDS();
    const int gw = F.vcu * NWAVES + wave, NGW = F.G * NWAVES; bf16* KVm = (bf16*)(F.ws + WS_MEMKV);
    for (int idx = gw; idx < 4096 * 4; idx += NGW) { const int row = idx >> 2, h = idx & 3, l = row >> 10;
        bf16* p = KVm + (size_t)row * 1024 + h * 128 + lane * 2; const float* g = memk_norm + l * 128;
        const float a = bf2f(p[0]), b = bf2f(p[1]);
        const float rstd = 1.0f / sqrtf(wave_sum(a * a + b * b) * (1.f / 128.f) + EPS);
        *(GAS unsigned*)p = cvt_pk_bf16(a * rstd * g[lane * 2], b * rstd * g[lane * 2 + 1]); }
}
struct ConvPtrs { const float *g0, *u0, *d0, *g1, *u1, *d1, *wo, *gin, *min, *uq, *ukv, *n1, *n2, *nm; };
template <int MAP>
__device__ __forceinline__ void conv_job(Frame& F, const float* W, int ldw, int nkb, int nblk, bf16* dst, int K, int& rot, LAS float* scr, int wave, int lane, const float* gain) {
    const int NGW = F.G * NWAVES; int gw = F.vcu * NWAVES + wave - rot; if (gw < 0) gw += NGW;
    const int total = nkb * nblk;
    for (int r = gw; r < total; r += NGW) {
        const int kb = r / nblk, nb = r - kb * nblk; int scol = 32 * nb, drow = 32 * nb, nv = 32;
        if (MAP == 1) drow = 32 * ((nb >> 2) * 8 + (nb & 3));
        if (MAP == 2) drow = 32 * ((nb >> 2) * 8 + 4 + (nb & 3));
        if (MAP == 3) { scol = drow < 1024 ? drow : drow < 2048 ? drow + 1040 : drow < 3072 ? drow - 1024 : drow < 3584 ? drow + 16 : 2048; nv = drow < 3584 ? 32 : drow == 3584 ? 16 : 0; }
        if (MAP == 4) nv = drow >= MLA_IN ? 0 : 32;
        tr_item(W, ldw, scol, 64 * kb, dst, K, drow, scr, lane, nv, gain);
    }
    rot = (rot + total) % NGW;
}
__device__ __forceinline__ void conv_layer(Frame& F, int i, const ConvPtrs& cp) {
    PH_IDS();
    const int j = i >> 1; const bool gla = !(i & 1);
    LAS float* scr = (LAS float*)(F.lds + RING_OFF + wave * 16384);
    unsigned char* wb = F.ws + WS_WB; int rot = 0;
    conv_job<1>(F, cp.g0 + (size_t)i * DM * FF, FF, 16, 88, (bf16*)(wb + WB_GU0), DM, rot, scr, wave, lane, cp.n1 + i * DM);
    conv_job<2>(F, cp.u0 + (size_t)i * DM * FF, FF, 16, 88, (bf16*)(wb + WB_GU0), DM, rot, scr, wave, lane, cp.n1 + i * DM);
    conv_job<1>(F, cp.g1 + (size_t)i * DM * FF, FF, 16, 88, (bf16*)(wb + WB_GU1), DM, rot, scr, wave, lane, cp.n2 + i * DM);
    conv_job<2>(F, cp.u1 + (size_t)i * DM * FF, FF, 16, 88, (bf16*)(wb + WB_GU1), DM, rot, scr, wave, lane, cp.n2 + i * DM);
    conv_job<0>(F, cp.d0 + (size_t)i * FF * DM, DM, 44, 32, (bf16*)(wb + WB_D0), FF, rot, scr, wave, lane, nullptr);
    conv_job<0>(F, cp.d1 + (size_t)i * FF * DM, DM, 44, 32, (bf16*)(wb + WB_D1), FF, rot, scr, wave, lane, nullptr);
    conv_job<0>(F, cp.wo + (size_t)i * 1536 * DM, DM, 24, 32, (bf16*)(wb + WB_WO), 1536, rot, scr, wave, lane, nullptr);
    if (gla) conv_job<3>(F, cp.gin + (size_t)j * DM * GLA_IN, GLA_IN, 16, 120, (bf16*)(wb + WB_IN), DM, rot, scr, wave, lane, cp.nm + i * DM);
    else {
        conv_job<4>(F, cp.min + (size_t)j * DM * MLA_IN, MLA_IN, 16, 40, (bf16*)(wb + WB_IN), DM, rot, scr, wave, lane, cp.nm + i * DM);
        conv_job<0>(F, cp.uq + (size_t)j * 384 * QW, QW, 6, 48, (bf16*)(wb + WB_UQ), 384, rot, scr, wave, lane, nullptr);
        conv_job<0>(F, cp.ukv + (size_t)j * 256 * KVW, KVW, 4, 64, (bf16*)(wb + WB_UKV), 256, rot, scr, wave, lane, nullptr);
    }
}
__device__ __forceinline__ void ph_mla_rowprep(Frame& F, const float* gq, const float* gkv, const float* gkr, const bool dry = false) {
    PH_IDS();
    const int gw = F.vcu * NWAVES + wave, NGW = F.G * NWAVES;
    bf16* P = (bf16*)(F.ws + WS_PM); bf16* KR = (bf16*)(F.ws + WS_KR); const float* rope = (const float*)(F.ws + WS_ROPE);
    f32x4 ga[2], gb[2];
    { const float* g = lane < 48 ? gq + 8 * lane : gkv + 8 * (lane - 48); ga[0] = *(const f32x4*)g; ga[1] = *(const f32x4*)(g + 4); }
    { const float* g = lane < 16 ? gkv + 8 * (16 + lane) : gkr + 8 * ((lane - 16) & 7); gb[0] = *(const f32x4*)g; gb[1] = *(const f32x4*)(g + 4); }
    for (int m = gw; m < M; m += NGW) {
        bf16* p = P + (size_t)m * PM;
        const bf16x8 c0 = *(const bf16x8*)(p + 8 * lane);
        bf16x8 c1 = (bf16x8){0, 0, 0, 0, 0, 0, 0, 0}; if (lane < 24) c1 = *(const bf16x8*)(p + 512 + 8 * lane);
        float a[8], b[8]; float s0 = 0.f, s1 = 0.f;
#pragma unroll
        for (int e = 0; e < 8; ++e) { a[e] = bf2f((bf16)c0[e]); b[e] = bf2f((bf16)c1[e]); s0 += a[e] * a[e]; s1 += b[e] * b[e]; }
        const float sq = wave_sum(lane < 48 ? s0 : 0.f), skv = wave_sum((lane >= 48 ? s0 : 0.f) + (lane < 16 ? s1 : 0.f)), skr = wave_sum((lane >= 16 && lane < 24) ? s1 : 0.f);
        const float rq = 1.0f / sqrtf(sq * (1.f / 384.f) + EPS), rkv = 1.0f / sqrtf(skv * (1.f / 256.f) + EPS), rkr = 1.0f / sqrtf(skr * (1.f / 64.f) + EPS);
        const float r0 = lane < 48 ? rq : rkv, r1 = lane < 16 ? rkv : rkr;
        f32x4 x0, x1, y0, y1;
#pragma unroll
        for (int e = 0; e < 4; ++e) { x0[e] = a[e] * r0 * ga[0][e]; x1[e] = a[4 + e] * r0 * ga[1][e]; y0[e] = b[e] * r1 * gb[0][e]; y1[e] = b[4 + e] * r1 * gb[1][e]; }
        if (!dry) *(bf16x8*)(p + 8 * lane) = att::pack8(x0, x1);
        if (lane < 16 && !dry) *(bf16x8*)(p + 512 + 8 * lane) = att::pack8(y0, y1);
        const int ck = (lane - 16) & 7, pos = m % SEQ; const float* cp = rope + pos * 32 + 8 * (ck & 3); const float* sp = cp + SEQ * 32;
        const f32x4 cs0 = *(const f32x4*)cp, cs1 = *(const f32x4*)(cp + 4), sn0 = *(const f32x4*)sp, sn1 = *(const f32x4*)(sp + 4);
        f32x4 o0, o1;
#pragma unroll
        for (int e = 0; e < 4; ++e) { const float t0 = __shfl_xor(y0[e], 4), t1 = __shfl_xor(y1[e], 4);
            o0[e] = ck < 4 ? (y0[e] * cs0[e] - t0 * sn0[e]) : (t0 * sn0[e] + y0[e] * cs0[e]);
            o1[e] = ck < 4 ? (y1[e] * cs1[e] - t1 * sn1[e]) : (t1 * sn1[e] + y1[e] * cs1[e]); }
        if (lane >= 16 && lane < 24 && !dry) *(bf16x8*)(KR + (size_t)m * 64 + 8 * ck) = att::pack8(o0, o1);
    }
}
__device__ __forceinline__ void ph_mla_knorm(Frame& F, const float* gkn, const bool dry = false) {
    PH_IDS();
    const int gw = F.vcu * NWAVES + wave, NGW = F.G * NWAVES; bf16* KV = (bf16*)(F.ws + WS_KV);
    f32x4 g[4];
#pragma unroll
    for (int q = 0; q < 4; ++q) g[q] = *(const f32x4*)(gkn + (lane & 7) * 16 + 4 * q);
    for (int m = gw; m < M; m += NGW) {
        bf16* p = KV + (size_t)m * KVW + (lane >> 3) * 256 + (lane & 7) * 16;
        const bf16x8 c0 = *(const bf16x8*)p, c1 = *(const bf16x8*)(p + 8);
        float a[16]; float s = 0.f;
#pragma unroll
        for (int e = 0; e < 8; ++e) { a[e] = bf2f((bf16)c0[e]); a[8 + e] = bf2f((bf16)c1[e]); s += a[e] * a[e] + a[8 + e] * a[8 + e]; }
        s += __shfl_xor(s, 1); s += __shfl_xor(s, 2); s += __shfl_xor(s, 4);
        const float rstd = 1.0f / sqrtf(s * (1.f / 128.f) + EPS);
        f32x4 x[4];
#pragma unroll
        for (int q = 0; q < 4; ++q)
#pragma unroll
            for (int e = 0; e < 4; ++e) x[q][e] = a[4 * q + e] * rstd * g[q][e];
        if (!dry) { *(bf16x8*)p = att::pack8(x[0], x[1]); *(bf16x8*)(p + 8) = att::pack8(x[2], x[3]); }
    }
}
__device__ __forceinline__ float wave_absmax(const float* g, int n, int lane) {
    float m = fabsf(g[lane]); if (n > 64) m = fmaxf(m, fabsf(g[64 + lane]));
#pragma unroll
    for (int o = 1; o < 64; o <<= 1) m = fmaxf(m, __shfl_xor(m, o));
    return m;
}
__device__ __forceinline__ void ph_memattn(Frame& F, int layer, bool gla, const float* qgain, const float* kgain, const bool dry = false) {
    float bnd; { PH_IDS(); bnd = 0.08838834764831845f * 128.f * wave_absmax(qgain, 128, lane) * wave_absmax(kgain, 128, lane) * 1.03f; if (!(bnd < 40.f)) bnd = 0.f; }
    const bf16* memkv = (const bf16*)(F.ws + WS_MEMKV) + (size_t)layer * 1024 * 1024;
    for (int x = F.vcu; x < 512; x += F.G) {
        const int b = x >> 7, h = (x >> 5) & 3, qb = x & 31; const size_t row0 = (size_t)b * SEQ + 256 * qb;
        const bf16* Q; bf16* O; int ldq, ldo;
        if (gla) { bf16* P = (bf16*)(F.ws + WS_PG); Q = P + row0 * PG + PG_QM + h * 128; O = P + row0 * PG + PG_QM + h * 128; ldq = PG; ldo = PG; }
        else { Q = (const bf16*)(F.ws + WS_PM) + row0 * PM + PM_QM + h * 128; O = F.OC + row0 * OCW + 1024 + h * 128; ldq = PM; ldo = OCW; }
        const bf16* Kn = memkv + (size_t)b * NMEM * 1024 + h * 128;
        att::attn_block<0, false, 1>((LAS char*)F.lds, Q, ldq, Kn, 1024, nullptr, Kn + 512, 1024, O, ldo, 4, 0, 0.08838834764831845f, bnd, qgain, nullptr, nullptr, dry);
    }
}

__device__ __forceinline__ void ph_mla_attn(Frame& F, const float* gqn, const float* gqr, const float* gkn, const float* gkr, const bool dry = false) {
    float bnd; { PH_IDS(); bnd = 0.07216878364870322f * (128.f * wave_absmax(gqn, 128, lane) * wave_absmax(gkn, 128, lane) + 64.f * wave_absmax(gqr, 64, lane) * wave_absmax(gkr, 64, lane)) * 1.03f; if (!(bnd < 40.f)) bnd = 0.f; }
    const bf16* Qb = (const bf16*)(F.ws + WS_Q); const bf16* KVb = (const bf16*)(F.ws + WS_KV); const bf16* KRb = (const bf16*)(F.ws + WS_KR); bf16* OC = F.OC;
    const float* rope = (const float*)(F.ws + WS_ROPE);
    for (int x = F.vcu; x < 512; x += F.G) {
        const int bh = x >> 4, y = x & 15, b = bh >> 3, h = bh & 7;
        for (int pass = 0; pass < 2; ++pass) {
            const int qb = pass ? y : 31 - y; const size_t row0 = (size_t)b * SEQ + 256 * qb; const bf16* Kn = KVb + (size_t)b * SEQ * KVW + h * 256;
            att::attn_block<4, true, 2>((LAS char*)F.lds, Qb + row0 * QW + h * 192, QW, Kn, KVW, KRb + (size_t)b * SEQ * 64, Kn + 128, KVW, OC + row0 * OCW + h * 128, OCW,
                                        4 * (qb + 1), 256 * qb, 0.07216878364870322f, bnd, gqn, gqr, rope, dry);
        }
    }
}

constexpr int GCH = 128, GNU = 1024;
__device__ __forceinline__ void ph_gla_prep(Frame& F, const float* wa  , const float* ba  , const bool dry = false) {
    PH_IDS();
    const int u4 = wave >> 1, c = tid & 127;
    bf16* P = (bf16*)(F.ws + WS_PG); const float* ALOW = (const float*)(F.ws + WS_ALOW); float* GV = (float*)(F.ws + WS_GV);
    for (int ub = F.vcu * 4; ub < GNU; ub += F.G * 4) {
        const int unit = ub + u4, h = unit & 3; const size_t row0 = (size_t)(unit >> 2) * GCH;
        float w[16];
#pragma unroll
        for (int k = 0; k < 16; ++k) w[k] = wa[k * 512 + h * 128 + c];
        const float bias = ba[h * 128 + c];
        float bc[64]; float run = 0.f, bref = 0.f;
#pragma unroll
        for (int hf = 0; hf < 2; ++hf) {
            const float* al = ALOW + (row0 + 64 * hf) * 16;
#pragma unroll
            for (int r = 0; r < 64; ++r) { float z = bias;
#pragma unroll
                for (int k = 0; k < 16; ++k) z += al[r * 16 + k] * w[k];
                const float ls = fminf(z, 0.f) - 0.6931471805599453f * __builtin_amdgcn_logf(1.0f + __builtin_amdgcn_exp2f(-1.4426950408889634f * fabsf(z)));
                run += ls * (1.f / 16.f); bc[r] = run; }
            if (hf == 0) bref = bc[63];
            bf16* qp = P + (row0 + 64 * hf) * PG + PG_Q + h * 128 + c; bf16* kp = P + (row0 + 64 * hf) * PG + PG_K + h * 128 + c;
#pragma unroll
            for (int r = 0; r < 64; ++r) { const float qv = bf2f(qp[(size_t)r * PG]), kv = bf2f(kp[(size_t)r * PG]);
                const float eq = __builtin_amdgcn_exp2f(1.4426950408889634f * (bc[r] - bref));
                if (!dry) { qp[(size_t)r * PG] = f2bf(qv * eq * 0.08838834764831845f); kp[(size_t)r * PG] = f2bf(kv * __builtin_amdgcn_rcpf(eq)); } }
        }
        const float blast = run;
        float* gv = GV + (size_t)unit * 384 + c;
        if (!dry) { gv[0] = __builtin_amdgcn_exp2f(1.4426950408889634f * blast); gv[128] = __builtin_amdgcn_exp2f(1.4426950408889634f * (blast - bref)); gv[256] = __builtin_amdgcn_exp2f(1.4426950408889634f * bref); }
    }
}
#define GL_TRRD(dst, base, off) asm volatile("ds_read_b64_tr_b16 %0, %1 offset:%2" : "=&v"(dst) : "v"(base), "i"(off) : "memory")
#define GL_FRAG(out, base, d0, ks) do { att::s16x4 l_, h_; GL_TRRD(l_, base, (d0) * 512 + (ks) * 4096); GL_TRRD(h_, base, (d0) * 512 + (ks) * 4096 + 2048); \
        asm volatile("s_waitcnt lgkmcnt(0)" ::: "memory"); __builtin_amdgcn_sched_barrier(0); out = (bf16x8){l_[0], l_[1], l_[2], l_[3], h_[0], h_[1], h_[2], h_[3]}; } while (0)
#define GL_STAGE_V() do { const bf16* vp = P + (row0 + sr) * PG + PG_V + h * 256 + sc; \
        _Pragma("unroll") for (int q4 = 0; q4 < 4; ++q4) { const bf16x8 x0 = *(const bf16x8*)(vp + (size_t)(32 * q4) * PG), x1 = *(const bf16x8*)(vp + (size_t)(32 * q4) * PG + 128); \
            const int o_ = (q4 >> 1) * 32768 + ((q4 & 1) ? vst1 : vst0); *(LAS bf16x8*)(lds + o_) = x0; *(LAS bf16x8*)(lds + o_ + 16384) = x1; } } while (0)
__device__ __forceinline__ void ph_gla_u(Frame& F) {
    PH_IDS();
    const int r32 = lane & 31, hi = lane >> 5, sr = tid >> 4, sc = (tid & 15) * 8;
    const bf16* P = (const bf16*)(F.ws + WS_PG); bf16* US = (bf16*)(F.ws + WS_US); const float* GV = (const float*)(F.ws + WS_GV);
    LAS char* lds = (LAS char*)F.lds;
    const int vst0 = att::v_st(sr, sc), vst1 = att::v_st(32 + sr, sc);
    const int vbA = (int)(uintptr_t)lds + att::v_rd_base(lane) + (wave >> 2) * 16384 + (wave & 3) * 512, vbB = (int)(uintptr_t)lds + att::v_rd_base(lane) + 65536;
    for (int unit = F.vcu; unit < GNU; unit += F.G) {
        const int h = unit & 3; const size_t row0 = (size_t)(unit >> 2) * GCH;
        GL_STAGE_V();
        { const bf16* kp = P + (row0 + sr) * PG + PG_K + h * 128 + sc;
#pragma unroll
          for (int q4 = 0; q4 < 4; ++q4) { const bf16x8 x0 = *(const bf16x8*)(kp + (size_t)(32 * q4) * PG); *(LAS bf16x8*)(lds + 65536 + (q4 >> 1) * 16384 + ((q4 & 1) ? vst1 : vst0)) = x0; } }
        __syncthreads();
        att::f32x16 acc[4] = {};
#pragma unroll
        for (int jh = 0; jh < 2; ++jh)
#pragma unroll
            for (int ks = 0; ks < 4; ++ks) { bf16x8 a; GL_FRAG(a, vbA + jh * 32768, 0, ks);
#pragma unroll
                for (int nb = 0; nb < 4; ++nb) { bf16x8 b; GL_FRAG(b, vbB + jh * 16384, nb, ks); acc[nb] = __builtin_amdgcn_mfma_f32_32x32x16_bf16(a, b, acc[nb], 0, 0, 0); } }
        bf16* up = US + (size_t)unit * 32768 + (size_t)(wave * 32) * 128 + r32;
#pragma unroll
        for (int nb = 0; nb < 4; ++nb) { const float e2 = GV[(size_t)unit * 384 + 128 + nb * 32 + r32];
#pragma unroll
            for (int r = 0; r < 16; ++r) up[(size_t)att::crow(r, hi) * 128 + nb * 32] = f2bf(acc[nb][r] * e2); }
        __syncthreads();
    }
}
__device__ __forceinline__ void ph_gla_scan(Frame& F, const bool dry = false) {
    PH_IDS();
    bf16* US = (bf16*)(F.ws + WS_US); const float* GV = (const float*)(F.ws + WS_GV);
    for (int e = F.vcu * 512 + tid; e < 131072; e += F.G * 512) {
        const int dkq = e & 31, dv = (e >> 5) & 255, bh = e >> 13, b = bh >> 2, h = bh & 3;
        f32x4 S = (f32x4){0.f, 0.f, 0.f, 0.f};
        const size_t ustride = (size_t)4 * 32768;
        bf16* up = US + ((size_t)(b * 64) * 4 + h) * 32768 + (size_t)dv * 128 + dkq * 4;
        const float* gp = GV + ((size_t)(b * 64) * 4 + h) * 384 + dkq * 4;
        for (int n = 0; n < 64; n += 4) {
            u32x2 uu[4]; f32x4 dc[4], e1[4];
#pragma unroll
            for (int q = 0; q < 4; ++q) { uu[q] = *(const GAS u32x2*)(up + (size_t)(n + q) * ustride); dc[q] = *(const GAS f32x4*)(gp + (size_t)(n + q) * 4 * 384); e1[q] = *(const GAS f32x4*)(gp + (size_t)(n + q) * 4 * 384 + 256); }
#pragma unroll
            for (int q = 0; q < 4; ++q) {
                const f32x4 s1 = S * e1[q]; u32x2 w; w.x = cvt_pk_bf16(s1.x, s1.y); w.y = cvt_pk_bf16(s1.z, s1.w);
                if (!dry) *(GAS u32x2*)(up + (size_t)(n + q) * ustride) = w;
                f32x4 u; u.x = __uint_as_float(uu[q].x << 16); u.y = __uint_as_float(uu[q].x & 0xffff0000u); u.z = __uint_as_float(uu[q].y << 16); u.w = __uint_as_float(uu[q].y & 0xffff0000u);
                S = S * dc[q] + u; }
        }
    }
}
template <int B_> __device__ __forceinline__ bf16x8 gl_pk4(const att::f32x16& P) {
    const unsigned a0 = cvt_pk_bf16(P[B_ + 0], P[B_ + 1]), a1 = cvt_pk_bf16(P[B_ + 2], P[B_ + 3]), b0 = cvt_pk_bf16(P[B_ + 4], P[B_ + 5]), b1 = cvt_pk_bf16(P[B_ + 6], P[B_ + 7]);
    auto r0 = __builtin_amdgcn_permlane32_swap(a0, b0, false, false); auto r1 = __builtin_amdgcn_permlane32_swap(a1, b1, false, false);
    u32x4 w = {r0[0], r1[0], r0[1], r1[1]}; return __builtin_bit_cast(bf16x8, w);
}
__device__ __forceinline__ void ph_gla_out(Frame& F, const float* gout  , const bool dry = false) {
    PH_IDS();
    const int r32 = lane & 31, hi = lane >> 5, sr = tid >> 4, sc = (tid & 15) * 8, it = wave & 3, grp = wave >> 2;
    bf16* P = (bf16*)(F.ws + WS_PG); const bf16* US = (const bf16*)(F.ws + WS_US);
    LAS char* lds = (LAS char*)F.lds; LAS float* part = (LAS float*)(lds + 65536); LAS float* rstd_l = (LAS float*)(lds + 65536 + 1024);
    const int vst0 = att::v_st(sr, sc), vst1 = att::v_st(32 + sr, sc);
    const int vb = (int)(uintptr_t)lds + att::v_rd_base(lane) + grp * 16384;
    float g4[4];
#pragma unroll
    for (int blk = 0; blk < 4; ++blk) g4[blk] = gout[grp * 128 + blk * 32 + r32];
    for (int unit = F.vcu; unit < GNU; unit += F.G) {
        const int h = unit & 3; const size_t row0 = (size_t)(unit >> 2) * GCH;
        GL_STAGE_V();
        bf16x8 qr[8];
        { const bf16* qp = P + (row0 + 32 * it + r32) * PG + PG_Q + h * 128 + hi * 8;
#pragma unroll
          for (int d0 = 0; d0 < 8; ++d0) qr[d0] = *(const bf16x8*)(qp + d0 * 16); }
        __syncthreads();
        att::f32x16 o[4] = {};
#define GL_JT(jt) do { att::f32x16 p = {}; const bf16* kp = P + (row0 + 32 * (jt) + r32) * PG + PG_K + h * 128 + hi * 8; \
            _Pragma("unroll") for (int d0 = 0; d0 < 8; ++d0) { const bf16x8 kf = *(const bf16x8*)(kp + d0 * 16); p = __builtin_amdgcn_mfma_f32_32x32x16_bf16(kf, qr[d0], p, 0, 0, 0); } \
            if ((jt) == it) { _Pragma("unroll") for (int r = 0; r < 16; ++r) if (att::crow(r, hi) > r32) p[r] = 0.f; } \
            const bf16x8 paA = gl_pk4<0>(p), paB = gl_pk4<8>(p); \
            _Pragma("unroll") for (int blk = 0; blk < 4; ++blk) { bf16x8 vA, vB; GL_FRAG(vA, vb + ((jt) >> 1) * 32768, blk, 2 * ((jt) & 1)); GL_FRAG(vB, vb + ((jt) >> 1) * 32768, blk, 2 * ((jt) & 1) + 1); \
                o[blk] = __builtin_amdgcn_mfma_f32_32x32x16_bf16(paA, vA, o[blk], 0, 0, 0); o[blk] = __builtin_amdgcn_mfma_f32_32x32x16_bf16(paB, vB, o[blk], 0, 0, 0); } } while (0)
        GL_JT(0);
        if (it >= 1) GL_JT(1);
        if (it >= 2) GL_JT(2);
        if (it >= 3) GL_JT(3);
#undef GL_JT
        { const bf16* sp = US + (size_t)unit * 32768 + (size_t)(grp * 128 + r32) * 128 + hi * 8;
#pragma unroll
          for (int ks = 0; ks < 8; ++ks)
#pragma unroll
              for (int blk = 0; blk < 4; ++blk) { const bf16x8 b0 = *(const bf16x8*)(sp + (size_t)(blk * 32) * 128 + ks * 16); o[blk] = __builtin_amdgcn_mfma_f32_32x32x16_bf16(qr[ks], b0, o[blk], 0, 0, 0); } }
        float v16[16];
#pragma unroll
        for (int r = 0; r < 16; ++r) v16[r] = (o[0][r] * o[0][r] + o[1][r] * o[1][r]) + (o[2][r] * o[2][r] + o[3][r] * o[3][r]);
        float w8[8], w4[4], w2[2], w1;
        { const bool up = (lane & 16) != 0;
#pragma unroll
          for (int q = 0; q < 8; ++q) { const float keep = up ? v16[8 + q] : v16[q], send = up ? v16[q] : v16[8 + q]; w8[q] = keep + __shfl_xor(send, 16); } }
        { const bool up = (lane & 8) != 0;
#pragma unroll
          for (int q = 0; q < 4; ++q) { const float keep = up ? w8[4 + q] : w8[q], send = up ? w8[q] : w8[4 + q]; w4[q] = keep + __shfl_xor(send, 8); } }
        { const bool up = (lane & 4) != 0;
#pragma unroll
          for (int q = 0; q < 2; ++q) { const float keep = up ? w4[2 + q] : w4[q], send = up ? w4[q] : w4[2 + q]; w2[q] = keep + __shfl_xor(send, 4); } }
        { const bool up = (lane & 2) != 0; const float keep = up ? w2[1] : w2[0], send = up ? w2[0] : w2[1]; w1 = keep + __shfl_xor(send, 2); }
        w1 += __shfl_xor(w1, 1);
        if ((lane & 1) == 0) part[(it * 32 + att::crow(r32 >> 1, hi)) * 2 + grp] = w1;
        __syncthreads();
        if (tid < 128) rstd_l[tid] = 1.0f / sqrtf((part[tid * 2] + part[tid * 2 + 1]) * (1.f / 256.f) + EPS);
        __syncthreads();
#pragma unroll
        for (int r = 0; r < 16; ++r) { const int i = 32 * it + att::crow(r, hi); const float rs = rstd_l[i];
            bf16* rowp = P + (row0 + i) * PG + h * 256 + grp * 128 + r32;
#pragma unroll
            for (int blk = 0; blk < 4; ++blk) { const float rg = bf2f(rowp[PG_R + blk * 32]);
                if (!dry) rowp[PG_V + blk * 32] = f2bf(o[blk][r] * rs * g4[blk] * fast_silu(rg)); } }
        __syncthreads();
    }
}
#undef GL_STAGE_V

constexpr int PID_END = 16 * 9;
#ifndef PROBE_PID
#define PROBE_PID (-1)
#endif
#ifndef PROBE_N
#define PROBE_N 1
#endif
#ifndef PROBE_PID2
#define PROBE_PID2 (-1)
#endif
#ifndef PROBE_PID3
#define PROBE_PID3 (-1)
#endif
#define NREP(k) ((((k) == PROBE_PID) || ((k) == PROBE_PID2) || ((k) == PROBE_PID3)) ? PROBE_N : 1)
#ifndef GU_ALIGN
#define GU_ALIGN true
#endif
#ifndef REV_GU
#define REV_GU 0
#endif
#ifndef REV_DOWN
#define REV_DOWN 1
#endif
#ifndef REV_OUT
#define REV_OUT 1
#endif
#ifndef REV_IN
#define REV_IN 0
#endif
#define REP(k) for (int rep_ = 0; rep_ < NREP(k); ++rep_)
#define DRY(k) (rep_ + 1 < NREP(k))
__global__ void __launch_bounds__(NWAVES * 64, 2) mk_fwd(MArgs args) {
    extern __shared__ __attribute__((aligned(16))) unsigned char lds_raw[];
    Frame F;
    F.lds = (LAS unsigned char*)lds_raw;
    F.G = gridDim.x; { const int bx = blockIdx.x; F.vcu = (F.G % 8 == 0) ? (bx % 8) * (F.G / 8) + bx / 8 : bx; }
    F.X = args.out; F.ws = args.ws; F.OC = (bf16*)args.out;
    volatile LAS unsigned* MISC = (volatile LAS unsigned*)(F.lds + MISC_OFF);
    for (int u = threadIdx.x; u < 128; u += NWAVES * 64) MISC[u] = 0u;
    __syncthreads();
    XcdBarrier bar = xcd_barrier_post((unsigned*)(F.ws + WS_CTL) + CW_BAR + args.region * XCD_BAR_WORDS, MISC + 8);
    const int lo = args.lo, hi = args.hi;
#define IN(k) (lo <= (k) && (k) < hi)
#define SEAM(k) do { if ((k) + 1 < hi) xcd_barrier(bar); } while (0)
    unsigned char* ws = F.ws; unsigned char* wb = ws + WS_WB;

    LAS unsigned char* rstab = F.lds + XTRA_OFF;
    float* RS = (float*)(ws + WS_RS); LAS float* rspart = (LAS float*)(F.lds + XTRA_OFF + 8192);
#define OPQ(k) ({ const float* p_ = args.in[k]; asm volatile("" : "+s"(p_)); p_; })
#define CONV(layer) do { const ConvPtrs cp{OPQ(3), OPQ(4), OPQ(5), OPQ(7), OPQ(8), OPQ(9), OPQ(11), OPQ(16), OPQ(20), OPQ(23), OPQ(24), OPQ(2), OPQ(6), OPQ(10)}; conv_layer(F, (layer), cp); } while (0)

    if (IN(0)) { REP(0) { ph_prologue(F, args.in[0], args.in[1], args.in[12], args.in[13]); CONV(0); } SEAM(0); }
    if (IN(1)) {
        pg8::Gemm g{(const bf16*)(ws + WS_MEMH), (const bf16*)(ws + WS_MEMW), 4096, 4096, DM, DM, DM}; pg8::DiagOrder S{F.G, (int)blockIdx.x, 4};
        pg8::EpiBf16<false> E{(bf16*)(ws + WS_MEMKV), 1024, 3};
        pg8::gemm_phase<pg8::EpiBf16<false>, pg8::DiagOrder, PG8_ALIGN, PG8_SP2>(F.lds + RING_OFF, g, S, E);
        SEAM(1);
    }
    if (IN(2)) { ph_memknorm(F, args.in[15]); SEAM(2); }

    for (int it = 0; it < 8; ++it) {
        const int pb = 16 * (it + 1), i = it >> 1, half = it & 1, j = i >> 1;
        if (pb + 16 <= lo || pb >= hi) continue;
        if (half) {
            const bool gla = !(i & 1);
            if (IN(pb + 1)) REP(pb + 1) {
                if (gla) {
                    pg8::Gemm g{(const bf16*)(ws + WS_XN), (const bf16*)(wb + WB_IN), M, 3840, DM, DM, DM}; pg8::StaticOrder S; S.init(M, 3840, F.G, (int)blockIdx.x, REV_IN);
                    pg8::EpiGlaIn E{(bf16*)(ws + WS_PG), (float*)(ws + WS_ALOW)};
                    pg8::gemm_phase<pg8::EpiGlaIn, pg8::StaticOrder, PG8_ALIGN, PG8_SP2>(F.lds + RING_OFF, g, S, E, RS + (size_t)(3 * i + 1) * 4 * M, rstab);
                } else {
                    pg8::Gemm g{(const bf16*)(ws + WS_XN), (const bf16*)(wb + WB_IN), M, PM, DM, DM, DM}; pg8::StaticOrder S; S.init(M, PM, F.G, (int)blockIdx.x, REV_IN);
                    pg8::EpiBf16<true> E{(bf16*)(ws + WS_PM), PM, 0x7fffffff};
                    pg8::gemm_phase<pg8::EpiBf16<true>, pg8::StaticOrder, PG8_ALIGN, PG8_SP2>(F.lds + RING_OFF, g, S, E, RS + (size_t)(3 * i + 1) * 4 * M, rstab);
                }
                if (rep_ + 1 == NREP(pb + 1)) SEAM(pb + 1);
            }
            if (gla) {
                if (IN(pb + 2)) { REP(pb + 2) { ph_gla_prep(F, args.in[17] + (size_t)j * 16 * 512, args.in[18] + j * 512, DRY(pb + 2)); ph_memattn(F, i, true, args.in[14] + i * 128, args.in[15] + i * 128, DRY(pb + 2)); } SEAM(pb + 2); }
                if (IN(pb + 3)) { REP(pb + 3) ph_gla_u(F); SEAM(pb + 3); }
                if (IN(pb + 4)) { REP(pb + 4) ph_gla_scan(F, DRY(pb + 4)); SEAM(pb + 4); }
                if (IN(pb + 5)) { REP(pb + 5) ph_gla_out(F, args.in[19] + j * 256, DRY(pb + 5)); SEAM(pb + 5); }
            }
            if (IN(pb + 2) && !gla) { REP(pb + 2) { ph_mla_rowprep(F, args.in[21] + j * 384, args.in[22] + j * 256, args.in[28] + j * 64, DRY(pb + 2)); ph_memattn(F, i, false, args.in[14] + i * 128, args.in[15] + i * 128, DRY(pb + 2)); } SEAM(pb + 2); }
            if (IN(pb + 3) && !gla) REP(pb + 3) {
                { pg8::Gemm g{(const bf16*)(ws + WS_PM) + PM_CQ, (const bf16*)(wb + WB_UQ), M, QW, 384, PM, 384}; pg8::StaticOrder S; S.init(M, QW, F.G, (int)blockIdx.x);
                  pg8::EpiBf16<false> E{(bf16*)(ws + WS_Q), QW, 0x7fffffff};
                  pg8::gemm_phase<pg8::EpiBf16<false>, pg8::StaticOrder, PG8_ALIGN, PG8_SP2>(F.lds + RING_OFF, g, S, E); }
                { pg8::Gemm g{(const bf16*)(ws + WS_PM) + PM_CKV, (const bf16*)(wb + WB_UKV), M, KVW, 256, PM, 256}; pg8::StaticOrder S; S.init(M, KVW, F.G, (int)blockIdx.x);
                  pg8::EpiBf16<false> E{(bf16*)(ws + WS_KV), KVW, 0x7fffffff};
                  pg8::gemm_phase<pg8::EpiBf16<false>, pg8::StaticOrder, PG8_ALIGN, PG8_SP2>(F.lds + RING_OFF, g, S, E); }
                if (rep_ + 1 == NREP(pb + 3)) SEAM(pb + 3);
            }
            if (IN(pb + 4) && !gla) { REP(pb + 4) ph_mla_knorm(F, args.in[27] + j * 128, DRY(pb + 4)); SEAM(pb + 4); }
            if (IN(pb + 5) && !gla) { REP(pb + 5) ph_mla_attn(F, args.in[25] + j * 128, args.in[26] + j * 64, args.in[27] + j * 128, args.in[28] + j * 64, DRY(pb + 5)); SEAM(pb + 5); }
            if (IN(pb + 6)) {
                pg8::Gemm g{gla ? (const bf16*)(ws + WS_PG) + PG_V : (const bf16*)F.OC, (const bf16*)(wb + WB_WO), M, DM, 1536, gla ? PG : OCW, 1536};
                pg8::StaticOrder S; S.init(M, DM, F.G, (int)blockIdx.x, REV_OUT);
                REP(pb + 6) { pg8::EpiResid E{(bf16*)(ws + WS_XN), nullptr, RS + (size_t)(3 * i + 2) * 4 * M, rspart, DM, rep_ ? 0.0f : 1.0f};
                pg8::gemm_phase<pg8::EpiResid, pg8::StaticOrder, PG8_ALIGN, PG8_SP2>(F.lds + RING_OFF, g, S, E); }
                SEAM(pb + 6);
            }
        }
        if (IN(pb + 7) && !half && it > 0) { REP(pb + 7) CONV(i); SEAM(pb + 7); }
        if (IN(pb + 9)) {
            pg8::Gemm g{(const bf16*)(ws + WS_XN), (const bf16*)(wb + (half ? WB_GU1 : WB_GU0)), M, 2 * FF, DM, DM, DM}; pg8::StaticOrder S; S.init(M, 2 * FF, F.G, (int)blockIdx.x, REV_GU);
            pg8::EpiSwiGLU E{(bf16*)(ws + WS_H), FF};
#ifndef DN_SKIP
#define DN_SKIP 0
#endif
#ifdef GU_PK
#ifndef GU_SKIP
#define GU_SKIP 0
#endif
            REP(pb + 9) { pg8::Gemm g2 = g; if (DRY(pb + 9)) g2.K = GU_PK; pg8::gemm_phase<pg8::EpiSwiGLU, pg8::StaticOrder, GU_ALIGN, PG8_SP2>(F.lds + RING_OFF, g2, S, E, RS + (size_t)(3 * i + (half ? 2 : 0)) * 4 * M, rstab, GU_SKIP && DRY(pb + 9)); }
#else
            REP(pb + 9) pg8::gemm_phase<pg8::EpiSwiGLU, pg8::StaticOrder, GU_ALIGN, PG8_SP2>(F.lds + RING_OFF, g, S, E, RS + (size_t)(3 * i + (half ? 2 : 0)) * 4 * M, rstab);
#endif
            SEAM(pb + 9);
        }
        if (IN(pb + 10)) {
            pg8::Gemm g{(const bf16*)(ws + WS_H), (const bf16*)(wb + (half ? WB_D1 : WB_D0)), M, DM, FF, FF, FF}; pg8::StaticOrder S; S.init(M, DM, F.G, (int)blockIdx.x, REV_DOWN);
            const bool lastp = (it == 7);
            REP(pb + 10) { pg8::EpiResid E{(bf16*)(ws + WS_XN), lastp ? F.X : nullptr, RS + (size_t)(half ? 3 * (i + 1) : 3 * i + 1) * 4 * M, rspart, DM, rep_ ? 0.0f : 0.5f};
            pg8::gemm_phase<pg8::EpiResid, pg8::StaticOrder, PG8_ALIGN, PG8_SP2>(F.lds + RING_OFF, g, S, E, nullptr, nullptr, DN_SKIP && rep_ > 0); }
            SEAM(pb + 10);
        }
    }
#undef OPQ
#undef CONV
#undef IN
#undef SEAM
}
#ifndef FAST_GLA
#define FAST_GLA 0
#endif
#ifndef FAST_MLA_PREP
#define FAST_MLA_PREP 0
#endif
#ifndef FAST_MLA_ATT
#define FAST_MLA_ATT 0
#endif
extern "C" void kernel_launch(void* const* d_in, const int* in_sizes, int n_in, void* d_out, int out_size, void* d_ws, size_t ws_size, hipStream_t stream) {
    static int grid = 0;
    if (grid == 0) {
        if (n_in != 29 || out_size != M * DM || ws_size < WS_END) { fprintf(stderr, "kernel_launch: unexpected shapes (n_in %d out %d ws %zu)\n", n_in, out_size, ws_size); grid = -1; return; }
        int dev = 0, cus = 0, per_cu = 0;
        if (hipGetDevice(&dev) != hipSuccess || hipDeviceGetAttribute(&cus, hipDeviceAttributeMultiprocessorCount, dev) != hipSuccess) { grid = -1; return; }
        if (hipFuncSetAttribute((const void*)mk_fwd, hipFuncAttributeMaxDynamicSharedMemorySize, LDS_BYTES) != hipSuccess) { fprintf(stderr, "kernel_launch: hipFuncSetAttribute failed\n"); grid = -1; return; }
        if (hipOccupancyMaxActiveBlocksPerMultiprocessor(&per_cu, (const void*)mk_fwd, NWAVES * 64, LDS_BYTES) != hipSuccess || per_cu < 1)
            fprintf(stderr, "kernel_launch: note: occupancy query reports %d workgroups per CU\n", per_cu);
        (void)hipGetLastError();
        grid = cus;
    }
    if (grid < 0) return;
    const float* mem = (const float*)d_in[1]; (void)mem;
    const float* memq_norm = (const float*)d_in[14];
    const float* gla_w_alpha = (const float*)d_in[17]; const float* gla_b_alpha = (const float*)d_in[18]; const float* gla_out_norm = (const float*)d_in[19];
    const float* mla_q_norm = (const float*)d_in[21]; const float* mla_kv_norm = (const float*)d_in[22];
    const float* mla_qn = (const float*)d_in[25]; const float* mla_qr = (const float*)d_in[26]; const float* mla_kn = (const float*)d_in[27]; const float* mla_kr = (const float*)d_in[28];
    unsigned char* ws = (unsigned char*)d_ws;
    float* ROPE = (float*)(ws + WS_ROPE); bf16* MEMKV = (bf16*)(ws + WS_MEMKV); float* ALOW = (float*)(ws + WS_ALOW);
    bf16* KR = (bf16*)(ws + WS_KR); bf16* PGb = (bf16*)(ws + WS_PG); float* ALPHA = (float*)(ws + WS_US);
    bf16* OC = (bf16*)d_out; bf16* PMb = (bf16*)(ws + WS_PM); bf16* Qb = (bf16*)(ws + WS_Q); bf16* KVb = (bf16*)(ws + WS_KV);

    (void)hipMemsetAsync(ws + WS_CTL, 0, CTL_ZERO_BYTES, stream);
    MArgs a{};
    for (int k = 0; k < 29; ++k) a.in[k] = (const float*)d_in[k];
    a.out = (float*)d_out; a.ws = ws;
    int region = 0;
    auto mk = [&](int lo, int hi) { if (lo >= hi) return; a.lo = lo; a.hi = hi; a.region = region++; a.pad = 0; hipLaunchKernelGGL(mk_fwd, dim3(grid), dim3(NWAVES * 64), LDS_BYTES, stream, a); };
    int cur_lo = 0;
    for (int it = 1; it < 8; it += 2) {
        const int pb = 16 * (it + 1), i = it >> 1, j = i >> 1; const bool gla = !(i & 1);
        const bf16* memkv = MEMKV + (size_t)i * 1024 * 1024;
        if (gla) {
            if (!FAST_GLA) {
                mk(cur_lo, pb + 2);
                nv_gla_alpha<<<M * 512 / 256, 256, 0, stream>>>(ALOW, gla_w_alpha + (size_t)j * 16 * 512, gla_b_alpha + j * 512, ALPHA);
                nv_attn<128, false><<<dim3(SEQ / 64, 4, BATCH), 64, 0, stream>>>(PGb + PG_QM, PG, 128, memkv, 1024, 128, nullptr, 0, memkv + 512, 1024, 128, PGb + PG_QM, PG, 128, 4, SEQ, NMEM, 0.08838834764831845f, memq_norm + i * 128);
                nv_gla_rec<<<16, 256, 0, stream>>>(PGb, ALPHA, gla_out_norm + j * 256);
                cur_lo = pb + 6;
            }
        } else {
            if (!FAST_MLA_PREP) {
                mk(cur_lo, pb + 2);
                nv_attn<128, false><<<dim3(SEQ / 64, 4, BATCH), 64, 0, stream>>>(PMb + PM_QM, PM, 128, memkv, 1024, 128, nullptr, 0, memkv + 512, 1024, 128, OC + 1024, OCW, 128, 4, SEQ, NMEM, 0.08838834764831845f, memq_norm + i * 128);
                nv_mla_rowprep<<<M / 4, 256, 0, stream>>>(PMb, mla_q_norm + j * 384, mla_kv_norm + j * 256, mla_kr + j * 64, ROPE, KR);
                cur_lo = pb + 3;
            }
            if (!FAST_MLA_ATT) {
                mk(cur_lo, pb + 4);
                nv_mla_headprep<<<M * 8 / 4, 256, 0, stream>>>(Qb, KVb, mla_qn + j * 128, mla_qr + j * 64, mla_kn + j * 128, ROPE);
                nv_attn<192, true><<<dim3(SEQ / 64, 8, BATCH), 64, 0, stream>>>(Qb, QW, 192, KVb, KVW, 256, KR, 64, KVb + 128, KVW, 256, OC, OCW, 128, 8, SEQ, SEQ, 0.07216878364870322f, nullptr);
                cur_lo = pb + 6;
            }
        }
    }
    mk(cur_lo, PID_END);
}
```

```cpp
#define FAST_GLA 1
#define FAST_MLA_PREP 1
#define FAST_MLA_ATT 1
#include <hip/hip_runtime.h>
#include <cstdio>
#include <cstdint>

typedef unsigned short bf16;
typedef short bf16x8 __attribute__((ext_vector_type(8)));
typedef float f32x4 __attribute__((ext_vector_type(4)));

constexpr int BATCH = 4, SEQ = 8192, DM = 1024, DEPTH = 4, NMEM = 256, FF = 2816;
constexpr int M = BATCH * SEQ;
constexpr float EPS = 1e-6f;
constexpr int GLA_IN = 3600, MLA_IN = 1216;
constexpr int PG = 3584;
constexpr int PG_Q = 0, PG_K = 512, PG_R = 1024, PG_V = 2048, PG_QM = 3072;
constexpr int PM = 1280;
constexpr int PM_CQ = 0, PM_CKV = 384, PM_KR = 640, PM_QM = 704;
constexpr int QW = 1536, KVW = 2048, OCW = 1536;

constexpr size_t MiB = 1u << 20;
constexpr size_t WS_CTL = 0;
constexpr size_t WS_ROPE = 28 * MiB;
constexpr size_t WS_MEMKV = 3 * MiB;
constexpr size_t WS_MEMH = 11 * MiB;
constexpr size_t WS_ALOW = 19 * MiB;
constexpr size_t WS_GV = 21 * MiB;
constexpr size_t WS_KR = 24 * MiB;
constexpr size_t WS_WB = 32 * MiB;
constexpr size_t WS_XN = 84 * MiB;
constexpr size_t WS_BIG = 148 * MiB;
constexpr size_t WS_H = WS_BIG;
constexpr size_t WS_PG = WS_BIG;
constexpr size_t WS_US = 372 * MiB;
constexpr size_t WS_PM = 180 * MiB;
constexpr size_t WS_Q = 260 * MiB;
constexpr size_t WS_KV = 356 * MiB;
constexpr size_t WS_END = 500 * MiB;

__device__ __forceinline__ float bf2f(bf16 b) { return __uint_as_float(((unsigned)b) << 16); }
__device__ __forceinline__ bf16 f2bf(float f) { unsigned u = __float_as_uint(f); return (bf16)((u + 0x7fffu + ((u >> 16) & 1u)) >> 16); }
__device__ __forceinline__ float wave_sum(float v) {
#pragma unroll
    for (int o = 1; o < 64; o <<= 1) v += __shfl_xor(v, o);
    return v;
}
__device__ __forceinline__ float silu_f(float x) { return x / (1.f + __expf(-x)); }

struct ColMap { int t0, a0, t1, a1, t2, a2, a3, nvalid; };
__device__ __forceinline__ int cm_src(const ColMap& c, int n) { return n + (n < c.t0 ? c.a0 : n < c.t1 ? c.a1 : n < c.t2 ? c.a2 : c.a3); }
static ColMap cm_identity(int nvalid) { ColMap c; c.t0 = 1 << 30; c.a0 = 0; c.t1 = 1 << 30; c.a1 = 0; c.t2 = 1 << 30; c.a2 = 0; c.a3 = 0; c.nvalid = nvalid; return c; }

template <int EPI>
__global__ __launch_bounds__(256) void nv_gemm(const bf16* __restrict__ A, int lda, const float* __restrict__ W, const float* __restrict__ W2, int ldw, ColMap cm,
                                               int K, void* Cv, int ldc, float scale, int nstore) {
    __shared__ __attribute__((aligned(16))) bf16 sA[64][40];
    __shared__ __attribute__((aligned(16))) bf16 sB[64][40];
    __shared__ __attribute__((aligned(16))) bf16 sB2[64][40];
    const int tid = threadIdx.x, lane = tid & 63, wid = tid >> 6;
    const int m0 = blockIdx.y * 64, n0 = blockIdx.x * 64;
    const int wm = (wid >> 1) * 32, wn = (wid & 1) * 32;
    f32x4 acc[2][2], acc2[2][2];
#pragma unroll
    for (int i = 0; i < 2; ++i)
#pragma unroll
        for (int j = 0; j < 2; ++j) { acc[i][j] = (f32x4){0.f, 0.f, 0.f, 0.f}; acc2[i][j] = (f32x4){0.f, 0.f, 0.f, 0.f}; }
    const int ar = tid >> 2, ac = (tid & 3) * 8;
    const int bk = tid >> 3, bn = (tid & 7) * 8;
    const int ncol = n0 + bn; const bool nval = ncol < cm.nvalid; const int src = cm_src(cm, ncol);
    for (int k0 = 0; k0 < K; k0 += 32) {
        const bf16x8 av = *(const bf16x8*)(A + (size_t)(m0 + ar) * lda + k0 + ac);
        f32x4 w0 = (f32x4){0.f, 0.f, 0.f, 0.f}, w1 = w0, u0 = w0, u1 = w0;
        if (nval) { const float* wp = W + (size_t)(k0 + bk) * ldw + src; w0 = *(const f32x4*)wp; w1 = *(const f32x4*)(wp + 4);
            if (EPI == 1) { const float* up = W2 + (size_t)(k0 + bk) * ldw + src; u0 = *(const f32x4*)up; u1 = *(const f32x4*)(up + 4); } }
        *(bf16x8*)&sA[ar][ac] = av;
#pragma unroll
        for (int j = 0; j < 4; ++j) { sB[bn + j][bk] = f2bf(w0[j]); sB[bn + 4 + j][bk] = f2bf(w1[j]); }
        if (EPI == 1) {
#pragma unroll
            for (int j = 0; j < 4; ++j) { sB2[bn + j][bk] = f2bf(u0[j]); sB2[bn + 4 + j][bk] = f2bf(u1[j]); } }
        __syncthreads();
        bf16x8 a[2], b[2], b2[2];
#pragma unroll
        for (int i = 0; i < 2; ++i) { a[i] = *(const bf16x8*)&sA[wm + i * 16 + (lane & 15)][(lane >> 4) * 8]; b[i] = *(const bf16x8*)&sB[wn + i * 16 + (lane & 15)][(lane >> 4) * 8];
            if (EPI == 1) b2[i] = *(const bf16x8*)&sB2[wn + i * 16 + (lane & 15)][(lane >> 4) * 8]; }
#pragma unroll
        for (int i = 0; i < 2; ++i)
#pragma unroll
            for (int j = 0; j < 2; ++j) { acc[i][j] = __builtin_amdgcn_mfma_f32_16x16x32_bf16(a[i], b[j], acc[i][j], 0, 0, 0);
                if (EPI == 1) acc2[i][j] = __builtin_amdgcn_mfma_f32_16x16x32_bf16(a[i], b2[j], acc2[i][j], 0, 0, 0); }
        __syncthreads();
    }
#pragma unroll
    for (int i = 0; i < 2; ++i)
#pragma unroll
        for (int j = 0; j < 2; ++j)
#pragma unroll
            for (int r = 0; r < 4; ++r) {
                const int row = m0 + wm + i * 16 + (lane >> 4) * 4 + r, col = n0 + wn + j * 16 + (lane & 15);
                const float v = acc[i][j][r];
                if (EPI == 0) ((bf16*)Cv)[(size_t)row * ldc + col] = f2bf(v);
                if (EPI == 1) ((bf16*)Cv)[(size_t)row * ldc + col] = f2bf(silu_f(v) * acc2[i][j][r]);
                if (EPI == 2) { float* p = (float*)Cv + (size_t)row * ldc + col; *p = *p + scale * v; }
                if (EPI == 3) { if (col < nstore) ((float*)Cv)[(size_t)row * ldc + col] = v; }
            }
}

__global__ __launch_bounds__(256) void nv_rmsnorm(const float* __restrict__ X, const float* __restrict__ g, bf16* __restrict__ out, int rows) {
    const int lane = threadIdx.x & 63, row = blockIdx.x * 4 + (threadIdx.x >> 6);
    if (row >= rows) return;
    const f32x4* xr = (const f32x4*)(X + (size_t)row * DM) + lane; f32x4 v[4]; float s = 0.f;
#pragma unroll
    for (int j = 0; j < 4; ++j) { v[j] = xr[64 * j]; s += v[j].x * v[j].x + v[j].y * v[j].y + v[j].z * v[j].z + v[j].w * v[j].w; }
    const float rstd = 1.0f / sqrtf(wave_sum(s) * (1.f / DM) + EPS);
#pragma unroll
    for (int j = 0; j < 4; ++j) { const f32x4 gg = ((const f32x4*)g)[lane + 64 * j]; bf16* o = out + (size_t)row * DM + (lane + 64 * j) * 4;
        o[0] = f2bf(v[j].x * rstd * gg.x); o[1] = f2bf(v[j].y * rstd * gg.y); o[2] = f2bf(v[j].z * rstd * gg.z); o[3] = f2bf(v[j].w * rstd * gg.w); }
}

__global__ void nv_rope_table(float* cs) {
    const int i = blockIdx.x * blockDim.x + threadIdx.x; if (i >= SEQ * 32) return;
    const int pos = i >> 5, f = i & 31;
    const float ex = (float)(2 * f) / 64.0f;
    const float inv = (float)(1.0 / pow(10000.0, (double)ex));
    const float ang = (float)pos * inv;
    cs[i] = (float)cos((double)ang); cs[SEQ * 32 + i] = (float)sin((double)ang);
}

__global__ __launch_bounds__(256) void nv_headnorm128(bf16* __restrict__ buf, int ld, int col0, int hstride, int nheads, const float* __restrict__ g, int rows) {
    const int lane = threadIdx.x & 63, idx = blockIdx.x * 4 + (threadIdx.x >> 6);
    if (idx >= rows * nheads) return;
    const int row = idx / nheads, h = idx % nheads;
    bf16* p = buf + (size_t)row * ld + col0 + h * hstride + lane * 2;
    const float a = bf2f(p[0]), b = bf2f(p[1]);
    const float rstd = 1.0f / sqrtf(wave_sum(a * a + b * b) * (1.f / 128.f) + EPS);
    p[0] = f2bf(a * rstd * g[lane * 2]); p[1] = f2bf(b * rstd * g[lane * 2 + 1]);
}

__global__ __launch_bounds__(256) void nv_mla_rowprep(bf16* __restrict__ P, const float* __restrict__ gq, const float* __restrict__ gkv, const float* __restrict__ gkr,
                                                      const float* __restrict__ rope, bf16* __restrict__ KR) {
    const int lane = threadIdx.x & 63, row = blockIdx.x * 4 + (threadIdx.x >> 6);
    bf16* p = P + (size_t)row * PM;
    float q[6]; float s = 0.f;
#pragma unroll
    for (int j = 0; j < 6; ++j) { q[j] = bf2f(p[PM_CQ + lane + 64 * j]); s += q[j] * q[j]; }
    float rstd = 1.0f / sqrtf(wave_sum(s) * (1.f / 384.f) + EPS);
#pragma unroll
    for (int j = 0; j < 6; ++j) p[PM_CQ + lane + 64 * j] = f2bf(q[j] * rstd * gq[lane + 64 * j]);
    float c[4]; s = 0.f;
#pragma unroll
    for (int j = 0; j < 4; ++j) { c[j] = bf2f(p[PM_CKV + lane + 64 * j]); s += c[j] * c[j]; }
    rstd = 1.0f / sqrtf(wave_sum(s) * (1.f / 256.f) + EPS);
#pragma unroll
    for (int j = 0; j < 4; ++j) p[PM_CKV + lane + 64 * j] = f2bf(c[j] * rstd * gkv[lane + 64 * j]);
    float k = bf2f(p[PM_KR + lane]);
    rstd = 1.0f / sqrtf(wave_sum(k * k) * (1.f / 64.f) + EPS);
    k = k * rstd * gkr[lane];
    const float other = __shfl_xor(k, 32);
    const int pos = row % SEQ, f = lane & 31;
    const float cs = rope[pos * 32 + f], sn = rope[SEQ * 32 + pos * 32 + f];
    const float o = lane < 32 ? (k * cs - other * sn) : (other * sn + k * cs);
    KR[(size_t)row * 64 + lane] = f2bf(o);
}

__global__ __launch_bounds__(256) void nv_mla_headprep(bf16* __restrict__ Q, bf16* __restrict__ KV, const float* __restrict__ gqn, const float* __restrict__ gqr, const float* __restrict__ gkn,
                                                       const float* __restrict__ rope) {
    const int lane = threadIdx.x & 63, idx = blockIdx.x * 4 + (threadIdx.x >> 6);
    const int row = idx >> 3, h = idx & 7;
    bf16* q = Q + (size_t)row * QW + h * 192;
    { const float a = bf2f(q[lane * 2]), b = bf2f(q[lane * 2 + 1]);
      const float rstd = 1.0f / sqrtf(wave_sum(a * a + b * b) * (1.f / 128.f) + EPS);
      q[lane * 2] = f2bf(a * rstd * gqn[lane * 2]); q[lane * 2 + 1] = f2bf(b * rstd * gqn[lane * 2 + 1]); }
    { float k = bf2f(q[128 + lane]);
      const float rstd = 1.0f / sqrtf(wave_sum(k * k) * (1.f / 64.f) + EPS);
      k = k * rstd * gqr[lane];
      const float other = __shfl_xor(k, 32);
      const int pos = row % SEQ, f = lane & 31;
      const float cs = rope[pos * 32 + f], sn = rope[SEQ * 32 + pos * 32 + f];
      q[128 + lane] = f2bf(lane < 32 ? (k * cs - other * sn) : (other * sn + k * cs)); }
    bf16* kk = KV + (size_t)row * KVW + h * 256;
    { const float a = bf2f(kk[lane * 2]), b = bf2f(kk[lane * 2 + 1]);
      const float rstd = 1.0f / sqrtf(wave_sum(a * a + b * b) * (1.f / 128.f) + EPS);
      kk[lane * 2] = f2bf(a * rstd * gkn[lane * 2]); kk[lane * 2 + 1] = f2bf(b * rstd * gkn[lane * 2 + 1]); }
}

template <int DQK, bool CAUSAL>
__global__ __launch_bounds__(64) void nv_attn(const bf16* __restrict__ Q, int ldq, int qhs, const bf16* __restrict__ Kn, int ldkn, int knhs, const bf16* __restrict__ Kr, int ldkr,
                                              const bf16* __restrict__ V, int ldv, int vhs, bf16* __restrict__ O, int ldo, int ohs, int nheads, int sq, int skv, float scale, const float* __restrict__ qgain) {
    __shared__ float sQ[64][DQK + 1];
    const int lane = threadIdx.x;
    const int qb = blockIdx.x, h = blockIdx.y, b = blockIdx.z;
    const int q0 = qb * 64;
    const size_t qrow = (size_t)b * sq + q0 + lane;
    { const bf16* qp = Q + qrow * ldq + h * qhs; float s = 0.f;
      for (int d = 0; d < DQK; ++d) { const float v = bf2f(qp[d]); sQ[lane][d] = v; s += v * v; }
      if (qgain) { const float rstd = 1.0f / sqrtf(s * (1.f / DQK) + EPS); for (int d = 0; d < DQK; ++d) sQ[lane][d] = sQ[lane][d] * rstd * qgain[d]; } }
    float acc[128];
#pragma unroll
    for (int d = 0; d < 128; ++d) acc[d] = 0.f;
    float mx = -1e30f, l = 0.f;
    const int jend = CAUSAL ? (q0 + 64) : skv;
    for (int j = 0; j < jend; ++j) {
        const size_t krow = (size_t)b * skv + j;
        const bf16* kn = Kn + krow * ldkn + h * knhs;
        float s = 0.f;
#pragma unroll 8
        for (int d = 0; d < 128; ++d) s += sQ[lane][d] * bf2f(kn[d]);
        if (DQK > 128) { const bf16* kr = Kr + krow * ldkr;
#pragma unroll 8
            for (int d = 0; d < DQK - 128; ++d) s += sQ[lane][128 + d] * bf2f(kr[d]); }
        s *= scale;
        const bool ok = !CAUSAL || (j <= q0 + lane);
        if (ok) {
            const float mn = fmaxf(mx, s), al = __expf(mx - mn), p = __expf(s - mn);
            l = l * al + p; mx = mn;
            const bf16* vp = V + krow * ldv + h * vhs;
#pragma unroll
            for (int d = 0; d < 128; ++d) acc[d] = acc[d] * al + p * bf2f(vp[d]);
        }
    }
    const float inv = 1.0f / l;
    bf16* op = O + qrow * ldo + h * ohs;
#pragma unroll
    for (int d = 0; d < 128; ++d) op[d] = f2bf(acc[d] * inv);
}

__global__ __launch_bounds__(256) void nv_gla_alpha(const float* __restrict__ alow, const float* __restrict__ wa, const float* __restrict__ ba, float* __restrict__ alpha) {
    const size_t i = (size_t)blockIdx.x * 256 + threadIdx.x; const int m = (int)(i >> 9), c = (int)(i & 511);
    float z = ba[c];
#pragma unroll
    for (int r = 0; r < 16; ++r) z += alow[(size_t)m * 16 + r] * wa[r * 512 + c];
    const float ls = fminf(z, 0.f) - log1pf(expf(-fabsf(z)));
    alpha[i] = expf(ls * (1.f / 16.f));
}
__global__ __launch_bounds__(256) void nv_gla_rec(bf16* __restrict__ P, const float* __restrict__ alpha, const float* __restrict__ gout) {
    __shared__ float red[2][4];
    const int dv = threadIdx.x, h = blockIdx.x & 3, b = blockIdx.x >> 2, lane = dv & 63, wv = dv >> 6;
    float S[128];
#pragma unroll
    for (int d = 0; d < 128; ++d) S[d] = 0.f;
    const float g = gout[dv];
    const float scale = 0.08838834764831845f;
    for (int t = 0; t < SEQ; ++t) {
        const size_t row = (size_t)b * SEQ + t;
        bf16* p = P + row * PG;
        const bf16* q = p + PG_Q + h * 128; const bf16* k = p + PG_K + h * 128; const float* al = alpha + row * 512 + h * 128;
        const float v = bf2f(p[PG_V + h * 256 + dv]);
        float o = 0.f;
#pragma unroll
        for (int d = 0; d < 128; ++d) { S[d] = al[d] * S[d] + bf2f(k[d]) * v; o += bf2f(q[d]) * S[d]; }
        o *= scale;
        float ss = wave_sum(o * o);
        if (lane == 0) red[t & 1][wv] = ss;
        __syncthreads();
        ss = red[t & 1][0] + red[t & 1][1] + red[t & 1][2] + red[t & 1][3];
        const float rstd = 1.0f / sqrtf(ss * (1.f / 256.f) + EPS);
        const float r = bf2f(p[PG_R + h * 256 + dv]);
        p[PG_V + h * 256 + dv] = f2bf(o * rstd * g * silu_f(r));
    }
}

#define LAS __attribute__((address_space(3)))
#define GAS __attribute__((address_space(1)))
typedef unsigned u32x4 __attribute__((ext_vector_type(4)));
typedef unsigned u32x2 __attribute__((ext_vector_type(2)));
typedef float f32x2 __attribute__((ext_vector_type(2)));
typedef GAS unsigned gu32;
#define RLX_AGENT __ATOMIC_RELAXED, __HIP_MEMORY_SCOPE_AGENT
#define LDS_WAIT() asm volatile("s_waitcnt lgkmcnt(0)" ::: "memory")
#define VM_WAIT() asm volatile("s_waitcnt vmcnt(0)" ::: "memory")
__device__ __forceinline__ unsigned cvt_pk_bf16(float lo, float hi) { unsigned r; asm volatile("v_cvt_pk_bf16_f32 %0, %1, %2" : "=v"(r) : "v"(lo), "v"(hi)); return r; }
__device__ __forceinline__ float fast_silu(float x) { return x * __builtin_amdgcn_rcpf(1.0f + __builtin_amdgcn_exp2f(-1.4426950408889634f * x)); }

namespace pg8 {
constexpr int BM = 256, BK = 64, HALF = 128, HTB = HALF * BK * 2  , STAGE_BYTES = 8 * HTB, NXCD = 8, WGM = 8;
__host__ __device__ __forceinline__ int lds_byte(int r, int c) { const int st = (r >> 4) * 2 + (c >> 5), rr = r & 15, cc = c & 31, ob = rr * 64 + cc * 2; return st * 1024 + (ob ^ (((ob >> 9) & 1) << 5)); }
__host__ __device__ __forceinline__ void stage_rc(int b, int& R, int& C) { const int st = b / 1024, sb = b % 1024, swz = sb ^ (((sb >> 9) & 1) << 5); R = (st >> 1) * 16 + swz / 64; C = (st & 1) * 32 + (swz % 64) / 2; }
__host__ __device__ __forceinline__ int perm32(int rho) { const int n = rho >> 4, i = rho & 15; return 8 * (i >> 2) + 4 * n + (i & 3); }

struct Unit { int pm, pn; };
struct Gemm { const bf16* A; const bf16* Bt; int M, N, K, lda, ldb; };

struct StaticOrder {
    int nM, nN, nwg, G, c, rev;
    __device__ void init(int M_, int N_, int G_, int c_, int rev_ = 0) { nM = M_ / BM; nN = N_ / BM; nwg = nM * nN; G = G_; c = c_; rev = rev_; }
    __device__ bool next(int i, Unit& u) const {
        const int R = (nwg - c + G - 1) / G;
        if (i >= R) return false;
        const long L = (long)(rev ? R - 1 - i : i) * G + c;
        int wgid = (int)L; { const int q = nwg / NXCD, r = nwg % NXCD, xcd = wgid % NXCD, off = wgid / NXCD; wgid = (xcd < r ? xcd * (q + 1) : r * (q + 1) + (xcd - r) * q) + off; }
        const int nig = WGM * nN, gid = wgid / nig, fm = gid * WGM, gsz = (nM - fm) < WGM ? (nM - fm) : WGM;
        u.pm = fm + ((wgid % nig) % gsz); u.pn = (wgid % nig) / gsz; return true;
    }
};
struct DiagOrder {
    int G, c, nb;
    __device__ bool next(int i, Unit& u) const { const int L = i * G + c; if (L >= nb * 16) return false; const int blk = L >> 4, r = L & 15; u.pm = blk * 4 + (r >> 2); u.pn = blk * 4 + (r & 3); return true; }
};

__device__ __forceinline__ float rstd_of(float ss) { return __builtin_amdgcn_rsqf(ss * (1.f / 1024.f) + EPS); }
#ifndef RS_DIRECT
#define RS_DIRECT 0
#endif
#if RS_DIRECT
#define TABV(idx) ({ const f32x4 t_ = *(const f32x4*)(rsg + (idx) * 4); (t_.x + t_.y) + (t_.z + t_.w); })
#else
#define TABV(idx) ({ const f32x4 t_ = *(const LAS f32x4*)(tab + (idx) * 4); (t_.x + t_.y) + (t_.z + t_.w); })
#endif
template <bool RS> struct EpiBf16 {
    static constexpr bool PERM = true, USE_RS = RS;
    bf16* O; int ldc; int pn_mask;
    __device__ __forceinline__ void operator()(const f32x4 (&acc)[2][2][4][2], const Unit& u, int wr, int wc, int fr, int fq, const LAS float* tab, const float* rsg) const {
        const int row0 = u.pm * BM + wr * 64 + fr, col0 = (u.pn & pn_mask) * BM + wc * 32 + 8 * fq;
#pragma unroll
        for (int ai = 0; ai < 2; ++ai)
#pragma unroll
            for (int m = 0; m < 4; ++m) { bf16* rowp = O + (size_t)(row0 + ai * HALF + m * 16) * ldc + col0;
                const float rs = RS ? rstd_of(TABV(ai * HALF + wr * 64 + m * 16 + fr)) : 1.f;
#pragma unroll
                for (int bj = 0; bj < 2; ++bj) { const f32x4 v0 = acc[ai][bj][m][0] * rs, v1 = acc[ai][bj][m][1] * rs;
                    u32x4 w; w.x = cvt_pk_bf16(v0[0], v0[1]); w.y = cvt_pk_bf16(v0[2], v0[3]); w.z = cvt_pk_bf16(v1[0], v1[1]); w.w = cvt_pk_bf16(v1[2], v1[3]);
                    *(u32x4*)(rowp + bj * HALF) = w; } }
    }
};
struct EpiGlaIn {
    static constexpr bool PERM = true, USE_RS = true;
    bf16* O; float* alow;
    __device__ __forceinline__ void operator()(const f32x4 (&acc)[2][2][4][2], const Unit& u, int wr, int wc, int fr, int fq, const LAS float* tab, const float* rsg) const {
        const int row0 = u.pm * BM + wr * 64 + fr;
        if (u.pn == 14) {
            if (wc == 0 && fq < 2) {
#pragma unroll
                for (int ai = 0; ai < 2; ++ai)
#pragma unroll
                    for (int m = 0; m < 4; ++m) { const float rs = rstd_of(TABV(ai * HALF + wr * 64 + m * 16 + fr)); float* ap = alow + (size_t)(row0 + ai * HALF + m * 16) * 16 + 8 * fq;
                        *(f32x4*)ap = acc[ai][0][m][0] * rs; *(f32x4*)(ap + 4) = acc[ai][0][m][1] * rs; } }
            return;
        }
        const int col0 = u.pn * BM + wc * 32 + 8 * fq;
#pragma unroll
        for (int ai = 0; ai < 2; ++ai)
#pragma unroll
            for (int m = 0; m < 4; ++m) { bf16* rowp = O + (size_t)(row0 + ai * HALF + m * 16) * PG + col0;
                const float rs = rstd_of(TABV(ai * HALF + wr * 64 + m * 16 + fr));
#pragma unroll
                for (int bj = 0; bj < 2; ++bj) { const f32x4 v0 = acc[ai][bj][m][0] * rs, v1 = acc[ai][bj][m][1] * rs;
                    u32x4 w; w.x = cvt_pk_bf16(v0[0], v0[1]); w.y = cvt_pk_bf16(v0[2], v0[3]); w.z = cvt_pk_bf16(v1[0], v1[1]); w.w = cvt_pk_bf16(v1[2], v1[3]);
                    *(u32x4*)(rowp + bj * HALF) = w; } }
    }
};
struct EpiSwiGLU {
    static constexpr bool PERM = true, USE_RS = true;
    bf16* O; int ldc;
    __device__ __forceinline__ void operator()(const f32x4 (&acc)[2][2][4][2], const Unit& u, int wr, int wc, int fr, int fq, const LAS float* tab, const float* rsg) const {
        const int row0 = u.pm * BM + wr * 64 + fr, col0 = u.pn * HALF + wc * 32 + 8 * fq;
        float ss[2][4];
#pragma unroll
        for (int ai = 0; ai < 2; ++ai)
#pragma unroll
            for (int m = 0; m < 4; ++m) ss[ai][m] = TABV(ai * HALF + wr * 64 + m * 16 + fr);
#pragma unroll
        for (int ai = 0; ai < 2; ++ai)
#pragma unroll
            for (int m = 0; m < 4; ++m) { bf16* rowp = O + (size_t)(row0 + ai * HALF + m * 16) * ldc + col0;
                const float v = ss[ai][m] * (1.f / 1024.f) + EPS, c = -1.4426950408889634f * __builtin_amdgcn_rsqf(v);
                float h[8], e[8];
#pragma unroll
                for (int k = 0; k < 8; ++k) e[k] = acc[ai][0][m][k >> 2][k & 3] * c;
#pragma unroll
                for (int k = 0; k < 8; ++k) h[k] = acc[ai][0][m][k >> 2][k & 3] * acc[ai][1][m][k >> 2][k & 3];
                __builtin_amdgcn_sched_barrier(0);
#pragma unroll
                for (int k = 0; k < 8; ++k) e[k] = __builtin_amdgcn_exp2f(e[k]);
                __builtin_amdgcn_sched_barrier(0);
#pragma unroll
                for (int k = 0; k < 8; ++k) e[k] = __builtin_fmaf(e[k], v, v);
                __builtin_amdgcn_sched_barrier(0);
#pragma unroll
                for (int k = 0; k < 8; ++k) e[k] = __builtin_amdgcn_rcpf(e[k]);
                __builtin_amdgcn_sched_barrier(0);
#pragma unroll
                for (int k = 0; k < 8; ++k) h[k] *= e[k];
                u32x4 w; w.x = cvt_pk_bf16(h[0], h[1]); w.y = cvt_pk_bf16(h[2], h[3]); w.z = cvt_pk_bf16(h[4], h[5]); w.w = cvt_pk_bf16(h[6], h[7]);
                *(u32x4*)rowp = w; }
    }
};
struct EpiKV {
    static constexpr bool PERM = true, USE_RS = false;
    bf16* O; int ldc; const float* gkn; LAS float* part;
    __device__ __forceinline__ void operator()(const f32x4 (&acc)[2][2][4][2], const Unit& u, int wr, int wc, int fr, int fq, const LAS float*, const float*) const {
        const int row0 = u.pm * BM + wr * 64 + fr, col0 = u.pn * BM + wc * 32 + 8 * fq;
#pragma unroll
        for (int ai = 0; ai < 2; ++ai)
#pragma unroll
            for (int m = 0; m < 4; ++m) { const f32x4 a = acc[ai][0][m][0], b = acc[ai][0][m][1];
                float ss = ((a[0] * a[0] + a[1] * a[1]) + (a[2] * a[2] + a[3] * a[3])) + ((b[0] * b[0] + b[1] * b[1]) + (b[2] * b[2] + b[3] * b[3]));
                ss += __shfl_xor(ss, 16); ss += __shfl_xor(ss, 32);
                if (fq == 0) part[(ai * HALF + wr * 64 + m * 16 + fr) * 4 + wc] = ss; }
        asm volatile("s_waitcnt lgkmcnt(0)" ::: "memory"); __builtin_amdgcn_s_barrier(); asm volatile("" ::: "memory");
        const f32x4 g0 = *(const f32x4*)(gkn + wc * 32 + 8 * fq), g1 = *(const f32x4*)(gkn + wc * 32 + 8 * fq + 4);
#pragma unroll
        for (int ai = 0; ai < 2; ++ai)
#pragma unroll
            for (int m = 0; m < 4; ++m) { bf16* rowp = O + (size_t)(row0 + ai * HALF + m * 16) * ldc + col0;
                const f32x4 pp = *(const LAS f32x4*)(part + (ai * HALF + wr * 64 + m * 16 + fr) * 4);
                const float rs = __builtin_amdgcn_rsqf(((pp.x + pp.y) + (pp.z + pp.w)) * (1.f / 128.f) + EPS);
                { const f32x4 v0 = acc[ai][0][m][0] * rs * g0, v1 = acc[ai][0][m][1] * rs * g1;
                  u32x4 w; w.x = cvt_pk_bf16(v0[0], v0[1]); w.y = cvt_pk_bf16(v0[2], v0[3]); w.z = cvt_pk_bf16(v1[0], v1[1]); w.w = cvt_pk_bf16(v1[2], v1[3]); *(u32x4*)rowp = w; }
                { const f32x4 v0 = acc[ai][1][m][0], v1 = acc[ai][1][m][1];
                  u32x4 w; w.x = cvt_pk_bf16(v0[0], v0[1]); w.y = cvt_pk_bf16(v0[2], v0[3]); w.z = cvt_pk_bf16(v1[0], v1[1]); w.w = cvt_pk_bf16(v1[2], v1[3]); *(u32x4*)(rowp + HALF) = w; } }
    }
};
struct EpiResid {
    static constexpr bool PERM = true, USE_RS = false;
    bf16* XB; float* OUT; float* RS4; LAS float* part; int ldc; float scale;
    __device__ __forceinline__ void operator()(const f32x4 (&acc)[2][2][4][2], const Unit& u, int wr, int wc, int fr, int fq, const LAS float*, const float*) const {
        const int row0 = u.pm * BM + wr * 64 + fr, col0 = u.pn * BM + wc * 32 + 8 * fq;
#pragma unroll
        for (int ai = 0; ai < 2; ++ai) {
            const size_t off = (size_t)(row0 + ai * HALF) * ldc + col0;
            u32x4 xv[4][2];
#pragma unroll
            for (int m = 0; m < 4; ++m)
#pragma unroll
                for (int bj = 0; bj < 2; ++bj) xv[m][bj] = *(const u32x4*)(XB + off + (size_t)(m * 16) * ldc + bj * HALF);
#pragma unroll
            for (int m = 0; m < 4; ++m) { float ss = 0.f;
#pragma unroll
                for (int bj = 0; bj < 2; ++bj) { const u32x4 w = xv[m][bj]; const size_t o2 = off + (size_t)(m * 16) * ldc + bj * HALF;
                    f32x4 n0, n1;
                    n0[0] = __uint_as_float(w.x << 16) + acc[ai][bj][m][0][0] * scale; n0[1] = __uint_as_float(w.x & 0xffff0000u) + acc[ai][bj][m][0][1] * scale;
                    n0[2] = __uint_as_float(w.y << 16) + acc[ai][bj][m][0][2] * scale; n0[3] = __uint_as_float(w.y & 0xffff0000u) + acc[ai][bj][m][0][3] * scale;
                    n1[0] = __uint_as_float(w.z << 16) + acc[ai][bj][m][1][0] * scale; n1[1] = __uint_as_float(w.z & 0xffff0000u) + acc[ai][bj][m][1][1] * scale;
                    n1[2] = __uint_as_float(w.w << 16) + acc[ai][bj][m][1][2] * scale; n1[3] = __uint_as_float(w.w & 0xffff0000u) + acc[ai][bj][m][1][3] * scale;
                    if (OUT) { *(f32x4*)(OUT + o2) = n0; *(f32x4*)(OUT + o2 + 4) = n1; }
                    else { u32x4 o; o.x = cvt_pk_bf16(n0[0], n0[1]); o.y = cvt_pk_bf16(n0[2], n0[3]); o.z = cvt_pk_bf16(n1[0], n1[1]); o.w = cvt_pk_bf16(n1[2], n1[3]); *(u32x4*)(XB + o2) = o;
                        ss += ((n0[0] * n0[0] + n0[1] * n0[1]) + (n0[2] * n0[2] + n0[3] * n0[3])) + ((n1[0] * n1[0] + n1[1] * n1[1]) + (n1[2] * n1[2] + n1[3] * n1[3])); } }
                if (!OUT) { ss += __shfl_xor(ss, 16); ss += __shfl_xor(ss, 32); if (fq == 0) part[(ai * HALF + wr * 64 + m * 16 + fr) * 4 + wc] = ss; } }
            asm volatile("" ::: "memory"); }
        if (!OUT) {
            asm volatile("s_waitcnt lgkmcnt(0)" ::: "memory"); __builtin_amdgcn_s_barrier(); asm volatile("" ::: "memory");
            const int t = (wr * 4 + wc) * 64 + fq * 16 + fr;
            if (t < 256) { const f32x4 pp = *(const LAS f32x4*)(part + t * 4); RS4[((size_t)u.pm * BM + t) * 4 + u.pn] = (pp.x + pp.y) + (pp.z + pp.w); }
        }
    }
};

template <class Epi, class Sched, bool ALIGN_EPI = false, bool SP2 = false>
__device__ __forceinline__ void gemm_phase(LAS unsigned char* lds, const Gemm g, const Sched& S, const Epi& E, const float* rs = nullptr, LAS unsigned char* rstab = nullptr, const bool skip_epi = false) {
    int tid_ = threadIdx.x; asm volatile("" : "+v"(tid_));
    const int tid = tid_, wid = __builtin_amdgcn_readfirstlane(tid >> 6), lane = tid & 63, wr = wid >> 2, wc = wid & 3, fr = lane & 15, fq = lane >> 4;
    const int K = g.K, nt = K / BK, lda = g.lda, ldb = g.ldb;
    unsigned voffA[2], voffB[2];
#pragma unroll
    for (int i = 0; i < 2; ++i) { int R, C; stage_rc(tid * 16 + i * 8192, R, C); const int Rb = Epi::PERM ? ((R & ~31) + perm32(R & 31)) : R;
        voffA[i] = (unsigned)(R * lda + C) * 2u; voffB[i] = (unsigned)(Rb * ldb + C) * 2u; }
    const size_t kstep = (size_t)(BK * 2);
    const size_t hstepA = (size_t)HALF * lda * 2, hstepB = (size_t)HALF * ldb * 2;
    const size_t tstepA = 2 * hstepA, tstepB = 2 * hstepB;
    const unsigned ldsw = (unsigned)wid * 1024u;
    const int aoff = lds_byte(wr * 64 + fr, fq * 8), boff = lds_byte(wc * 32 + fr, fq * 8);
#define PG8_SA(b, h) (((b) * 2 + (h)) * HTB)
#define PG8_SB(b, h) ((4 + (b) * 2 + (h)) * HTB)
#define PG8_STAGE(bufoff, gbase, voff) do { _Pragma("unroll") for (int _i = 0; _i < 2; ++_i) \
        __builtin_amdgcn_global_load_lds((const unsigned*)((const char*)(gbase) + (voff)[_i]), (LAS unsigned*)(lds + (bufoff) + ldsw + _i * 8192), 16, 0, 0); } while (0)
#define PG8_LDA(dst, b, h) do { _Pragma("unroll") for (int m = 0; m < 4; ++m) _Pragma("unroll") for (int k = 0; k < 2; ++k) dst[m][k] = *(const LAS bf16x8*)(lds + PG8_SA(b, h) + aoff + m * 2048 + k * 1024); } while (0)
#define PG8_LDB(dst, b, h) do { _Pragma("unroll") for (int n = 0; n < 2; ++n) _Pragma("unroll") for (int k = 0; k < 2; ++k) dst[n][k] = *(const LAS bf16x8*)(lds + PG8_SB(b, h) + boff + n * 2048 + k * 1024); } while (0)
#define PG8_MMA(ai, bj, At, Bt) do { __builtin_amdgcn_s_setprio(1); _Pragma("unroll") for (int m = 0; m < 4; ++m) _Pragma("unroll") for (int n = 0; n < 2; ++n) _Pragma("unroll") for (int k = 0; k < 2; ++k) \
        acc[ai][bj][m][n] = __builtin_amdgcn_mfma_f32_16x16x32_bf16(Bt[n][k], At[m][k], acc[ai][bj][m][n], 0, 0, 0); __builtin_amdgcn_s_setprio(0); } while (0)
#define PG8_WAIT_V(n) asm volatile("s_waitcnt vmcnt(" #n ")" ::: "memory")
#define PG8_WAIT_L(n) asm volatile("s_waitcnt lgkmcnt(" #n ")" ::: "memory")
#define PG8_BAR __builtin_amdgcn_s_barrier()
#define PG8_SCHED __builtin_amdgcn_sched_barrier(0)
    Unit cur, nxt; int ui = 0;
    if (!S.next(0, cur)) return;
    f32x4 acc[2][2][4][2];
#pragma unroll
    for (int a = 0; a < 2; ++a)
#pragma unroll
        for (int b = 0; b < 2; ++b)
#pragma unroll
            for (int m = 0; m < 4; ++m)
#pragma unroll
                for (int n = 0; n < 2; ++n) acc[a][b][m][n] = (f32x4){0.f, 0.f, 0.f, 0.f};
    bf16x8 At[4][2], B0[2][2], B1[2][2];
    const char* cA = (const char*)g.A + (size_t)cur.pm * tstepA; const char* cB = (const char*)g.Bt + (size_t)cur.pn * tstepB;
#define PG8_RSDMA(unit, par) do { if (Epi::USE_RS && wid < 4) __builtin_amdgcn_global_load_lds((const unsigned*)(rs + ((size_t)(unit).pm * BM + wid * 64 + lane) * 4), (LAS unsigned*)(rstab + (par) * 4096 + wid * 1024), 16, 0, 0); } while (0)
    PG8_RSDMA(cur, 0);
    if constexpr (SP2) {
        PG8_STAGE(PG8_SB(0, 0), cB, voffB); PG8_STAGE(PG8_SB(0, 1), cB + hstepB, voffB); PG8_STAGE(PG8_SA(0, 0), cA, voffA); PG8_STAGE(PG8_SA(0, 1), cA + hstepA, voffA);
        if (wr == 1) PG8_BAR;
        PG8_WAIT_V(2); PG8_BAR;
        PG8_STAGE(PG8_SB(1, 0), cB + kstep, voffB); PG8_STAGE(PG8_SA(1, 0), cA + kstep, voffA); PG8_STAGE(PG8_SB(1, 1), cB + hstepB + kstep, voffB);
        PG8_WAIT_V(6); PG8_BAR;
    } else {
        PG8_STAGE(PG8_SB(0, 0), cB, voffB); PG8_STAGE(PG8_SA(0, 0), cA, voffA); PG8_STAGE(PG8_SB(0, 1), cB + hstepB, voffB); PG8_STAGE(PG8_SA(0, 1), cA + hstepA, voffA);
        if (wr == 1) PG8_BAR;
        PG8_WAIT_V(4); PG8_BAR;
        PG8_STAGE(PG8_SB(1, 0), cB + kstep, voffB); PG8_STAGE(PG8_SA(1, 0), cA + kstep, voffA); PG8_STAGE(PG8_SB(1, 1), cB + hstepB + kstep, voffB);
        PG8_WAIT_V(6); PG8_BAR;
    }
    for (;;) {
        const bool has_next = S.next(ui + 1, nxt);
        const char* nA = has_next ? (const char*)g.A + (size_t)nxt.pm * tstepA : cA; const char* nB = has_next ? (const char*)g.Bt + (size_t)nxt.pn * tstepB : cB;
        for (int t = 0; t < nt; t += 2) {
            const bool last = (t == nt - 2);
            const char* a1 = cA + (size_t)(t + 1) * kstep;
            const char* a2 = last ? nA : cA + (size_t)(t + 2) * kstep; const char* b2 = last ? nB : cB + (size_t)(t + 2) * kstep;
            const char* a3 = a2 + kstep; const char* b3 = b2 + kstep;
            if (last && has_next) PG8_RSDMA(nxt, (ui + 1) & 1);
            if constexpr (SP2) {
            PG8_LDB(B0, 0, 0); PG8_LDB(B1, 0, 1); PG8_SCHED; PG8_LDA(At, 0, 0); PG8_STAGE(PG8_SA(1, 1), a1 + hstepA, voffA);
            PG8_WAIT_V(8); PG8_WAIT_L(0); PG8_BAR; PG8_MMA(0, 0, At, B0); PG8_MMA(0, 1, At, B1); PG8_BAR; PG8_SCHED;
            PG8_LDA(At, 0, 1); PG8_STAGE(PG8_SB(0, 0), b2, voffB); PG8_STAGE(PG8_SB(0, 1), b2 + hstepB, voffB); PG8_STAGE(PG8_SA(0, 0), a2, voffA);
            PG8_WAIT_V(8); PG8_WAIT_L(0); PG8_BAR; PG8_MMA(1, 0, At, B0); PG8_MMA(1, 1, At, B1); PG8_BAR; PG8_SCHED;
            PG8_LDB(B0, 1, 0); PG8_LDB(B1, 1, 1); PG8_SCHED; PG8_LDA(At, 1, 0); PG8_STAGE(PG8_SA(0, 1), a2 + hstepA, voffA);
            PG8_WAIT_V(8); PG8_WAIT_L(0); PG8_BAR; PG8_MMA(0, 0, At, B0); PG8_MMA(0, 1, At, B1); PG8_BAR; PG8_SCHED;
            PG8_LDA(At, 1, 1); PG8_STAGE(PG8_SB(1, 0), b3, voffB); PG8_STAGE(PG8_SB(1, 1), b3 + hstepB, voffB); PG8_STAGE(PG8_SA(1, 0), a3, voffA);
            PG8_WAIT_V(8); PG8_WAIT_L(0); PG8_BAR; PG8_MMA(1, 0, At, B0); PG8_MMA(1, 1, At, B1); PG8_BAR; PG8_SCHED;
            } else {
            PG8_LDB(B0, 0, 0); PG8_SCHED; PG8_LDA(At, 0, 0); PG8_STAGE(PG8_SA(1, 1), a1 + hstepA, voffA);
            PG8_WAIT_L(8); PG8_BAR; PG8_WAIT_L(0); PG8_MMA(0, 0, At, B0); PG8_BAR; PG8_SCHED;
            PG8_LDB(B1, 0, 1); PG8_STAGE(PG8_SB(0, 0), b2, voffB);
            PG8_BAR; PG8_WAIT_L(0); PG8_MMA(0, 1, At, B1); PG8_BAR;
            PG8_LDA(At, 0, 1); PG8_STAGE(PG8_SA(0, 0), a2, voffA);
            PG8_BAR; PG8_WAIT_L(0); PG8_MMA(1, 0, At, B0); PG8_BAR; PG8_SCHED;
            PG8_STAGE(PG8_SB(0, 1), b2 + hstepB, voffB);
            PG8_WAIT_V(6); PG8_BAR; PG8_MMA(1, 1, At, B1); PG8_BAR;
            PG8_LDB(B0, 1, 0); PG8_SCHED; PG8_LDA(At, 1, 0); PG8_STAGE(PG8_SA(0, 1), a2 + hstepA, voffA);
            PG8_WAIT_L(8); PG8_BAR; PG8_WAIT_L(0); PG8_MMA(0, 0, At, B0); PG8_BAR; PG8_SCHED;
            PG8_LDB(B1, 1, 1); PG8_STAGE(PG8_SB(1, 0), b3, voffB);
            PG8_BAR; PG8_WAIT_L(0); PG8_MMA(0, 1, At, B1); PG8_BAR;
            PG8_LDA(At, 1, 1); PG8_STAGE(PG8_SA(1, 0), a3, voffA);
            PG8_BAR; PG8_WAIT_L(0); PG8_MMA(1, 0, At, B0); PG8_BAR; PG8_SCHED;
            PG8_STAGE(PG8_SB(1, 1), b3 + hstepB, voffB);
            PG8_WAIT_V(6); PG8_BAR; PG8_MMA(1, 1, At, B1); PG8_BAR;
            }
        }
        if constexpr (ALIGN_EPI) { if (wr == 0) PG8_BAR; }
        if (!skip_epi) E(acc, cur, wr, wc, fr, fq, (const LAS float*)(rstab + (ui & 1) * 4096), rs + (size_t)cur.pm * BM * 4);
        if (!has_next) break;
#pragma unroll
        for (int a = 0; a < 2; ++a)
#pragma unroll
            for (int b = 0; b < 2; ++b)
#pragma unroll
                for (int m = 0; m < 4; ++m)
#pragma unroll
                    for (int n = 0; n < 2; ++n) acc[a][b][m][n] = (f32x4){0.f, 0.f, 0.f, 0.f};
        cur = nxt; cA = nA; cB = nB; ++ui;
        if constexpr (ALIGN_EPI) { if (wr == 1) PG8_BAR; }
    }
    PG8_WAIT_V(0);
    if constexpr (!ALIGN_EPI) { if (wr == 0) PG8_BAR; }
    PG8_BAR;
#undef PG8_RSDMA
#undef PG8_SA
#undef PG8_SB
#undef PG8_STAGE
#undef PG8_LDA
#undef PG8_LDB
#undef PG8_MMA
#undef PG8_WAIT_V
#undef PG8_WAIT_L
#undef PG8_BAR
#undef PG8_SCHED
}
}
#ifndef PG8_SP2
#define PG8_SP2 true
#endif
#ifndef PG8_ALIGN
#define PG8_ALIGN true
#endif

#define XB_TMO      128
#define XB_XCNT(j)  (256  + 64 * (j))
#define XB_XSUB(j)  (1280 + 64 * (j))
#define XB_XGEN(j)  (2304 + 64 * (j))
#define XB_TOP      3328
#define XB_TOPGEN   3392
#define XCD_BAR_WORDS 3456
#define XB_SPIN_CAP (1u << 18)
__device__ __forceinline__ unsigned xb_ld(unsigned* p)              { return __hip_atomic_load(p, __ATOMIC_RELAXED, __HIP_MEMORY_SCOPE_AGENT); }
__device__ __forceinline__ unsigned xb_add(unsigned* p, unsigned v) { return __hip_atomic_fetch_add(p, v, __ATOMIC_RELAXED, __HIP_MEMORY_SCOPE_AGENT); }
__device__ __forceinline__ unsigned xb_xcc_id() { return (unsigned)__builtin_amdgcn_s_getreg((3 << 11) | 20) & 0xFu; }
#define XB_SPIN(cond, bar) do { unsigned _sp = 0; while (cond) { __builtin_amdgcn_s_sleep(1); \
    if ((++_sp & 255u) == 0u) { if (xb_ld(&(bar)[XB_TMO])) break; if (_sp > XB_SPIN_CAP) { atomicAdd(&(bar)[XB_TMO], 1u); break; } } } } while (0)
struct XcdBarrier { unsigned* bar; unsigned x; volatile LAS unsigned* st; };
__device__ __forceinline__ XcdBarrier xcd_barrier_post(unsigned* bar, volatile LAS unsigned* st) {
    XcdBarrier b; b.bar = bar; b.x = xb_xcc_id(); b.st = st;
    if (threadIdx.x == 0) (void)xb_add(&bar[XB_XCNT(b.x)], 1u);
    return b;
}
__device__ __forceinline__ void xcd_barrier_complete(unsigned* bar, unsigned x, unsigned& nloc, unsigned& nx) {
    const unsigned G = gridDim.x * gridDim.y * gridDim.z;
    unsigned sum, cnt, mine, sp = 0u;
    for (;;) {
        sum = 0u; cnt = 0u; mine = 0u;
#pragma unroll
        for (unsigned j = 0; j < 16; ++j) { const unsigned c = xb_ld(&bar[XB_XCNT(j)]); sum += c; cnt += (c > 0u) ? 1u : 0u; mine = (j == x) ? c : mine; }
        if (sum == G) break;
        __builtin_amdgcn_s_sleep(1);
        if ((++sp & 255u) == 0u) { if (xb_ld(&bar[XB_TMO])) break; if (sp > XB_SPIN_CAP) { atomicAdd(&bar[XB_TMO], 1u); break; } }
    }
    nloc = mine > 0u ? mine : 1u; nx = cnt > 0u ? cnt : 1u;
}
__device__ __forceinline__ void xcd_barrier(const XcdBarrier& b) {
    asm volatile("s_waitcnt vmcnt(0)" ::: "memory");
    __syncthreads();
    if (threadIdx.x == 0) {
        unsigned* bar = b.bar;
        __builtin_amdgcn_s_waitcnt(0);
        unsigned nloc = b.st[0], nx = b.st[1];
        if (nloc == 0u) { xcd_barrier_complete(bar, b.x, nloc, nx); b.st[0] = nloc; b.st[1] = nx; }
        const unsigned old = xb_add(&bar[XB_XSUB(b.x)], 1u);
        const unsigned gen = old / nloc;
        if (old + 1u == (gen + 1u) * nloc) {
            __builtin_amdgcn_fence(__ATOMIC_RELEASE, "agent");
            asm volatile("s_waitcnt vmcnt(0)" ::: "memory");
            const unsigned og = xb_add(&bar[XB_TOP], 1u);
            const unsigned tg = og / nx;
            if (og + 1u == (tg + 1u) * nx) xb_add(&bar[XB_TOPGEN], 1u);
            else XB_SPIN(xb_ld(&bar[XB_TOPGEN]) == tg, bar);
            __builtin_amdgcn_fence(__ATOMIC_ACQUIRE, "agent");
            xb_add(&bar[XB_XGEN(b.x)], 1u);
            asm volatile("s_waitcnt vmcnt(0)" ::: "memory");
        } else {
            XB_SPIN(xb_ld(&bar[XB_XGEN(b.x)]) == gen, bar);
            __builtin_amdgcn_fence(__ATOMIC_ACQUIRE, "agent");
            asm volatile("s_waitcnt vmcnt(0)" ::: "memory");
        }
    }
    __syncthreads();
}
namespace att {
typedef float f32x16 __attribute__((ext_vector_type(16)));
typedef short s16x4 __attribute__((ext_vector_type(4)));
constexpr int SHM_V = 16384, SHM_KN = 16384, SHM_KR = 8192;
constexpr int NKS = 3, NVS = 4;
constexpr int L_KN = 0, L_KR = L_KN + NKS * SHM_KN, L_V = L_KR + NKS * SHM_KR, L_WS = L_V + NVS * SHM_V, L_END = L_WS + 8 * 64 * 4;
static_assert(L_END <= 160 * 1024 - 1024, "attention LDS map");
constexpr float THR = 8.f;
#define KSWZ(row, chunk) ((row) * 256 + ((((chunk) ^ (row)) & 15) << 4))
#define KRSWZ(row, chunk) ((row) * 128 + ((((chunk) ^ ((row) >> 1)) & 7) << 4))
#define SBAR() __builtin_amdgcn_sched_barrier(0)
__device__ __forceinline__ int v_st(int k, int c) { const int kk = (k & ~0xC) | ((k & 4) << 1) | ((k & 8) >> 1); return ((kk >> 3) * 4 + (c >> 5)) * 512 + ((kk & 7) * 32 + (c & 31)) * 2; }
__device__ __forceinline__ int v_rd_base(int lane) { return ((lane & 3) << 3) | (((lane >> 2) & 3) << 6) | (((lane >> 4) & 1) << 5) | (((lane >> 5) & 1) << 8); }
constexpr int v_rd_off(int d0, int ks, int half) { return d0 * 512 + ks * 4096 + half * 2048; }
__device__ __forceinline__ int crow(int r, int hi) { return (r & 3) + 8 * (r >> 2) + 4 * hi; }
__device__ __forceinline__ bf16x8 pack8(f32x4 a, f32x4 b) { u32x4 w = {cvt_pk_bf16(a[0], a[1]), cvt_pk_bf16(a[2], a[3]), cvt_pk_bf16(b[0], b[1]), cvt_pk_bf16(b[2], b[3])}; return __builtin_bit_cast(bf16x8, w); }
__device__ __forceinline__ void mask_tile(f32x16& p0, f32x16& p1, int dq) {
    const float NEG = -__builtin_inff();
#pragma unroll
    for (int r = 0; r < 16; ++r) { const int c = (r & 3) + 8 * (r >> 2); if (dq - c < 0) p0[r] = NEG; if (dq - c - 32 < 0) p1[r] = NEG; }
}
__device__ __forceinline__ void partialSM(f32x16& p0, f32x16& p1, float& m_reg, float& mn, float& alpha, const float SCALE) {
    float pmax = p0[0];
#pragma unroll
    for (int r = 1; r < 16; ++r) pmax = fmaxf(pmax, p0[r]);
#pragma unroll
    for (int r = 0; r < 16; ++r) pmax = fmaxf(pmax, p1[r]);
    { auto rr = __builtin_amdgcn_permlane32_swap(__float_as_uint(pmax), __float_as_uint(pmax), false, false);
      pmax = fmaxf(__uint_as_float(rr[0]), __uint_as_float(rr[1])); }
    const float C2 = 1.4426950408889634f * SCALE;
    if (__builtin_expect(__all((pmax - m_reg) * SCALE <= THR), 1)) { mn = m_reg; alpha = 1.f; }
    else { mn = fmaxf(m_reg, pmax); alpha = __builtin_amdgcn_exp2f((m_reg - mn) * C2); m_reg = mn; }
    const float mnL = -mn * C2;
#pragma unroll
    for (int r = 0; r < 16; ++r) p0[r] = fmaf(p0[r], C2, mnL);
#pragma unroll
    for (int r = 0; r < 16; ++r) p1[r] = fmaf(p1[r], C2, mnL);
#pragma unroll
    for (int r = 0; r < 16; ++r) p0[r] = __builtin_amdgcn_exp2f(p0[r]);
}
__device__ __forceinline__ void finishSM(f32x16& p0, f32x16& p1, float alpha, float& l_reg, bf16x8& pa0, bf16x8& pa1, bf16x8& pa2, bf16x8& pa3) {
#pragma unroll
    for (int r = 0; r < 16; ++r) p1[r] = __builtin_amdgcn_exp2f(p1[r]);
    float ps = 0;
#pragma unroll
    for (int r = 0; r < 16; ++r) ps += p0[r];
#pragma unroll
    for (int r = 0; r < 16; ++r) ps += p1[r];
    { auto rr = __builtin_amdgcn_permlane32_swap(__float_as_uint(ps), __float_as_uint(ps), false, false);
      ps = __uint_as_float(rr[0]) + __uint_as_float(rr[1]); }
    l_reg = l_reg * alpha + ps;
#define PK4(P, B_, OUT) do { unsigned a0 = cvt_pk_bf16(P[B_+0], P[B_+1]), a1 = cvt_pk_bf16(P[B_+2], P[B_+3]);                          \
        unsigned b0 = cvt_pk_bf16(P[B_+4], P[B_+5]), b1 = cvt_pk_bf16(P[B_+6], P[B_+7]);                                             \
        auto r0 = __builtin_amdgcn_permlane32_swap(a0, b0, false, false); auto r1 = __builtin_amdgcn_permlane32_swap(a1, b1, false, false); \
        u32x4 w = {r0[0], r1[0], r0[1], r1[1]}; OUT = __builtin_bit_cast(bf16x8, w); } while (0)
    PK4(p0, 0, pa0); PK4(p0, 8, pa1); PK4(p1, 0, pa2); PK4(p1, 8, pa3);
#undef PK4
}
__device__ __forceinline__ void staticSM(f32x16& p0, f32x16& p1, float& l_reg, bf16x8& pa0, bf16x8& pa1, bf16x8& pa2, bf16x8& pa3) {
#pragma unroll
    for (int r = 0; r < 16; ++r) p0[r] = __builtin_amdgcn_exp2f(p0[r]);
#pragma unroll
    for (int r = 0; r < 16; ++r) p1[r] = __builtin_amdgcn_exp2f(p1[r]);
    float ps = 0;
#pragma unroll
    for (int r = 0; r < 16; ++r) ps += p0[r];
#pragma unroll
    for (int r = 0; r < 16; ++r) ps += p1[r];
    { auto rr = __builtin_amdgcn_permlane32_swap(__float_as_uint(ps), __float_as_uint(ps), false, false);
      ps = __uint_as_float(rr[0]) + __uint_as_float(rr[1]); }
    l_reg += ps;
#define PK4(P, B_, OUT) do { unsigned a0 = cvt_pk_bf16(P[B_+0], P[B_+1]), a1 = cvt_pk_bf16(P[B_+2], P[B_+3]);                          \
        unsigned b0 = cvt_pk_bf16(P[B_+4], P[B_+5]), b1 = cvt_pk_bf16(P[B_+6], P[B_+7]);                                             \
        auto r0 = __builtin_amdgcn_permlane32_swap(a0, b0, false, false); auto r1 = __builtin_amdgcn_permlane32_swap(a1, b1, false, false); \
        u32x4 w = {r0[0], r1[0], r0[1], r1[1]}; OUT = __builtin_bit_cast(bf16x8, w); } while (0)
    PK4(p0, 0, pa0); PK4(p0, 8, pa1); PK4(p1, 0, pa2); PK4(p1, 8, pa3);
#undef PK4
}
template <int NR>
__device__ __forceinline__ void qkt(f32x16& p0, f32x16& p1, const int (&kaddr)[8], const int (&raddr)[4], const bf16x8* qr, const float init) {
#pragma unroll
    for (int r = 0; r < 16; ++r) { p0[r] = init; p1[r] = init; }
    bf16x8 a0, a1, a2, a3, b0, b1, b2, b3;
#define KRD(dst, addr, off) asm volatile("ds_read_b128 %0, %1 offset:%2" : "=&v"(dst) : "v"(addr), "i"(off) : "memory")
#define KLD(d, x0, x1) do { if ((d) < 8) { KRD(x0, kaddr[(d) & 7], 0); KRD(x1, kaddr[(d) & 7], 8192); } else { KRD(x0, raddr[((d) - 8) & 3], 0); KRD(x1, raddr[((d) - 8) & 3], 4096); } } while (0)
#define KWAIT(n) do { asm volatile("s_waitcnt lgkmcnt(" #n ")" : "+v"(a0), "+v"(a1), "+v"(a2), "+v"(a3), "+v"(b0), "+v"(b1), "+v"(b2), "+v"(b3) :: "memory"); SBAR(); } while (0)
#define KMMA(d, x0, x1) do { p0 = __builtin_amdgcn_mfma_f32_32x32x16_bf16(x0, qr[d], p0, 0, 0, 0); p1 = __builtin_amdgcn_mfma_f32_32x32x16_bf16(x1, qr[d], p1, 0, 0, 0); } while (0)
    constexpr int NS = 8 + NR;
    KLD(0, a0, a1); KLD(1, a2, a3); KLD(2, b0, b1); KLD(3, b2, b3);
    KWAIT(4); KMMA(0, a0, a1); KMMA(1, a2, a3); KLD(4, a0, a1); KLD(5, a2, a3);
    KWAIT(4); KMMA(2, b0, b1); KMMA(3, b2, b3); KLD(6, b0, b1); KLD(7, b2, b3);
    if constexpr (NS > 8) {
        KWAIT(4); KMMA(4, a0, a1); KMMA(5, a2, a3); KLD(8, a0, a1); KLD(9, a2, a3);
        KWAIT(4); KMMA(6, b0, b1); KMMA(7, b2, b3); KLD(10, b0, b1); KLD(11, b2, b3);
        KWAIT(4); KMMA(8, a0, a1); KMMA(9, a2, a3);
        KWAIT(0); KMMA(10, b0, b1); KMMA(11, b2, b3);
    } else {
        KWAIT(4); KMMA(4, a0, a1); KMMA(5, a2, a3);
        KWAIT(0); KMMA(6, b0, b1); KMMA(7, b2, b3);
    }
#undef KMMA
#undef KWAIT
#undef KLD
#undef KRD
}
__device__ __forceinline__ void pv_tile(f32x16* o, int vb0  , bf16x8 pa0, bf16x8 pa1, bf16x8 pa2, bf16x8 pa3) {
#define TRRD(dst, off) asm volatile("ds_read_b64_tr_b16 %0, %1 offset:%2" : "=&v"(dst) : "v"(vb0), "i"(off) : "memory")
#define PV_LOAD(L, H, ks) do { constexpr int b_ = (ks) * 4096; \
        TRRD(L[0], b_); TRRD(H[0], b_ + 2048); TRRD(L[1], b_ + 512); TRRD(H[1], b_ + 512 + 2048); TRRD(L[2], b_ + 1024); TRRD(H[2], b_ + 1024 + 2048); TRRD(L[3], b_ + 1536); TRRD(H[3], b_ + 1536 + 2048); } while (0)
#define PV_WAIT(n) do { asm volatile("s_waitcnt lgkmcnt(" #n ")" : "+v"(la[0]), "+v"(ha[0]), "+v"(la[1]), "+v"(ha[1]), "+v"(la[2]), "+v"(ha[2]), "+v"(la[3]), "+v"(ha[3]), "+v"(lb[0]), "+v"(hb[0]), "+v"(lb[1]), "+v"(hb[1]), "+v"(lb[2]), "+v"(hb[2]), "+v"(lb[3]), "+v"(hb[3]) :: "memory"); SBAR(); } while (0)
#define PV_MMA(pa, L, H) do { _Pragma("unroll") for (int d0 = 0; d0 < 4; ++d0) \
        o[d0] = __builtin_amdgcn_mfma_f32_32x32x16_bf16(pa, (bf16x8){L[d0][0], L[d0][1], L[d0][2], L[d0][3], H[d0][0], H[d0][1], H[d0][2], H[d0][3]}, o[d0], 0, 0, 0); } while (0)
    s16x4 la[4], ha[4], lb[4], hb[4];
    PV_LOAD(la, ha, 0); PV_LOAD(lb, hb, 1);
    PV_WAIT(8); PV_MMA(pa0, la, ha);
    PV_LOAD(la, ha, 2);
    PV_WAIT(8); PV_MMA(pa1, lb, hb);
    PV_LOAD(lb, hb, 3);
    PV_WAIT(8); PV_MMA(pa2, la, ha);
    PV_WAIT(0); PV_MMA(pa3, lb, hb);
#undef PV_MMA
#undef PV_WAIT
#undef PV_LOAD
#undef TRRD
}

template <int NR, bool CAUSAL, int QMODE>
__device__ __forceinline__ void attn_block(LAS char* lds, const bf16* Q, int ldq, const bf16* Kn, int ldk, const bf16* Kr, const bf16* V, int ldv, bf16* O, int ldo,
                                           int NT, int P0, const float SCALE, const float BND  , const float* qgain, const float* qgain2, const float* rope, const bool dry = false) {
    int tid_ = threadIdx.x; asm volatile("" : "+v"(tid_));
    const int tid = tid_, wid = __builtin_amdgcn_readfirstlane(tid >> 6), lane = tid & 63, r32 = lane & 31, hi = lane >> 5;
#ifndef ATT_STAGGER
#define ATT_STAGGER 1
#endif
    const bool late = ATT_STAGGER && wid >= 4;
#ifndef ABL
#define ABL 0
#endif
#ifndef ATT_PRIO
#define ATT_PRIO 1
#endif
    const int abl = dry ? ABL : 0;
    constexpr int NOPS = 4 + (NR > 0 ? 1 : 0);
    int so_k[2], so_v[2], so_r = 0;
#pragma unroll
    for (int i = 0; i < 2; ++i) {
        const int p = 2 * wid + i;
        { const int row = 4 * p + (lane >> 4), c = (lane ^ row) & 15; so_k[i] = row * ldk + c * 8; }
        { const int st = 2 * p + (lane >> 5), kk = (st >> 2) * 8 + ((lane & 31) >> 2), key = (kk & ~0xC) | ((kk & 4) << 1) | ((kk & 8) >> 1), col = (st & 3) * 32 + (lane & 3) * 8; so_v[i] = key * ldv + col; }
    }
    if constexpr (NR > 0) { const int row = 8 * wid + (lane >> 3), c = ((lane & 7) ^ (row >> 1)) & 7; so_r = row * 64 + c * 8; }
#define DMA16(gp, loff) __builtin_amdgcn_global_load_lds((const unsigned*)(gp), (LAS unsigned*)(lds + (loff)), 16, 0, 0)
#define ISSUE(tile, ks_, vs_) do { const int k0_ = (tile) * 64; \
        DMA16(Kn + (size_t)k0_ * ldk + so_k[0], L_KN + (ks_) * SHM_KN + (2 * wid) * 1024); DMA16(Kn + (size_t)k0_ * ldk + so_k[1], L_KN + (ks_) * SHM_KN + (2 * wid + 1) * 1024); \
        if constexpr (NR > 0) DMA16(Kr + (size_t)k0_ * 64 + so_r, L_KR + (ks_) * SHM_KR + wid * 1024); \
        DMA16(V + (size_t)k0_ * ldv + so_v[0], L_V + (vs_) * SHM_V + (2 * wid) * 1024); DMA16(V + (size_t)k0_ * ldv + so_v[1], L_V + (vs_) * SHM_V + (2 * wid + 1) * 1024); } while (0)
    ISSUE(0, 0, 0); ISSUE(1, 1, 1);
    bf16x8 qr[8 + NR];
#pragma unroll
    for (int d0 = 0; d0 < 8 + NR; ++d0) qr[d0] = *(const bf16x8*)(Q + (size_t)(wid * 32 + r32) * ldq + d0 * 16 + hi * 8);
    if constexpr (QMODE >= 1) {
        float ss = 0.f;
#pragma unroll
        for (int d0 = 0; d0 < 8; ++d0)
#pragma unroll
            for (int e = 0; e < 8; ++e) { const float v = bf2f((bf16)qr[d0][e]); ss += v * v; }
        { auto rr = __builtin_amdgcn_permlane32_swap(__float_as_uint(ss), __float_as_uint(ss), false, false); ss = __uint_as_float(rr[0]) + __uint_as_float(rr[1]); }
        const float rstdc = (1.0f / sqrtf(ss * (1.f / 128.f) + EPS)) * (1.4426950408889634f * SCALE);
#pragma unroll
        for (int d0 = 0; d0 < 8; ++d0) { const f32x4 g0 = *(const f32x4*)(qgain + d0 * 16 + hi * 8), g1 = *(const f32x4*)(qgain + d0 * 16 + hi * 8 + 4); f32x4 a, b;
#pragma unroll
            for (int e = 0; e < 4; ++e) { a[e] = bf2f((bf16)qr[d0][e]) * rstdc * g0[e]; b[e] = bf2f((bf16)qr[d0][4 + e]) * rstdc * g1[e]; }
            qr[d0] = pack8(a, b); }
    }
    if constexpr (QMODE == 2 && NR == 4) {
        float ss = 0.f;
#pragma unroll
        for (int d0 = 8; d0 < 12; ++d0)
#pragma unroll
            for (int e = 0; e < 8; ++e) { const float v = bf2f((bf16)qr[d0][e]); ss += v * v; }
        { auto rr = __builtin_amdgcn_permlane32_swap(__float_as_uint(ss), __float_as_uint(ss), false, false); ss = __uint_as_float(rr[0]) + __uint_as_float(rr[1]); }
        const float rstd = (1.0f / sqrtf(ss * (1.f / 64.f) + EPS)) * (1.4426950408889634f * SCALE);
        const int pos = P0 + wid * 32 + r32;
#pragma unroll
        for (int dd = 0; dd < 2; ++dd) {
            const float* cp = rope + pos * 32 + dd * 16 + hi * 8; const float* sp = cp + SEQ * 32;
            const float* g1 = qgain2 + dd * 16 + hi * 8; const float* g2 = g1 + 32;
            f32x4 a, b, c, d;
#pragma unroll
            for (int e = 0; e < 8; ++e) { const float t1 = bf2f((bf16)qr[8 + dd][e]) * rstd * g1[e], t2 = bf2f((bf16)qr[10 + dd][e]) * rstd * g2[e], cs = cp[e], sn = sp[e];
                const float n1 = t1 * cs - t2 * sn, n2 = t1 * sn + t2 * cs;
                if (e < 4) { a[e] = n1; c[e] = n2; } else { b[e - 4] = n1; d[e - 4] = n2; } }
            qr[8 + dd] = pack8(a, b); qr[10 + dd] = pack8(c, d); }
    }
    LAS float* ws = (LAS float*)(lds + L_WS) + wid * 64; LAS float* li_l = ws; LAS float* al_l = ws + 32;
    float m_reg = -1e30f, l_reg = 0.f; f32x16 o[4] = {};
    int kbase[8], krbase[4];
#pragma unroll
    for (int d0 = 0; d0 < 8; ++d0) kbase[d0] = KSWZ(r32, 2 * d0 + hi);
#pragma unroll
    for (int dr = 0; dr < 4; ++dr) krbase[dr] = KRSWZ(r32, 2 * dr + hi);
    const int vrd = (int)(uintptr_t)lds + L_V + v_rd_base(lane), kn0 = (int)(uintptr_t)lds + L_KN, kr0 = (int)(uintptr_t)lds + L_KR;
    const int qlo = P0 + wid * 32, qm = qlo + r32 - 4 * hi;
#define RESC(a) do { if (__any((a) < 1.f)) { if (hi == 0) al_l[r32] = (a); asm volatile("s_waitcnt lgkmcnt(0)" ::: "memory");              \
        _Pragma("unroll") for (int d_ = 0; d_ < 4; ++d_) _Pragma("unroll") for (int r = 0; r < 16; ++r) o[d_][r] *= al_l[crow(r, hi)]; } } while (0)
    f32x16 p0, p1; float mn, al; bf16x8 pa0, pa1, pa2, pa3;
    const float pinit = 0.f;
    asm volatile("s_waitcnt vmcnt(0)" ::: "memory");
    int ks = 0, vs = 0;
    for (int t = 0; t < NT; ++t) {
        if constexpr (NOPS == 5) asm volatile("s_waitcnt vmcnt(5)" ::: "memory"); else asm volatile("s_waitcnt vmcnt(4)" ::: "memory");
        asm volatile("s_waitcnt lgkmcnt(0)" ::: "memory"); if (abl != 4 && abl != 5) __builtin_amdgcn_s_barrier(); asm volatile("" ::: "memory");
        if (abl != 5) { const int tn = (t + 2 < NT) ? t + 2 : NT - 1;
          int ks2 = ks + 2; if (ks2 >= NKS) ks2 -= NKS; int vs2 = vs + 2; if (vs2 >= NVS) vs2 -= NVS;
          ISSUE(tn, ks2, vs2); }
        const int kb_ = t * 64;
        if (late && t > 0 && abl != 2) { int vp = vs - 1; if (vp < 0) vp += NVS; SBAR(); __builtin_amdgcn_s_setprio(ATT_PRIO); pv_tile(o, vrd + vp * SHM_V, pa0, pa1, pa2, pa3); __builtin_amdgcn_s_setprio(0); }
        { int kaddr[8], raddr[4];
#pragma unroll
          for (int d0 = 0; d0 < 8; ++d0) kaddr[d0] = kn0 + ks * SHM_KN + kbase[d0];
#pragma unroll
          for (int dr = 0; dr < 4; ++dr) raddr[dr] = kr0 + ks * SHM_KR + krbase[dr];
          SBAR(); __builtin_amdgcn_s_setprio(ATT_PRIO); if (abl != 3) qkt<NR>(p0, p1, kaddr, raddr, qr, pinit); else { p0 = f32x16{}; p1 = f32x16{}; } __builtin_amdgcn_s_setprio(0); }
        if (CAUSAL && kb_ + 63 > qlo) mask_tile(p0, p1, qm - kb_);
        if (abl != 1) { if (BND > 0.f) staticSM(p0, p1, l_reg, pa0, pa1, pa2, pa3);
                        else { partialSM(p0, p1, m_reg, mn, al, 0.6931471805599453f); finishSM(p0, p1, al, l_reg, pa0, pa1, pa2, pa3); RESC(al); } }
        else { u32x4 w0 = {cvt_pk_bf16(p0[0], p0[1]), cvt_pk_bf16(p0[2], p0[3]), cvt_pk_bf16(p0[4], p0[5]), cvt_pk_bf16(p0[6], p0[7])}, w1 = {cvt_pk_bf16(p0[8], p0[9]), cvt_pk_bf16(p0[10], p0[11]), cvt_pk_bf16(p0[12], p0[13]), cvt_pk_bf16(p0[14], p0[15])},
                     w2 = {cvt_pk_bf16(p1[0], p1[1]), cvt_pk_bf16(p1[2], p1[3]), cvt_pk_bf16(p1[4], p1[5]), cvt_pk_bf16(p1[6], p1[7])}, w3 = {cvt_pk_bf16(p1[8], p1[9]), cvt_pk_bf16(p1[10], p1[11]), cvt_pk_bf16(p1[12], p1[13]), cvt_pk_bf16(p1[14], p1[15])};
               pa0 = __builtin_bit_cast(bf16x8, w0); pa1 = __builtin_bit_cast(bf16x8, w1); pa2 = __builtin_bit_cast(bf16x8, w2); pa3 = __builtin_bit_cast(bf16x8, w3); l_reg = 1.f; }
        SBAR();
        if (!late && abl != 2) { __builtin_amdgcn_s_setprio(ATT_PRIO); pv_tile(o, vrd + vs * SHM_V, pa0, pa1, pa2, pa3); __builtin_amdgcn_s_setprio(0); }
        if (++ks == NKS) ks = 0; if (++vs == NVS) vs = 0;
    }
    if (late) { int vp = vs - 1; if (vp < 0) vp += NVS; SBAR(); pv_tile(o, vrd + vp * SHM_V, pa0, pa1, pa2, pa3); }
    if (hi == 0) li_l[r32] = l_reg;
    asm volatile("s_waitcnt lgkmcnt(0)" ::: "memory");
    bf16* Ow = O + (size_t)(wid * 32) * ldo;
#pragma unroll
    for (int r = 0; r < 16; ++r) { const int orow = crow(r, hi); const float rli = __builtin_amdgcn_rcpf(li_l[orow]);
#pragma unroll
        for (int d0 = 0; d0 < 4; ++d0) { const float v = o[d0][r] * rli; const float vn = __shfl_xor(v, 1);
            if ((r32 & 1) == 0 && !dry) *(unsigned*)(Ow + (size_t)orow * ldo + d0 * 32 + r32) = cvt_pk_bf16(v, vn); } }
    asm volatile("s_waitcnt vmcnt(0) lgkmcnt(0)" ::: "memory"); __builtin_amdgcn_s_barrier(); asm volatile("" ::: "memory");
#undef DMA16
#undef ISSUE
#undef RESC
}
}
constexpr int NWAVES = 8;
constexpr int RING_OFF = 0, RING_BYTES = 131072;
constexpr int XTRA_OFF = RING_BYTES, XTRA_BYTES = 32256;
constexpr int MISC_OFF = XTRA_OFF + XTRA_BYTES;
constexpr int LDS_BYTES = MISC_OFF + 512;
static_assert(LDS_BYTES == 163840, "LDS map");

constexpr size_t WB_GU0 = 0, WB_D0 = 11 * MiB, WB_GU1 = WB_D0 + (size_t)DM * FF * 2, WB_D1 = WB_GU1 + 11 * MiB, WB_WO = 33 * MiB, WB_IN = 36 * MiB, WB_UQ = 43 * MiB, WB_UKV = 45 * MiB;
static_assert(WB_D1 + (size_t)DM * FF * 2 <= WB_WO && WB_UKV + 1 * MiB <= 52 * MiB && WS_WB + 52 * MiB <= WS_XN, "weight map");
constexpr size_t WS_MEMW = WS_BIG;

constexpr int CW_BAR = 4096;
constexpr size_t WS_RS = 78 * MiB;
constexpr size_t CTL_ZERO_BYTES = 1 * MiB;
static_assert(WS_WB + 46 * MiB <= WS_RS && WS_RS + 12 * (size_t)M * 16 <= WS_XN, "row sums sit between the weight copies and XN");

struct MArgs { const float* in[29]; float* out; unsigned char* ws; int lo, hi, region, pad; };
static_assert(sizeof(MArgs) == 264, "no padding in the argument struct");

struct Frame {
    LAS unsigned char* lds;
    int vcu, G;
    float* X; unsigned char* ws; bf16* OC;
};
#define PH_IDS() int tid_ = threadIdx.x; asm volatile("" : "+v"(tid_)); const int tid = tid_, lane = tid & 63, wave = __builtin_amdgcn_readfirstlane(tid >> 6); (void)tid; (void)lane; (void)wave

__device__ __forceinline__ void tr_item(const float* W, int ldw, int scol, int k0, bf16* WT, int K, int drow, LAS float* scr, int lane, int nv, const float* gain) {
    const int c = lane & 7;
    if (nv == 0) {
#pragma unroll
        for (int j = 0; j < 4; ++j) { const int n = (lane >> 3) + 8 * j; *(GAS u32x4*)(WT + (size_t)(drow + n) * K + k0 + 8 * c) = (u32x4){0u, 0u, 0u, 0u}; }
        return;
    }
    const int n4 = (lane & 7) * 4, kq = lane >> 3;
    const GAS float* Wg = (const GAS float*)W + (size_t)(k0 + kq) * ldw + scol + n4;
    const bool val = n4 < nv;
    f32x4 wv[8];
#pragma unroll
    for (int i = 0; i < 8; ++i) wv[i] = val ? *(const GAS f32x4*)(Wg + (size_t)(8 * i) * ldw) : (f32x4){0.f, 0.f, 0.f, 0.f};
#pragma unroll
    for (int i = 0; i < 8; ++i) { LAS float* d = scr + (kq + 8 * i) * 33 + n4; d[0] = wv[i].x; d[1] = wv[i].y; d[2] = wv[i].z; d[3] = wv[i].w; }
    f32x4 g0 = (f32x4){1.f, 1.f, 1.f, 1.f}, g1 = g0;
    if (gain) { g0 = *(const GAS f32x4*)(gain + k0 + 8 * c); g1 = *(const GAS f32x4*)(gain + k0 + 8 * c + 4); }
    LDS_WAIT(); asm volatile("" ::: "memory");
#pragma unroll
    for (int j = 0; j < 4; ++j) { const int n = (lane >> 3) + 8 * j; const LAS float* s = scr + (8 * c) * 33 + n;
        u32x4 o; o.x = cvt_pk_bf16(s[0 * 33] * g0[0], s[1 * 33] * g0[1]); o.y = cvt_pk_bf16(s[2 * 33] * g0[2], s[3 * 33] * g0[3]); o.z = cvt_pk_bf16(s[4 * 33] * g1[0], s[5 * 33] * g1[1]); o.w = cvt_pk_bf16(s[6 * 33] * g1[2], s[7 * 33] * g1[3]);
        *(GAS u32x4*)(WT + (size_t)(drow + n) * K + k0 + 8 * c) = o; }
    LDS_WAIT(); asm volatile("" ::: "memory");
}

__device__ __forceinline__ void norm_row(const float* xrow, const f32x4 (&gg)[4], bf16* orow, int lane, f32x4 (&v)[4]) {
    const GAS f32x4* xr = (const GAS f32x4*)xrow + lane; float s = 0.f;
#pragma unroll
    for (int j = 0; j < 4; ++j) { v[j] = xr[64 * j]; s += (v[j].x * v[j].x + v[j].y * v[j].y) + (v[j].z * v[j].z + v[j].w * v[j].w); }
    const float rstd = 1.0f / sqrtf(wave_sum(s) * (1.f / DM) + EPS);
    GAS u32x2* o8 = (GAS u32x2*)orow + lane;
#pragma unroll
    for (int j = 0; j < 4; ++j) { v[j] = v[j] * rstd * gg[j]; u32x2 w; w.x = cvt_pk_bf16(v[j].x, v[j].y); w.y = cvt_pk_bf16(v[j].z, v[j].w); o8[64 * j] = w; }
}

__device__ __forceinline__ void raw_row(const float* xrow, bf16* orow, float* rs_out, int lane) {
    const GAS f32x4* xr = (const GAS f32x4*)xrow + lane; f32x4 v[4]; float s = 0.f;
#pragma unroll
    for (int j = 0; j < 4; ++j) { v[j] = xr[64 * j]; s += (v[j].x * v[j].x + v[j].y * v[j].y) + (v[j].z * v[j].z + v[j].w * v[j].w); }
    s = wave_sum(s);
    GAS u32x2* o8 = (GAS u32x2*)orow + lane;
#pragma unroll
    for (int j = 0; j < 4; ++j) { u32x2 w; w.x = cvt_pk_bf16(v[j].x, v[j].y); w.y = cvt_pk_bf16(v[j].z, v[j].w); o8[64 * j] = w; }
    if (lane == 0) *(GAS f32x4*)rs_out = (f32x4){s, 0.f, 0.f, 0.f};
}
__device__ __forceinline__ void ph_prologue(Frame& F, const float* x, const float* mem, const float* mn, const float* memw) {
    PH_IDS();
    const int gt = F.vcu * 512 + tid, NT = F.G * 512, gw = F.vcu * NWAVES + wave, NGW = F.G * NWAVES;
    { bf16* XB = (bf16*)(F.ws + WS_XN); float* RS0 = (float*)(F.ws + WS_RS);
      for (int m = gw; m < M; m += NGW) raw_row(x + (size_t)m * DM, XB + (size_t)m * DM, RS0 + (size_t)m * 4, lane); }
    { float* cs = (float*)(F.ws + WS_ROPE);
      const int f = gt & 31; const float ex = (float)(2 * f) / 64.0f; const float inv = (float)(1.0 / pow(10000.0, (double)ex));
      for (int i = gt; i < SEQ * 32; i += NT) { const int pos = i >> 5; const float ang = (float)pos * inv; float sn, cn; sincosf(ang, &sn, &cn);
          cs[i] = cn; cs[SEQ * 32 + i] = sn; } }
    { bf16* MEMH = (bf16*)(F.ws + WS_MEMH);
      for (int r = gw; r < 4 * 1024; r += NGW) { const int l = r >> 10, row = r & 1023; f32x4 gg[4], v[4];
#pragma unroll
          for (int j = 0; j < 4; ++j) gg[j] = ((const f32x4*)(mn + l * DM))[lane + 64 * j];
          norm_row(mem + (size_t)row * DM, gg, MEMH + (size_t)r * DM, lane, v); } }
    { LAS float* scr = (LAS float*)(F.lds + RING_OFF + wave * 16384); bf16* MW = (bf16*)(F.ws + WS_MEMW);
      for (int it = gw; it < 4 * 512; it += NGW) { const int l = it >> 9, r = it & 511, kb = r >> 5, nb = r & 31;
          tr_item(memw + (size_t)l * DM * DM, DM, 32 * nb, 64 * kb, MW + (size_t)l * DM * DM, DM, 32 * nb, scr, lane, 32, nullptr); } }
}
__device__ __forceinline__ void ph_memknorm(Frame& F, const float* memk_norm) {
    PH_IDS();
    const int gw = F.vcu * NWAVES + wave, NGW = F.G * NWAVES; bf16* KVm = (bf16*)(F.ws + WS_MEMKV);
    for (int idx = gw; idx < 4096 * 4; idx += NGW) { const int row = idx >> 2, h = idx & 3, l = row >> 10;
        bf16* p = KVm + (size_t)row * 1024 + h * 128 + lane * 2; const float* g = memk_norm + l * 128;
        const float a = bf2f(p[0]), b = bf2f(p[1]);
        const float rstd = 1.0f / sqrtf(wave_sum(a * a + b * b) * (1.f / 128.f) + EPS);
        *(GAS unsigned*)p = cvt_pk_bf16(a * rstd * g[lane * 2], b * rstd * g[lane * 2 + 1]); }
}
struct ConvPtrs { const float *g0, *u0, *d0, *g1, *u1, *d1, *wo, *gin, *min, *uq, *ukv, *n1, *n2, *nm; };
template <int MAP>
__device__ __forceinline__ void conv_job(Frame& F, const float* W, int ldw, int nkb, int nblk, bf16* dst, int K, int& rot, LAS float* scr, int wave, int lane, const float* gain) {
    const int NGW = F.G * NWAVES; int gw = F.vcu * NWAVES + wave - rot; if (gw < 0) gw += NGW;
    const int total = nkb * nblk;
    for (int r = gw; r < total; r += NGW) {
        const int kb = r / nblk, nb = r - kb * nblk; int scol = 32 * nb, drow = 32 * nb, nv = 32;
        if (MAP == 1) drow = 32 * ((nb >> 2) * 8 + (nb & 3));
        if (MAP == 2) drow = 32 * ((nb >> 2) * 8 + 4 + (nb & 3));
        if (MAP == 3) { scol = drow < 1024 ? drow : drow < 2048 ? drow + 1040 : drow < 3072 ? drow - 1024 : drow < 3584 ? drow + 16 : 2048; nv = drow < 3584 ? 32 : drow == 3584 ? 16 : 0; }
        if (MAP == 4) nv = drow >= MLA_IN ? 0 : 32;
        tr_item(W, ldw, scol, 64 * kb, dst, K, drow, scr, lane, nv, gain);
    }
    rot = (rot + total) % NGW;
}
__device__ __forceinline__ void conv_layer(Frame& F, int i, const ConvPtrs& cp) {
    PH_IDS();
    const int j = i >> 1; const bool gla = !(i & 1);
    LAS float* scr = (LAS float*)(F.lds + RING_OFF + wave * 16384);
    unsigned char* wb = F.ws + WS_WB; int rot = 0;
    conv_job<1>(F, cp.g0 + (size_t)i * DM * FF, FF, 16, 88, (bf16*)(wb + WB_GU0), DM, rot, scr, wave, lane, cp.n1 + i * DM);
    conv_job<2>(F, cp.u0 + (size_t)i * DM * FF, FF, 16, 88, (bf16*)(wb + WB_GU0), DM, rot, scr, wave, lane, cp.n1 + i * DM);
    conv_job<1>(F, cp.g1 + (size_t)i * DM * FF, FF, 16, 88, (bf16*)(wb + WB_GU1), DM, rot, scr, wave, lane, cp.n2 + i * DM);
    conv_job<2>(F, cp.u1 + (size_t)i * DM * FF, FF, 16, 88, (bf16*)(wb + WB_GU1), DM, rot, scr, wave, lane, cp.n2 + i * DM);
    conv_job<0>(F, cp.d0 + (size_t)i * FF * DM, DM, 44, 32, (bf16*)(wb + WB_D0), FF, rot, scr, wave, lane, nullptr);
    conv_job<0>(F, cp.d1 + (size_t)i * FF * DM, DM, 44, 32, (bf16*)(wb + WB_D1), FF, rot, scr, wave, lane, nullptr);
    conv_job<0>(F, cp.wo + (size_t)i * 1536 * DM, DM, 24, 32, (bf16*)(wb + WB_WO), 1536, rot, scr, wave, lane, nullptr);
    if (gla) conv_job<3>(F, cp.gin + (size_t)j * DM * GLA_IN, GLA_IN, 16, 120, (bf16*)(wb + WB_IN), DM, rot, scr, wave, lane, cp.nm + i * DM);
    else {
        conv_job<4>(F, cp.min + (size_t)j * DM * MLA_IN, MLA_IN, 16, 40, (bf16*)(wb + WB_IN), DM, rot, scr, wave, lane, cp.nm + i * DM);
        conv_job<0>(F, cp.uq + (size_t)j * 384 * QW, QW, 6, 48, (bf16*)(wb + WB_UQ), 384, rot, scr, wave, lane, nullptr);
        conv_job<0>(F, cp.ukv + (size_t)j * 256 * KVW, KVW, 4, 64, (bf16*)(wb + WB_UKV), 256, rot, scr, wave, lane, nullptr);
    }
}
__device__ __forceinline__ void ph_mla_rowprep(Frame& F, const float* gq, const float* gkv, const float* gkr, const bool dry = false) {
    PH_IDS();
    const int gw = F.vcu * NWAVES + wave, NGW = F.G * NWAVES;
    bf16* P = (bf16*)(F.ws + WS_PM); bf16* KR = (bf16*)(F.ws + WS_KR); const float* rope = (const float*)(F.ws + WS_ROPE);
    f32x4 ga[2], gb[2];
    { const float* g = lane < 48 ? gq + 8 * lane : gkv + 8 * (lane - 48); ga[0] = *(const f32x4*)g; ga[1] = *(const f32x4*)(g + 4); }
    { const float* g = lane < 16 ? gkv + 8 * (16 + lane) : gkr + 8 * ((lane - 16) & 7); gb[0] = *(const f32x4*)g; gb[1] = *(const f32x4*)(g + 4); }
    for (int m = gw; m < M; m += NGW) {
        bf16* p = P + (size_t)m * PM;
        const bf16x8 c0 = *(const bf16x8*)(p + 8 * lane);
        bf16x8 c1 = (bf16x8){0, 0, 0, 0, 0, 0, 0, 0}; if (lane < 24) c1 = *(const bf16x8*)(p + 512 + 8 * lane);
        float a[8], b[8]; float s0 = 0.f, s1 = 0.f;
#pragma unroll
        for (int e = 0; e < 8; ++e) { a[e] = bf2f((bf16)c0[e]); b[e] = bf2f((bf16)c1[e]); s0 += a[e] * a[e]; s1 += b[e] * b[e]; }
        const float sq = wave_sum(lane < 48 ? s0 : 0.f), skv = wave_sum((lane >= 48 ? s0 : 0.f) + (lane < 16 ? s1 : 0.f)), skr = wave_sum((lane >= 16 && lane < 24) ? s1 : 0.f);
        const float rq = 1.0f / sqrtf(sq * (1.f / 384.f) + EPS), rkv = 1.0f / sqrtf(skv * (1.f / 256.f) + EPS), rkr = 1.0f / sqrtf(skr * (1.f / 64.f) + EPS);
        const float r0 = lane < 48 ? rq : rkv, r1 = lane < 16 ? rkv : rkr;
        f32x4 x0, x1, y0, y1;
#pragma unroll
        for (int e = 0; e < 4; ++e) { x0[e] = a[e] * r0 * ga[0][e]; x1[e] = a[4 + e] * r0 * ga[1][e]; y0[e] = b[e] * r1 * gb[0][e]; y1[e] = b[4 + e] * r1 * gb[1][e]; }
        if (!dry) *(bf16x8*)(p + 8 * lane) = att::pack8(x0, x1);
        if (lane < 16 && !dry) *(bf16x8*)(p + 512 + 8 * lane) = att::pack8(y0, y1);
        const int ck = (lane - 16) & 7, pos = m % SEQ; const float* cp = rope + pos * 32 + 8 * (ck & 3); const float* sp = cp + SEQ * 32;
        const f32x4 cs0 = *(const f32x4*)cp, cs1 = *(const f32x4*)(cp + 4), sn0 = *(const f32x4*)sp, sn1 = *(const f32x4*)(sp + 4);
        f32x4 o0, o1;
#pragma unroll
        for (int e = 0; e < 4; ++e) { const float t0 = __shfl_xor(y0[e], 4), t1 = __shfl_xor(y1[e], 4);
            o0[e] = ck < 4 ? (y0[e] * cs0[e] - t0 * sn0[e]) : (t0 * sn0[e] + y0[e] * cs0[e]);
            o1[e] = ck < 4 ? (y1[e] * cs1[e] - t1 * sn1[e]) : (t1 * sn1[e] + y1[e] * cs1[e]); }
        if (lane >= 16 && lane < 24 && !dry) *(bf16x8*)(KR + (size_t)m * 64 + 8 * ck) = att::pack8(o0, o1);
    }
}
__device__ __forceinline__ void ph_mla_knorm(Frame& F, const float* gkn, const bool dry = false) {
    PH_IDS();
    const int gw = F.vcu * NWAVES + wave, NGW = F.G * NWAVES; bf16* KV = (bf16*)(F.ws + WS_KV);
    f32x4 g[4];
#pragma unroll
    for (int q = 0; q < 4; ++q) g[q] = *(const f32x4*)(gkn + (lane & 7) * 16 + 4 * q);
    for (int m = gw; m < M; m += NGW) {
        bf16* p = KV + (size_t)m * KVW + (lane >> 3) * 256 + (lane & 7) * 16;
        const bf16x8 c0 = *(const bf16x8*)p, c1 = *(const bf16x8*)(p + 8);
        float a[16]; float s = 0.f;
#pragma unroll
        for (int e = 0; e < 8; ++e) { a[e] = bf2f((bf16)c0[e]); a[8 + e] = bf2f((bf16)c1[e]); s += a[e] * a[e] + a[8 + e] * a[8 + e]; }
        s += __shfl_xor(s, 1); s += __shfl_xor(s, 2); s += __shfl_xor(s, 4);
        const float rstd = 1.0f / sqrtf(s * (1.f / 128.f) + EPS);
        f32x4 x[4];
#pragma unroll
        for (int q = 0; q < 4; ++q)
#pragma unroll
            for (int e = 0; e < 4; ++e) x[q][e] = a[4 * q + e] * rstd * g[q][e];
        if (!dry) { *(bf16x8*)p = att::pack8(x[0], x[1]); *(bf16x8*)(p + 8) = att::pack8(x[2], x[3]); }
    }
}
__device__ __forceinline__ float wave_absmax(const float* g, int n, int lane) {
    float m = fabsf(g[lane]); if (n > 64) m = fmaxf(m, fabsf(g[64 + lane]));
#pragma unroll
    for (int o = 1; o < 64; o <<= 1) m = fmaxf(m, __shfl_xor(m, o));
    return m;
}
__device__ __forceinline__ void ph_memattn(Frame& F, int layer, bool gla, const float* qgain, const float* kgain, const bool dry = false) {
    float bnd; { PH_IDS(); bnd = 0.08838834764831845f * 128.f * wave_absmax(qgain, 128, lane) * wave_absmax(kgain, 128, lane) * 1.03f; if (!(bnd < 40.f)) bnd = 0.f; }
    const bf16* memkv = (const bf16*)(F.ws + WS_MEMKV) + (size_t)layer * 1024 * 1024;
    for (int x = F.vcu; x < 512; x += F.G) {
        const int b = x >> 7, h = (x >> 5) & 3, qb = x & 31; const size_t row0 = (size_t)b * SEQ + 256 * qb;
        const bf16* Q; bf16* O; int ldq, ldo;
        if (gla) { bf16* P = (bf16*)(F.ws + WS_PG); Q = P + row0 * PG + PG_QM + h * 128; O = P + row0 * PG + PG_QM + h * 128; ldq = PG; ldo = PG; }
        else { Q = (const bf16*)(F.ws + WS_PM) + row0 * PM + PM_QM + h * 128; O = F.OC + row0 * OCW + 1024 + h * 128; ldq = PM; ldo = OCW; }
        const bf16* Kn = memkv + (size_t)b * NMEM * 1024 + h * 128;
        att::attn_block<0, false, 1>((LAS char*)F.lds, Q, ldq, Kn, 1024, nullptr, Kn + 512, 1024, O, ldo, 4, 0, 0.08838834764831845f, bnd, qgain, nullptr, nullptr, dry);
    }
}

__device__ __forceinline__ void ph_mla_attn(Frame& F, const float* gqn, const float* gqr, const float* gkn, const float* gkr, const bool dry = false) {
    float bnd; { PH_IDS(); bnd = 0.07216878364870322f * (128.f * wave_absmax(gqn, 128, lane) * wave_absmax(gkn, 128, lane) + 64.f * wave_absmax(gqr, 64, lane) * wave_absmax(gkr, 64, lane)) * 1.03f; if (!(bnd < 40.f)) bnd = 0.f; }
    const bf16* Qb = (const bf16*)(F.ws + WS_Q); const bf16* KVb = (const bf16*)(F.ws + WS_KV); const bf16* KRb = (const bf16*)(F.ws + WS_KR); bf16* OC = F.OC;
    const float* rope = (const float*)(F.ws + WS_ROPE);
    for (int x = F.vcu; x < 512; x += F.G) {
        const int bh = x >> 4, y = x & 15, b = bh >> 3, h = bh & 7;
        for (int pass = 0; pass < 2; ++pass) {
            const int qb = pass ? y : 31 - y; const size_t row0 = (size_t)b * SEQ + 256 * qb; const bf16* Kn = KVb + (size_t)b * SEQ * KVW + h * 256;
            att::attn_block<4, true, 2>((LAS char*)F.lds, Qb + row0 * QW + h * 192, QW, Kn, KVW, KRb + (size_t)b * SEQ * 64, Kn + 128, KVW, OC + row0 * OCW + h * 128, OCW,
                                        4 * (qb + 1), 256 * qb, 0.07216878364870322f, bnd, gqn, gqr, rope, dry);
        }
    }
}

constexpr int GCH = 128, GNU = 1024;
__device__ __forceinline__ void ph_gla_prep(Frame& F, const float* wa  , const float* ba  , const bool dry = false) {
    PH_IDS();
    const int u4 = wave >> 1, c = tid & 127;
    bf16* P = (bf16*)(F.ws + WS_PG); const float* ALOW = (const float*)(F.ws + WS_ALOW); float* GV = (float*)(F.ws + WS_GV);
    for (int ub = F.vcu * 4; ub < GNU; ub += F.G * 4) {
        const int unit = ub + u4, h = unit & 3; const size_t row0 = (size_t)(unit >> 2) * GCH;
        float w[16];
#pragma unroll
        for (int k = 0; k < 16; ++k) w[k] = wa[k * 512 + h * 128 + c];
        const float bias = ba[h * 128 + c];
        float bc[64]; float run = 0.f, bref = 0.f;
#pragma unroll
        for (int hf = 0; hf < 2; ++hf) {
            const float* al = ALOW + (row0 + 64 * hf) * 16;
#pragma unroll
            for (int r = 0; r < 64; ++r) { float z = bias;
#pragma unroll
                for (int k = 0; k < 16; ++k) z += al[r * 16 + k] * w[k];
                const float ls = fminf(z, 0.f) - 0.6931471805599453f * __builtin_amdgcn_logf(1.0f + __builtin_amdgcn_exp2f(-1.4426950408889634f * fabsf(z)));
                run += ls * (1.f / 16.f); bc[r] = run; }
            if (hf == 0) bref = bc[63];
            bf16* qp = P + (row0 + 64 * hf) * PG + PG_Q + h * 128 + c; bf16* kp = P + (row0 + 64 * hf) * PG + PG_K + h * 128 + c;
#pragma unroll
            for (int r = 0; r < 64; ++r) { const float qv = bf2f(qp[(size_t)r * PG]), kv = bf2f(kp[(size_t)r * PG]);
                const float eq = __builtin_amdgcn_exp2f(1.4426950408889634f * (bc[r] - bref));
                if (!dry) { qp[(size_t)r * PG] = f2bf(qv * eq * 0.08838834764831845f); kp[(size_t)r * PG] = f2bf(kv * __builtin_amdgcn_rcpf(eq)); } }
        }
        const float blast = run;
        float* gv = GV + (size_t)unit * 384 + c;
        if (!dry) { gv[0] = __builtin_amdgcn_exp2f(1.4426950408889634f * blast); gv[128] = __builtin_amdgcn_exp2f(1.4426950408889634f * (blast - bref)); gv[256] = __builtin_amdgcn_exp2f(1.4426950408889634f * bref); }
    }
}
#define GL_TRRD(dst, base, off) asm volatile("ds_read_b64_tr_b16 %0, %1 offset:%2" : "=&v"(dst) : "v"(base), "i"(off) : "memory")
#define GL_FRAG(out, base, d0, ks) do { att::s16x4 l_, h_; GL_TRRD(l_, base, (d0) * 512 + (ks) * 4096); GL_TRRD(h_, base, (d0) * 512 + (ks) * 4096 + 2048); \
        asm volatile("s_waitcnt lgkmcnt(0)" ::: "memory"); __builtin_amdgcn_sched_barrier(0); out = (bf16x8){l_[0], l_[1], l_[2], l_[3], h_[0], h_[1], h_[2], h_[3]}; } while (0)
#define GL_STAGE_V() do { const bf16* vp = P + (row0 + sr) * PG + PG_V + h * 256 + sc; \
        _Pragma("unroll") for (int q4 = 0; q4 < 4; ++q4) { const bf16x8 x0 = *(const bf16x8*)(vp + (size_t)(32 * q4) * PG), x1 = *(const bf16x8*)(vp + (size_t)(32 * q4) * PG + 128); \
            const int o_ = (q4 >> 1) * 32768 + ((q4 & 1) ? vst1 : vst0); *(LAS bf16x8*)(lds + o_) = x0; *(LAS bf16x8*)(lds + o_ + 16384) = x1; } } while (0)
__device__ __forceinline__ void ph_gla_u(Frame& F) {
    PH_IDS();
    const int r32 = lane & 31, hi = lane >> 5, sr = tid >> 4, sc = (tid & 15) * 8;
    const bf16* P = (const bf16*)(F.ws + WS_PG); bf16* US = (bf16*)(F.ws + WS_US); const float* GV = (const float*)(F.ws + WS_GV);
    LAS char* lds = (LAS char*)F.lds;
    const int vst0 = att::v_st(sr, sc), vst1 = att::v_st(32 + sr, sc);
    const int vbA = (int)(uintptr_t)lds + att::v_rd_base(lane) + (wave >> 2) * 16384 + (wave & 3) * 512, vbB = (int)(uintptr_t)lds + att::v_rd_base(lane) + 65536;
    for (int unit = F.vcu; unit < GNU; unit += F.G) {
        const int h = unit & 3; const size_t row0 = (size_t)(unit >> 2) * GCH;
        GL_STAGE_V();
        { const bf16* kp = P + (row0 + sr) * PG + PG_K + h * 128 + sc;
#pragma unroll
          for (int q4 = 0; q4 < 4; ++q4) { const bf16x8 x0 = *(const bf16x8*)(kp + (size_t)(32 * q4) * PG); *(LAS bf16x8*)(lds + 65536 + (q4 >> 1) * 16384 + ((q4 & 1) ? vst1 : vst0)) = x0; } }
        __syncthreads();
        att::f32x16 acc[4] = {};
#pragma unroll
        for (int jh = 0; jh < 2; ++jh)
#pragma unroll
            for (int ks = 0; ks < 4; ++ks) { bf16x8 a; GL_FRAG(a, vbA + jh * 32768, 0, ks);
#pragma unroll
                for (int nb = 0; nb < 4; ++nb) { bf16x8 b; GL_FRAG(b, vbB + jh * 16384, nb, ks); acc[nb] = __builtin_amdgcn_mfma_f32_32x32x16_bf16(a, b, acc[nb], 0, 0, 0); } }
        bf16* up = US + (size_t)unit * 32768 + (size_t)(wave * 32) * 128 + r32;
#pragma unroll
        for (int nb = 0; nb < 4; ++nb) { const float e2 = GV[(size_t)unit * 384 + 128 + nb * 32 + r32];
#pragma unroll
            for (int r = 0; r < 16; ++r) up[(size_t)att::crow(r, hi) * 128 + nb * 32] = f2bf(acc[nb][r] * e2); }
        __syncthreads();
    }
}
__device__ __forceinline__ void ph_gla_scan(Frame& F, const bool dry = false) {
    PH_IDS();
    bf16* US = (bf16*)(F.ws + WS_US); const float* GV = (const float*)(F.ws + WS_GV);
    for (int e = F.vcu * 512 + tid; e < 131072; e += F.G * 512) {
        const int dkq = e & 31, dv = (e >> 5) & 255, bh = e >> 13, b = bh >> 2, h = bh & 3;
        f32x4 S = (f32x4){0.f, 0.f, 0.f, 0.f};
        const size_t ustride = (size_t)4 * 32768;
        bf16* up = US + ((size_t)(b * 64) * 4 + h) * 32768 + (size_t)dv * 128 + dkq * 4;
        const float* gp = GV + ((size_t)(b * 64) * 4 + h) * 384 + dkq * 4;
        for (int n = 0; n < 64; n += 4) {
            u32x2 uu[4]; f32x4 dc[4], e1[4];
#pragma unroll
            for (int q = 0; q < 4; ++q) { uu[q] = *(const GAS u32x2*)(up + (size_t)(n + q) * ustride); dc[q] = *(const GAS f32x4*)(gp + (size_t)(n + q) * 4 * 384); e1[q] = *(const GAS f32x4*)(gp + (size_t)(n + q) * 4 * 384 + 256); }
#pragma unroll
            for (int q = 0; q < 4; ++q) {
                const f32x4 s1 = S * e1[q]; u32x2 w; w.x = cvt_pk_bf16(s1.x, s1.y); w.y = cvt_pk_bf16(s1.z, s1.w);
                if (!dry) *(GAS u32x2*)(up + (size_t)(n + q) * ustride) = w;
                f32x4 u; u.x = __uint_as_float(uu[q].x << 16); u.y = __uint_as_float(uu[q].x & 0xffff0000u); u.z = __uint_as_float(uu[q].y << 16); u.w = __uint_as_float(uu[q].y & 0xffff0000u);
                S = S * dc[q] + u; }
        }
    }
}
template <int B_> __device__ __forceinline__ bf16x8 gl_pk4(const att::f32x16& P) {
    const unsigned a0 = cvt_pk_bf16(P[B_ + 0], P[B_ + 1]), a1 = cvt_pk_bf16(P[B_ + 2], P[B_ + 3]), b0 = cvt_pk_bf16(P[B_ + 4], P[B_ + 5]), b1 = cvt_pk_bf16(P[B_ + 6], P[B_ + 7]);
    auto r0 = __builtin_amdgcn_permlane32_swap(a0, b0, false, false); auto r1 = __builtin_amdgcn_permlane32_swap(a1, b1, false, false);
    u32x4 w = {r0[0], r1[0], r0[1], r1[1]}; return __builtin_bit_cast(bf16x8, w);
}
__device__ __forceinline__ void ph_gla_out(Frame& F, const float* gout  , const bool dry = false) {
    PH_IDS();
    const int r32 = lane & 31, hi = lane >> 5, sr = tid >> 4, sc = (tid & 15) * 8, it = wave & 3, grp = wave >> 2;
    bf16* P = (bf16*)(F.ws + WS_PG); const bf16* US = (const bf16*)(F.ws + WS_US);
    LAS char* lds = (LAS char*)F.lds; LAS float* part = (LAS float*)(lds + 65536); LAS float* rstd_l = (LAS float*)(lds + 65536 + 1024);
    const int vst0 = att::v_st(sr, sc), vst1 = att::v_st(32 + sr, sc);
    const int vb = (int)(uintptr_t)lds + att::v_rd_base(lane) + grp * 16384;
    float g4[4];
#pragma unroll
    for (int blk = 0; blk < 4; ++blk) g4[blk] = gout[grp * 128 + blk * 32 + r32];
    for (int unit = F.vcu; unit < GNU; unit += F.G) {
        const int h = unit & 3; const size_t row0 = (size_t)(unit >> 2) * GCH;
        GL_STAGE_V();
        bf16x8 qr[8];
        { const bf16* qp = P + (row0 + 32 * it + r32) * PG + PG_Q + h * 128 + hi * 8;
#pragma unroll
          for (int d0 = 0; d0 < 8; ++d0) qr[d0] = *(const bf16x8*)(qp + d0 * 16); }
        __syncthreads();
        att::f32x16 o[4] = {};
#define GL_JT(jt) do { att::f32x16 p = {}; const bf16* kp = P + (row0 + 32 * (jt) + r32) * PG + PG_K + h * 128 + hi * 8; \
            _Pragma("unroll") for (int d0 = 0; d0 < 8; ++d0) { const bf16x8 kf = *(const bf16x8*)(kp + d0 * 16); p = __builtin_amdgcn_mfma_f32_32x32x16_bf16(kf, qr[d0], p, 0, 0, 0); } \
            if ((jt) == it) { _Pragma("unroll") for (int r = 0; r < 16; ++r) if (att::crow(r, hi) > r32) p[r] = 0.f; } \
            const bf16x8 paA = gl_pk4<0>(p), paB = gl_pk4<8>(p); \
            _Pragma("unroll") for (int blk = 0; blk < 4; ++blk) { bf16x8 vA, vB; GL_FRAG(vA, vb + ((jt) >> 1) * 32768, blk, 2 * ((jt) & 1)); GL_FRAG(vB, vb + ((jt) >> 1) * 32768, blk, 2 * ((jt) & 1) + 1); \
                o[blk] = __builtin_amdgcn_mfma_f32_32x32x16_bf16(paA, vA, o[blk], 0, 0, 0); o[blk] = __builtin_amdgcn_mfma_f32_32x32x16_bf16(paB, vB, o[blk], 0, 0, 0); } } while (0)
        GL_JT(0);
        if (it >= 1) GL_JT(1);
        if (it >= 2) GL_JT(2);
        if (it >= 3) GL_JT(3);
#undef GL_JT
        { const bf16* sp = US + (size_t)unit * 32768 + (size_t)(grp * 128 + r32) * 128 + hi * 8;
#pragma unroll
          for (int ks = 0; ks < 8; ++ks)
#pragma unroll
              for (int blk = 0; blk < 4; ++blk) { const bf16x8 b0 = *(const bf16x8*)(sp + (size_t)(blk * 32) * 128 + ks * 16); o[blk] = __builtin_amdgcn_mfma_f32_32x32x16_bf16(qr[ks], b0, o[blk], 0, 0, 0); } }
        float v16[16];
#pragma unroll
        for (int r = 0; r < 16; ++r) v16[r] = (o[0][r] * o[0][r] + o[1][r] * o[1][r]) + (o[2][r] * o[2][r] + o[3][r] * o[3][r]);
        float w8[8], w4[4], w2[2], w1;
        { const bool up = (lane & 16) != 0;
#pragma unroll
          for (int q = 0; q < 8; ++q) { const float keep = up ? v16[8 + q] : v16[q], send = up ? v16[q] : v16[8 + q]; w8[q] = keep + __shfl_xor(send, 16); } }
        { const bool up = (lane & 8) != 0;
#pragma unroll
          for (int q = 0; q < 4; ++q) { const float keep = up ? w8[4 + q] : w8[q], send = up ? w8[q] : w8[4 + q]; w4[q] = keep + __shfl_xor(send, 8); } }
        { const bool up = (lane & 4) != 0;
#pragma unroll
          for (int q = 0; q < 2; ++q) { const float keep = up ? w4[2 + q] : w4[q], send = up ? w4[q] : w4[2 + q]; w2[q] = keep + __shfl_xor(send, 4); } }
        { const bool up = (lane & 2) != 0; const float keep = up ? w2[1] : w2[0], send = up ? w2[0] : w2[1]; w1 = keep + __shfl_xor(send, 2); }
        w1 += __shfl_xor(w1, 1);
        if ((lane & 1) == 0) part[(it * 32 + att::crow(r32 >> 1, hi)) * 2 + grp] = w1;
        __syncthreads();
        if (tid < 128) rstd_l[tid] = 1.0f / sqrtf((part[tid * 2] + part[tid * 2 + 1]) * (1.f / 256.f) + EPS);
        __syncthreads();
#pragma unroll
        for (int r = 0; r < 16; ++r) { const int i = 32 * it + att::crow(r, hi); const float rs = rstd_l[i];
            bf16* rowp = P + (row0 + i) * PG + h * 256 + grp * 128 + r32;
#pragma unroll
            for (int blk = 0; blk < 4; ++blk) { const float rg = bf2f(rowp[PG_R + blk * 32]);
                if (!dry) rowp[PG_V + blk * 32] = f2bf(o[blk][r] * rs * g4[blk] * fast_silu(rg)); } }
        __syncthreads();
    }
}
#undef GL_STAGE_V

constexpr int PID_END = 16 * 9;
#ifndef PROBE_PID
#define PROBE_PID (-1)
#endif
#ifndef PROBE_N
#define PROBE_N 1
#endif
#ifndef PROBE_PID2
#define PROBE_PID2 (-1)
#endif
#ifndef PROBE_PID3
#define PROBE_PID3 (-1)
#endif
#define NREP(k) ((((k) == PROBE_PID) || ((k) == PROBE_PID2) || ((k) == PROBE_PID3)) ? PROBE_N : 1)
#ifndef GU_ALIGN
#define GU_ALIGN true
#endif
#ifndef REV_GU
#define REV_GU 0
#endif
#ifndef REV_DOWN
#define REV_DOWN 1
#endif
#ifndef REV_OUT
#define REV_OUT 1
#endif
#ifndef REV_IN
#define REV_IN 0
#endif
#define REP(k) for (int rep_ = 0; rep_ < NREP(k); ++rep_)
#define DRY(k) (rep_ + 1 < NREP(k))
__global__ void __launch_bounds__(NWAVES * 64, 2) mk_fwd(MArgs args) {
    extern __shared__ __attribute__((aligned(16))) unsigned char lds_raw[];
    Frame F;
    F.lds = (LAS unsigned char*)lds_raw;
    F.G = gridDim.x; { const int bx = blockIdx.x; F.vcu = (F.G % 8 == 0) ? (bx % 8) * (F.G / 8) + bx / 8 : bx; }
    F.X = args.out; F.ws = args.ws; F.OC = (bf16*)args.out;
    volatile LAS unsigned* MISC = (volatile LAS unsigned*)(F.lds + MISC_OFF);
    for (int u = threadIdx.x; u < 128; u += NWAVES * 64) MISC[u] = 0u;
    __syncthreads();
    XcdBarrier bar = xcd_barrier_post((unsigned*)(F.ws + WS_CTL) + CW_BAR + args.region * XCD_BAR_WORDS, MISC + 8);
    const int lo = args.lo, hi = args.hi;
#define IN(k) (lo <= (k) && (k) < hi)
#define SEAM(k) do { if ((k) + 1 < hi) xcd_barrier(bar); } while (0)
    unsigned char* ws = F.ws; unsigned char* wb = ws + WS_WB;

    LAS unsigned char* rstab = F.lds + XTRA_OFF;
    float* RS = (float*)(ws + WS_RS); LAS float* rspart = (LAS float*)(F.lds + XTRA_OFF + 8192);
#define OPQ(k) ({ const float* p_ = args.in[k]; asm volatile("" : "+s"(p_)); p_; })
#define CONV(layer) do { const ConvPtrs cp{OPQ(3), OPQ(4), OPQ(5), OPQ(7), OPQ(8), OPQ(9), OPQ(11), OPQ(16), OPQ(20), OPQ(23), OPQ(24), OPQ(2), OPQ(6), OPQ(10)}; conv_layer(F, (layer), cp); } while (0)

    if (IN(0)) { REP(0) { ph_prologue(F, args.in[0], args.in[1], args.in[12], args.in[13]); CONV(0); } SEAM(0); }
    if (IN(1)) {
        pg8::Gemm g{(const bf16*)(ws + WS_MEMH), (const bf16*)(ws + WS_MEMW), 4096, 4096, DM, DM, DM}; pg8::DiagOrder S{F.G, (int)blockIdx.x, 4};
        pg8::EpiBf16<false> E{(bf16*)(ws + WS_MEMKV), 1024, 3};
        pg8::gemm_phase<pg8::EpiBf16<false>, pg8::DiagOrder, PG8_ALIGN, PG8_SP2>(F.lds + RING_OFF, g, S, E);
        SEAM(1);
    }
    if (IN(2)) { ph_memknorm(F, args.in[15]); SEAM(2); }

    for (int it = 0; it < 8; ++it) {
        const int pb = 16 * (it + 1), i = it >> 1, half = it & 1, j = i >> 1;
        if (pb + 16 <= lo || pb >= hi) continue;
        if (half) {
            const bool gla = !(i & 1);
            if (IN(pb + 1)) REP(pb + 1) {
                if (gla) {
                    pg8::Gemm g{(const bf16*)(ws + WS_XN), (const bf16*)(wb + WB_IN), M, 3840, DM, DM, DM}; pg8::StaticOrder S; S.init(M, 3840, F.G, (int)blockIdx.x, REV_IN);
                    pg8::EpiGlaIn E{(bf16*)(ws + WS_PG), (float*)(ws + WS_ALOW)};
                    pg8::gemm_phase<pg8::EpiGlaIn, pg8::StaticOrder, PG8_ALIGN, PG8_SP2>(F.lds + RING_OFF, g, S, E, RS + (size_t)(3 * i + 1) * 4 * M, rstab);
                } else {
                    pg8::Gemm g{(const bf16*)(ws + WS_XN), (const bf16*)(wb + WB_IN), M, PM, DM, DM, DM}; pg8::StaticOrder S; S.init(M, PM, F.G, (int)blockIdx.x, REV_IN);
                    pg8::EpiBf16<true> E{(bf16*)(ws + WS_PM), PM, 0x7fffffff};
                    pg8::gemm_phase<pg8::EpiBf16<true>, pg8::StaticOrder, PG8_ALIGN, PG8_SP2>(F.lds + RING_OFF, g, S, E, RS + (size_t)(3 * i + 1) * 4 * M, rstab);
                }
                if (rep_ + 1 == NREP(pb + 1)) SEAM(pb + 1);
            }
            if (gla) {
                if (IN(pb + 2)) { REP(pb + 2) { ph_gla_prep(F, args.in[17] + (size_t)j * 16 * 512, args.in[18] + j * 512, DRY(pb + 2)); ph_memattn(F, i, true, args.in[14] + i * 128, args.in[15] + i * 128, DRY(pb + 2)); } SEAM(pb + 2); }
                if (IN(pb + 3)) { REP(pb + 3) ph_gla_u(F); SEAM(pb + 3); }
                if (IN(pb + 4)) { REP(pb + 4) ph_gla_scan(F, DRY(pb + 4)); SEAM(pb + 4); }
                if (IN(pb + 5)) { REP(pb + 5) ph_gla_out(F, args.in[19] + j * 256, DRY(pb + 5)); SEAM(pb + 5); }
            }
            if (IN(pb + 2) && !gla) { REP(pb + 2) { ph_mla_rowprep(F, args.in[21] + j * 384, args.in[22] + j * 256, args.in[28] + j * 64, DRY(pb + 2)); ph_memattn(F, i, false, args.in[14] + i * 128, args.in[15] + i * 128, DRY(pb + 2)); } SEAM(pb + 2); }
            if (IN(pb + 3) && !gla) REP(pb + 3) {
                { pg8::Gemm g{(const bf16*)(ws + WS_PM) + PM_CQ, (const bf16*)(wb + WB_UQ), M, QW, 384, PM, 384}; pg8::StaticOrder S; S.init(M, QW, F.G, (int)blockIdx.x);
                  pg8::EpiBf16<false> E{(bf16*)(ws + WS_Q), QW, 0x7fffffff};
                  pg8::gemm_phase<pg8::EpiBf16<false>, pg8::StaticOrder, PG8_ALIGN, PG8_SP2>(F.lds + RING_OFF, g, S, E); }
                { pg8::Gemm g{(const bf16*)(ws + WS_PM) + PM_CKV, (const bf16*)(wb + WB_UKV), M, KVW, 256, PM, 256}; pg8::StaticOrder S; S.init(M, KVW, F.G, (int)blockIdx.x);
                  pg8::EpiBf16<false> E{(bf16*)(ws + WS_KV), KVW, 0x7fffffff};
                  pg8::gemm_phase<pg8::EpiBf16<false>, pg8::StaticOrder, PG8_ALIGN, PG8_SP2>(F.lds + RING_OFF, g, S, E); }
                if (rep_ + 1 == NREP(pb + 3)) SEAM(pb + 3);
            }
            if (IN(pb + 4) && !gla) { REP(pb + 4) ph_mla_knorm(F, args.in[27] + j * 128, DRY(pb + 4)); SEAM(pb + 4); }
            if (IN(pb + 5) && !gla) { REP(pb + 5) ph_mla_attn(F, args.in[25] + j * 128, args.in[26] + j * 64, args.in[27] + j * 128, args.in[28] + j * 64, DRY(pb + 5)); SEAM(pb + 5); }
            if (IN(pb + 6)) {
                pg8::Gemm g{gla ? (const bf16*)(ws + WS_PG) + PG_V : (const bf16*)F.OC, (const bf16*)(wb + WB_WO), M, DM, 1536, gla ? PG : OCW, 1536};
                pg8::StaticOrder S; S.init(M, DM, F.G, (int)blockIdx.x, REV_OUT);
                REP(pb + 6) { pg8::EpiResid E{(bf16*)(ws + WS_XN), nullptr, RS + (size_t)(3 * i + 2) * 4 * M, rspart, DM, rep_ ? 0.0f : 1.0f};
                pg8::gemm_phase<pg8::EpiResid, pg8::StaticOrder, PG8_ALIGN, PG8_SP2>(F.lds + RING_OFF, g, S, E); }
                SEAM(pb + 6);
            }
        }
        if (IN(pb + 7) && !half && it > 0) { REP(pb + 7) CONV(i); SEAM(pb + 7); }
        if (IN(pb + 9)) {
            pg8::Gemm g{(const bf16*)(ws + WS_XN), (const bf16*)(wb + (half ? WB_GU1 : WB_GU0)), M, 2 * FF, DM, DM, DM}; pg8::StaticOrder S; S.init(M, 2 * FF, F.G, (int)blockIdx.x, REV_GU);
            pg8::EpiSwiGLU E{(bf16*)(ws + WS_H), FF};
#ifndef DN_SKIP
#define DN_SKIP 0
#endif
#ifdef GU_PK
#ifndef GU_SKIP
#define GU_SKIP 0
#endif
            REP(pb + 9) { pg8::Gemm g2 = g; if (DRY(pb + 9)) g2.K = GU_PK; pg8::gemm_phase<pg8::EpiSwiGLU, pg8::StaticOrder, GU_ALIGN, PG8_SP2>(F.lds + RING_OFF, g2, S, E, RS + (size_t)(3 * i + (half ? 2 : 0)) * 4 * M, rstab, GU_SKIP && DRY(pb + 9)); }
#else
            REP(pb + 9) pg8::gemm_phase<pg8::EpiSwiGLU, pg8::StaticOrder, GU_ALIGN, PG8_SP2>(F.lds + RING_OFF, g, S, E, RS + (size_t)(3 * i + (half ? 2 : 0)) * 4 * M, rstab);
#endif
            SEAM(pb + 9);
        }
        if (IN(pb + 10)) {
            pg8::Gemm g{(const bf16*)(ws + WS_H), (const bf16*)(wb + (half ? WB_D1 : WB_D0)), M, DM, FF, FF, FF}; pg8::StaticOrder S; S.init(M, DM, F.G, (int)blockIdx.x, REV_DOWN);
            const bool lastp = (it == 7);
            REP(pb + 10) { pg8::EpiResid E{(bf16*)(ws + WS_XN), lastp ? F.X : nullptr, RS + (size_t)(half ? 3 * (i + 1) : 3 * i + 1) * 4 * M, rspart, DM, rep_ ? 0.0f : 0.5f};
            pg8::gemm_phase<pg8::EpiResid, pg8::StaticOrder, PG8_ALIGN, PG8_SP2>(F.lds + RING_OFF, g, S, E, nullptr, nullptr, DN_SKIP && rep_ > 0); }
            SEAM(pb + 10);
        }
    }
#undef OPQ
#undef CONV
#undef IN
#undef SEAM
}
#ifndef FAST_GLA
#define FAST_GLA 0
#endif
#ifndef FAST_MLA_PREP
#define FAST_MLA_PREP 0
#endif
#ifndef FAST_MLA_ATT
#define FAST_MLA_ATT 0
#endif
extern "C" void kernel_launch(void* const* d_in, const int* in_sizes, int n_in, void* d_out, int out_size, void* d_ws, size_t ws_size, hipStream_t stream) {
    static int grid = 0;
    if (grid == 0) {
        if (n_in != 29 || out_size != M * DM || ws_size < WS_END) { fprintf(stderr, "kernel_launch: unexpected shapes (n_in %d out %d ws %zu)\n", n_in, out_size, ws_size); grid = -1; return; }
        int dev = 0, cus = 0, per_cu = 0;
        if (hipGetDevice(&dev) != hipSuccess || hipDeviceGetAttribute(&cus, hipDeviceAttributeMultiprocessorCount, dev) != hipSuccess) { grid = -1; return; }
        if (hipFuncSetAttribute((const void*)mk_fwd, hipFuncAttributeMaxDynamicSharedMemorySize, LDS_BYTES) != hipSuccess) { fprintf(stderr, "kernel_launch: hipFuncSetAttribute failed\n"); grid = -1; return; }
        if (hipOccupancyMaxActiveBlocksPerMultiprocessor(&per_cu, (const void*)mk_fwd, NWAVES * 64, LDS_BYTES) != hipSuccess || per_cu < 1)
            fprintf(stderr, "kernel_launch: note: occupancy query reports %d workgroups per CU\n", per_cu);
        (void)hipGetLastError();
        grid = cus;
    }
    if (grid < 0) return;
    const float* mem = (const float*)d_in[1]; (void)mem;
    const float* memq_norm = (const float*)d_in[14];
    const float* gla_w_alpha = (const float*)d_in[17]; const float* gla_b_alpha = (const float*)d_in[18]; const float* gla_out_norm = (const float*)d_in[19];
    const float* mla_q_norm = (const float*)d_in[21]; const float* mla_kv_norm = (const float*)d_in[22];
    const float* mla_qn = (const float*)d_in[25]; const float* mla_qr = (const float*)d_in[26]; const float* mla_kn = (const float*)d_in[27]; const float* mla_kr = (const float*)d_in[28];
    unsigned char* ws = (unsigned char*)d_ws;
    float* ROPE = (float*)(ws + WS_ROPE); bf16* MEMKV = (bf16*)(ws + WS_MEMKV); float* ALOW = (float*)(ws + WS_ALOW);
    bf16* KR = (bf16*)(ws + WS_KR); bf16* PGb = (bf16*)(ws + WS_PG); float* ALPHA = (float*)(ws + WS_US);
    bf16* OC = (bf16*)d_out; bf16* PMb = (bf16*)(ws + WS_PM); bf16* Qb = (bf16*)(ws + WS_Q); bf16* KVb = (bf16*)(ws + WS_KV);

    (void)hipMemsetAsync(ws + WS_CTL, 0, CTL_ZERO_BYTES, stream);
    MArgs a{};
    for (int k = 0; k < 29; ++k) a.in[k] = (const float*)d_in[k];
    a.out = (float*)d_out; a.ws = ws;
    int region = 0;
    auto mk = [&](int lo, int hi) { if (lo >= hi) return; a.lo = lo; a.hi = hi; a.region = region++; a.pad = 0; hipLaunchKernelGGL(mk_fwd, dim3(grid), dim3(NWAVES * 64), LDS_BYTES, stream, a); };
    int cur_lo = 0;
    for (int it = 1; it < 8; it += 2) {
        const int pb = 16 * (it + 1), i = it >> 1, j = i >> 1; const bool gla = !(i & 1);
        const bf16* memkv = MEMKV + (size_t)i * 1024 * 1024;
        if (gla) {
            if (!FAST_GLA) {
                mk(cur_lo, pb + 2);
                nv_gla_alpha<<<M * 512 / 256, 256, 0, stream>>>(ALOW, gla_w_alpha + (size_t)j * 16 * 512, gla_b_alpha + j * 512, ALPHA);
                nv_attn<128, false><<<dim3(SEQ / 64, 4, BATCH), 64, 0, stream>>>(PGb + PG_QM, PG, 128, memkv, 1024, 128, nullptr, 0, memkv + 512, 1024, 128, PGb + PG_QM, PG, 128, 4, SEQ, NMEM, 0.08838834764831845f, memq_norm + i * 128);
                nv_gla_rec<<<16, 256, 0, stream>>>(PGb, ALPHA, gla_out_norm + j * 256);
                cur_lo = pb + 6;
            }
        } else {
            if (!FAST_MLA_PREP) {
                mk(cur_lo, pb + 2);
                nv_attn<128, false><<<dim3(SEQ / 64, 4, BATCH), 64, 0, stream>>>(PMb + PM_QM, PM, 128, memkv, 1024, 128, nullptr, 0, memkv + 512, 1024, 128, OC + 1024, OCW, 128, 4, SEQ, NMEM, 0.08838834764831845f, memq_norm + i * 128);
                nv_mla_rowprep<<<M / 4, 256, 0, stream>>>(PMb, mla_q_norm + j * 384, mla_kv_norm + j * 256, mla_kr + j * 64, ROPE, KR);
                cur_lo = pb + 3;
            }
            if (!FAST_MLA_ATT) {
                mk(cur_lo, pb + 4);
                nv_mla_headprep<<<M * 8 / 4, 256, 0, stream>>>(Qb, KVb, mla_qn + j * 128, mla_qr + j * 64, mla_kn + j * 128, ROPE);
                nv_attn<192, true><<<dim3(SEQ / 64, 8, BATCH), 64, 0, stream>>>(Qb, QW, 192, KVb, KVW, 256, KR, 64, KVb + 128, KVW, 256, OC, OCW, 128, 8, SEQ, SEQ, 0.07216878364870322f, nullptr);
                cur_lo = pb + 6;
            }
        }
    }
    mk(cur_lo, PID_END);
}
```

```cpp
#define FAST_GLA 1
#define FAST_MLA_PREP 1
#define FAST_MLA_ATT 1
#define KV_FUSED 1
#include <hip/hip_runtime.h>
#include <cstdio>
#include <cstdint>

typedef unsigned short bf16;
typedef short bf16x8 __attribute__((ext_vector_type(8)));
typedef float f32x4 __attribute__((ext_vector_type(4)));

constexpr int BATCH = 4, SEQ = 8192, DM = 1024, DEPTH = 4, NMEM = 256, FF = 2816;
constexpr int M = BATCH * SEQ;
constexpr float EPS = 1e-6f;
constexpr int GLA_IN = 3600, MLA_IN = 1216;
constexpr int PG = 3584;
constexpr int PG_Q = 0, PG_K = 512, PG_R = 1024, PG_V = 2048, PG_QM = 3072;
constexpr int PM = 1280;
constexpr int PM_CQ = 0, PM_CKV = 384, PM_KR = 640, PM_QM = 704;
constexpr int QW = 1536, KVW = 2048, OCW = 1536;

constexpr size_t MiB = 1u << 20;
constexpr size_t WS_CTL = 0;
constexpr size_t WS_ROPE = 28 * MiB;
constexpr size_t WS_MEMKV = 3 * MiB;
constexpr size_t WS_MEMH = 11 * MiB;
constexpr size_t WS_ALOW = 19 * MiB;
constexpr size_t WS_GV = 21 * MiB;
constexpr size_t WS_KR = 24 * MiB;
constexpr size_t WS_WB = 32 * MiB;
constexpr size_t WS_XN = 84 * MiB;
constexpr size_t WS_BIG = 148 * MiB;
constexpr size_t WS_H = WS_BIG;
constexpr size_t WS_PG = WS_BIG;
constexpr size_t WS_US = 372 * MiB;
constexpr size_t WS_PM = 180 * MiB;
constexpr size_t WS_Q = 260 * MiB;
constexpr size_t WS_KV = 356 * MiB;
constexpr size_t WS_END = 500 * MiB;

__device__ __forceinline__ float bf2f(bf16 b) { return __uint_as_float(((unsigned)b) << 16); }
__device__ __forceinline__ bf16 f2bf(float f) { unsigned u = __float_as_uint(f); return (bf16)((u + 0x7fffu + ((u >> 16) & 1u)) >> 16); }
__device__ __forceinline__ float wave_sum(float v) {
#pragma unroll
    for (int o = 1; o < 64; o <<= 1) v += __shfl_xor(v, o);
    return v;
}
__device__ __forceinline__ float silu_f(float x) { return x / (1.f + __expf(-x)); }

struct ColMap { int t0, a0, t1, a1, t2, a2, a3, nvalid; };
__device__ __forceinline__ int cm_src(const ColMap& c, int n) { return n + (n < c.t0 ? c.a0 : n < c.t1 ? c.a1 : n < c.t2 ? c.a2 : c.a3); }
static ColMap cm_identity(int nvalid) { ColMap c; c.t0 = 1 << 30; c.a0 = 0; c.t1 = 1 << 30; c.a1 = 0; c.t2 = 1 << 30; c.a2 = 0; c.a3 = 0; c.nvalid = nvalid; return c; }

template <int EPI>
__global__ __launch_bounds__(256) void nv_gemm(const bf16* __restrict__ A, int lda, const float* __restrict__ W, const float* __restrict__ W2, int ldw, ColMap cm,
                                               int K, void* Cv, int ldc, float scale, int nstore) {
    __shared__ __attribute__((aligned(16))) bf16 sA[64][40];
    __shared__ __attribute__((aligned(16))) bf16 sB[64][40];
    __shared__ __attribute__((aligned(16))) bf16 sB2[64][40];
    const int tid = threadIdx.x, lane = tid & 63, wid = tid >> 6;
    const int m0 = blockIdx.y * 64, n0 = blockIdx.x * 64;
    const int wm = (wid >> 1) * 32, wn = (wid & 1) * 32;
    f32x4 acc[2][2], acc2[2][2];
#pragma unroll
    for (int i = 0; i < 2; ++i)
#pragma unroll
        for (int j = 0; j < 2; ++j) { acc[i][j] = (f32x4){0.f, 0.f, 0.f, 0.f}; acc2[i][j] = (f32x4){0.f, 0.f, 0.f, 0.f}; }
    const int ar = tid >> 2, ac = (tid & 3) * 8;
    const int bk = tid >> 3, bn = (tid & 7) * 8;
    const int ncol = n0 + bn; const bool nval = ncol < cm.nvalid; const int src = cm_src(cm, ncol);
    for (int k0 = 0; k0 < K; k0 += 32) {
        const bf16x8 av = *(const bf16x8*)(A + (size_t)(m0 + ar) * lda + k0 + ac);
        f32x4 w0 = (f32x4){0.f, 0.f, 0.f, 0.f}, w1 = w0, u0 = w0, u1 = w0;
        if (nval) { const float* wp = W + (size_t)(k0 + bk) * ldw + src; w0 = *(const f32x4*)wp; w1 = *(const f32x4*)(wp + 4);
            if (EPI == 1) { const float* up = W2 + (size_t)(k0 + bk) * ldw + src; u0 = *(const f32x4*)up; u1 = *(const f32x4*)(up + 4); } }
        *(bf16x8*)&sA[ar][ac] = av;
#pragma unroll
        for (int j = 0; j < 4; ++j) { sB[bn + j][bk] = f2bf(w0[j]); sB[bn + 4 + j][bk] = f2bf(w1[j]); }
        if (EPI == 1) {
#pragma unroll
            for (int j = 0; j < 4; ++j) { sB2[bn + j][bk] = f2bf(u0[j]); sB2[bn + 4 + j][bk] = f2bf(u1[j]); } }
        __syncthreads();
        bf16x8 a[2], b[2], b2[2];
#pragma unroll
        for (int i = 0; i < 2; ++i) { a[i] = *(const bf16x8*)&sA[wm + i * 16 + (lane & 15)][(lane >> 4) * 8]; b[i] = *(const bf16x8*)&sB[wn + i * 16 + (lane & 15)][(lane >> 4) * 8];
            if (EPI == 1) b2[i] = *(const bf16x8*)&sB2[wn + i * 16 + (lane & 15)][(lane >> 4) * 8]; }
#pragma unroll
        for (int i = 0; i < 2; ++i)
#pragma unroll
            for (int j = 0; j < 2; ++j) { acc[i][j] = __builtin_amdgcn_mfma_f32_16x16x32_bf16(a[i], b[j], acc[i][j], 0, 0, 0);
                if (EPI == 1) acc2[i][j] = __builtin_amdgcn_mfma_f32_16x16x32_bf16(a[i], b2[j], acc2[i][j], 0, 0, 0); }
        __syncthreads();
    }
#pragma unroll
    for (int i = 0; i < 2; ++i)
#pragma unroll
        for (int j = 0; j < 2; ++j)
#pragma unroll
            for (int r = 0; r < 4; ++r) {
                const int row = m0 + wm + i * 16 + (lane >> 4) * 4 + r, col = n0 + wn + j * 16 + (lane & 15);
                const float v = acc[i][j][r];
                if (EPI == 0) ((bf16*)Cv)[(size_t)row * ldc + col] = f2bf(v);
                if (EPI == 1) ((bf16*)Cv)[(size_t)row * ldc + col] = f2bf(silu_f(v) * acc2[i][j][r]);
                if (EPI == 2) { float* p = (float*)Cv + (size_t)row * ldc + col; *p = *p + scale * v; }
                if (EPI == 3) { if (col < nstore) ((float*)Cv)[(size_t)row * ldc + col] = v; }
            }
}

__global__ __launch_bounds__(256) void nv_rmsnorm(const float* __restrict__ X, const float* __restrict__ g, bf16* __restrict__ out, int rows) {
    const int lane = threadIdx.x & 63, row = blockIdx.x * 4 + (threadIdx.x >> 6);
    if (row >= rows) return;
    const f32x4* xr = (const f32x4*)(X + (size_t)row * DM) + lane; f32x4 v[4]; float s = 0.f;
#pragma unroll
    for (int j = 0; j < 4; ++j) { v[j] = xr[64 * j]; s += v[j].x * v[j].x + v[j].y * v[j].y + v[j].z * v[j].z + v[j].w * v[j].w; }
    const float rstd = 1.0f / sqrtf(wave_sum(s) * (1.f / DM) + EPS);
#pragma unroll
    for (int j = 0; j < 4; ++j) { const f32x4 gg = ((const f32x4*)g)[lane + 64 * j]; bf16* o = out + (size_t)row * DM + (lane + 64 * j) * 4;
        o[0] = f2bf(v[j].x * rstd * gg.x); o[1] = f2bf(v[j].y * rstd * gg.y); o[2] = f2bf(v[j].z * rstd * gg.z); o[3] = f2bf(v[j].w * rstd * gg.w); }
}

__global__ void nv_rope_table(float* cs) {
    const int i = blockIdx.x * blockDim.x + threadIdx.x; if (i >= SEQ * 32) return;
    const int pos = i >> 5, f = i & 31;
    const float ex = (float)(2 * f) / 64.0f;
    const float inv = (float)(1.0 / pow(10000.0, (double)ex));
    const float ang = (float)pos * inv;
    cs[i] = (float)cos((double)ang); cs[SEQ * 32 + i] = (float)sin((double)ang);
}

__global__ __launch_bounds__(256) void nv_headnorm128(bf16* __restrict__ buf, int ld, int col0, int hstride, int nheads, const float* __restrict__ g, int rows) {
    const int lane = threadIdx.x & 63, idx = blockIdx.x * 4 + (threadIdx.x >> 6);
    if (idx >= rows * nheads) return;
    const int row = idx / nheads, h = idx % nheads;
    bf16* p = buf + (size_t)row * ld + col0 + h * hstride + lane * 2;
    const float a = bf2f(p[0]), b = bf2f(p[1]);
    const float rstd = 1.0f / sqrtf(wave_sum(a * a + b * b) * (1.f / 128.f) + EPS);
    p[0] = f2bf(a * rstd * g[lane * 2]); p[1] = f2bf(b * rstd * g[lane * 2 + 1]);
}

__global__ __launch_bounds__(256) void nv_mla_rowprep(bf16* __restrict__ P, const float* __restrict__ gq, const float* __restrict__ gkv, const float* __restrict__ gkr,
                                                      const float* __restrict__ rope, bf16* __restrict__ KR) {
    const int lane = threadIdx.x & 63, row = blockIdx.x * 4 + (threadIdx.x >> 6);
    bf16* p = P + (size_t)row * PM;
    float q[6]; float s = 0.f;
#pragma unroll
    for (int j = 0; j < 6; ++j) { q[j] = bf2f(p[PM_CQ + lane + 64 * j]); s += q[j] * q[j]; }
    float rstd = 1.0f / sqrtf(wave_sum(s) * (1.f / 384.f) + EPS);
#pragma unroll
    for (int j = 0; j < 6; ++j) p[PM_CQ + lane + 64 * j] = f2bf(q[j] * rstd * gq[lane + 64 * j]);
    float c[4]; s = 0.f;
#pragma unroll
    for (int j = 0; j < 4; ++j) { c[j] = bf2f(p[PM_CKV + lane + 64 * j]); s += c[j] * c[j]; }
    rstd = 1.0f / sqrtf(wave_sum(s) * (1.f / 256.f) + EPS);
#pragma unroll
    for (int j = 0; j < 4; ++j) p[PM_CKV + lane + 64 * j] = f2bf(c[j] * rstd * gkv[lane + 64 * j]);
    float k = bf2f(p[PM_KR + lane]);
    rstd = 1.0f / sqrtf(wave_sum(k * k) * (1.f / 64.f) + EPS);
    k = k * rstd * gkr[lane];
    const float other = __shfl_xor(k, 32);
    const int pos = row % SEQ, f = lane & 31;
    const float cs = rope[pos * 32 + f], sn = rope[SEQ * 32 + pos * 32 + f];
    const float o = lane < 32 ? (k * cs - other * sn) : (other * sn + k * cs);
    KR[(size_t)row * 64 + lane] = f2bf(o);
}

__global__ __launch_bounds__(256) void nv_mla_headprep(bf16* __restrict__ Q, bf16* __restrict__ KV, const float* __restrict__ gqn, const float* __restrict__ gqr, const float* __restrict__ gkn,
                                                       const float* __restrict__ rope) {
    const int lane = threadIdx.x & 63, idx = blockIdx.x * 4 + (threadIdx.x >> 6);
    const int row = idx >> 3, h = idx & 7;
    bf16* q = Q + (size_t)row * QW + h * 192;
    { const float a = bf2f(q[lane * 2]), b = bf2f(q[lane * 2 + 1]);
      const float rstd = 1.0f / sqrtf(wave_sum(a * a + b * b) * (1.f / 128.f) + EPS);
      q[lane * 2] = f2bf(a * rstd * gqn[lane * 2]); q[lane * 2 + 1] = f2bf(b * rstd * gqn[lane * 2 + 1]); }
    { float k = bf2f(q[128 + lane]);
      const float rstd = 1.0f / sqrtf(wave_sum(k * k) * (1.f / 64.f) + EPS);
      k = k * rstd * gqr[lane];
      const float other = __shfl_xor(k, 32);
      const int pos = row % SEQ, f = lane & 31;
      const float cs = rope[pos * 32 + f], sn = rope[SEQ * 32 + pos * 32 + f];
      q[128 + lane] = f2bf(lane < 32 ? (k * cs - other * sn) : (other * sn + k * cs)); }
    bf16* kk = KV + (size_t)row * KVW + h * 256;
    { const float a = bf2f(kk[lane * 2]), b = bf2f(kk[lane * 2 + 1]);
      const float rstd = 1.0f / sqrtf(wave_sum(a * a + b * b) * (1.f / 128.f) + EPS);
      kk[lane * 2] = f2bf(a * rstd * gkn[lane * 2]); kk[lane * 2 + 1] = f2bf(b * rstd * gkn[lane * 2 + 1]); }
}

template <int DQK, bool CAUSAL>
__global__ __launch_bounds__(64) void nv_attn(const bf16* __restrict__ Q, int ldq, int qhs, const bf16* __restrict__ Kn, int ldkn, int knhs, const bf16* __restrict__ Kr, int ldkr,
                                              const bf16* __restrict__ V, int ldv, int vhs, bf16* __restrict__ O, int ldo, int ohs, int nheads, int sq, int skv, float scale, const float* __restrict__ qgain) {
    __shared__ float sQ[64][DQK + 1];
    const int lane = threadIdx.x;
    const int qb = blockIdx.x, h = blockIdx.y, b = blockIdx.z;
    const int q0 = qb * 64;
    const size_t qrow = (size_t)b * sq + q0 + lane;
    { const bf16* qp = Q + qrow * ldq + h * qhs; float s = 0.f;
      for (int d = 0; d < DQK; ++d) { const float v = bf2f(qp[d]); sQ[lane][d] = v; s += v * v; }
      if (qgain) { const float rstd = 1.0f / sqrtf(s * (1.f / DQK) + EPS); for (int d = 0; d < DQK; ++d) sQ[lane][d] = sQ[lane][d] * rstd * qgain[d]; } }
    float acc[128];
#pragma unroll
    for (int d = 0; d < 128; ++d) acc[d] = 0.f;
    float mx = -1e30f, l = 0.f;
    const int jend = CAUSAL ? (q0 + 64) : skv;
    for (int j = 0; j < jend; ++j) {
        const size_t krow = (size_t)b * skv + j;
        const bf16* kn = Kn + krow * ldkn + h * knhs;
        float s = 0.f;
#pragma unroll 8
        for (int d = 0; d < 128; ++d) s += sQ[lane][d] * bf2f(kn[d]);
        if (DQK > 128) { const bf16* kr = Kr + krow * ldkr;
#pragma unroll 8
            for (int d = 0; d < DQK - 128; ++d) s += sQ[lane][128 + d] * bf2f(kr[d]); }
        s *= scale;
        const bool ok = !CAUSAL || (j <= q0 + lane);
        if (ok) {
            const float mn = fmaxf(mx, s), al = __expf(mx - mn), p = __expf(s - mn);
            l = l * al + p; mx = mn;
            const bf16* vp = V + krow * ldv + h * vhs;
#pragma unroll
            for (int d = 0; d < 128; ++d) acc[d] = acc[d] * al + p * bf2f(vp[d]);
        }
    }
    const float inv = 1.0f / l;
    bf16* op = O + qrow * ldo + h * ohs;
#pragma unroll
    for (int d = 0; d < 128; ++d) op[d] = f2bf(acc[d] * inv);
}

__global__ __launch_bounds__(256) void nv_gla_alpha(const float* __restrict__ alow, const float* __restrict__ wa, const float* __restrict__ ba, float* __restrict__ alpha) {
    const size_t i = (size_t)blockIdx.x * 256 + threadIdx.x; const int m = (int)(i >> 9), c = (int)(i & 511);
    float z = ba[c];
#pragma unroll
    for (int r = 0; r < 16; ++r) z += alow[(size_t)m * 16 + r] * wa[r * 512 + c];
    const float ls = fminf(z, 0.f) - log1pf(expf(-fabsf(z)));
    alpha[i] = expf(ls * (1.f / 16.f));
}
__global__ __launch_bounds__(256) void nv_gla_rec(bf16* __restrict__ P, const float* __restrict__ alpha, const float* __restrict__ gout) {
    __shared__ float red[2][4];
    const int dv = threadIdx.x, h = blockIdx.x & 3, b = blockIdx.x >> 2, lane = dv & 63, wv = dv >> 6;
    float S[128];
#pragma unroll
    for (int d = 0; d < 128; ++d) S[d] = 0.f;
    const float g = gout[dv];
    const float scale = 0.08838834764831845f;
    for (int t = 0; t < SEQ; ++t) {
        const size_t row = (size_t)b * SEQ + t;
        bf16* p = P + row * PG;
        const bf16* q = p + PG_Q + h * 128; const bf16* k = p + PG_K + h * 128; const float* al = alpha + row * 512 + h * 128;
        const float v = bf2f(p[PG_V + h * 256 + dv]);
        float o = 0.f;
#pragma unroll
        for (int d = 0; d < 128; ++d) { S[d] = al[d] * S[d] + bf2f(k[d]) * v; o += bf2f(q[d]) * S[d]; }
        o *= scale;
        float ss = wave_sum(o * o);
        if (lane == 0) red[t & 1][wv] = ss;
        __syncthreads();
        ss = red[t & 1][0] + red[t & 1][1] + red[t & 1][2] + red[t & 1][3];
        const float rstd = 1.0f / sqrtf(ss * (1.f / 256.f) + EPS);
        const float r = bf2f(p[PG_R + h * 256 + dv]);
        p[PG_V + h * 256 + dv] = f2bf(o * rstd * g * silu_f(r));
    }
}

#define LAS __attribute__((address_space(3)))
#define GAS __attribute__((address_space(1)))
typedef unsigned u32x4 __attribute__((ext_vector_type(4)));
typedef unsigned u32x2 __attribute__((ext_vector_type(2)));
typedef float f32x2 __attribute__((ext_vector_type(2)));
typedef GAS unsigned gu32;
#define RLX_AGENT __ATOMIC_RELAXED, __HIP_MEMORY_SCOPE_AGENT
#define LDS_WAIT() asm volatile("s_waitcnt lgkmcnt(0)" ::: "memory")
#define VM_WAIT() asm volatile("s_waitcnt vmcnt(0)" ::: "memory")
__device__ __forceinline__ unsigned cvt_pk_bf16(float lo, float hi) { unsigned r; asm volatile("v_cvt_pk_bf16_f32 %0, %1, %2" : "=v"(r) : "v"(lo), "v"(hi)); return r; }
__device__ __forceinline__ float fast_silu(float x) { return x * __builtin_amdgcn_rcpf(1.0f + __builtin_amdgcn_exp2f(-1.4426950408889634f * x)); }

namespace pg8 {
constexpr int BM = 256, BK = 64, HALF = 128, HTB = HALF * BK * 2  , STAGE_BYTES = 8 * HTB, NXCD = 8, WGM = 8;
__host__ __device__ __forceinline__ int lds_byte(int r, int c) { const int st = (r >> 4) * 2 + (c >> 5), rr = r & 15, cc = c & 31, ob = rr * 64 + cc * 2; return st * 1024 + (ob ^ (((ob >> 9) & 1) << 5)); }
__host__ __device__ __forceinline__ void stage_rc(int b, int& R, int& C) { const int st = b / 1024, sb = b % 1024, swz = sb ^ (((sb >> 9) & 1) << 5); R = (st >> 1) * 16 + swz / 64; C = (st & 1) * 32 + (swz % 64) / 2; }
__host__ __device__ __forceinline__ int perm32(int rho) { const int n = rho >> 4, i = rho & 15; return 8 * (i >> 2) + 4 * n + (i & 3); }

struct Unit { int pm, pn; };
struct Gemm { const bf16* A; const bf16* Bt; int M, N, K, lda, ldb; };

struct StaticOrder {
    int nM, nN, nwg, G, c, rev;
    __device__ void init(int M_, int N_, int G_, int c_, int rev_ = 0) { nM = M_ / BM; nN = N_ / BM; nwg = nM * nN; G = G_; c = c_; rev = rev_; }
    __device__ bool next(int i, Unit& u) const {
        const int R = (nwg - c + G - 1) / G;
        if (i >= R) return false;
        const long L = (long)(rev ? R - 1 - i : i) * G + c;
        int wgid = (int)L; { const int q = nwg / NXCD, r = nwg % NXCD, xcd = wgid % NXCD, off = wgid / NXCD; wgid = (xcd < r ? xcd * (q + 1) : r * (q + 1) + (xcd - r) * q) + off; }
        const int nig = WGM * nN, gid = wgid / nig, fm = gid * WGM, gsz = (nM - fm) < WGM ? (nM - fm) : WGM;
        u.pm = fm + ((wgid % nig) % gsz); u.pn = (wgid % nig) / gsz; return true;
    }
};
struct DiagOrder {
    int G, c, nb;
    __device__ bool next(int i, Unit& u) const { const int L = i * G + c; if (L >= nb * 16) return false; const int blk = L >> 4, r = L & 15; u.pm = blk * 4 + (r >> 2); u.pn = blk * 4 + (r & 3); return true; }
};

__device__ __forceinline__ float rstd_of(float ss) { return __builtin_amdgcn_rsqf(ss * (1.f / 1024.f) + EPS); }
#ifndef RS_DIRECT
#define RS_DIRECT 0
#endif
#if RS_DIRECT
#define TABV(idx) ({ const f32x4 t_ = *(const f32x4*)(rsg + (idx) * 4); (t_.x + t_.y) + (t_.z + t_.w); })
#else
#define TABV(idx) ({ const f32x4 t_ = *(const LAS f32x4*)(tab + (idx) * 4); (t_.x + t_.y) + (t_.z + t_.w); })
#endif
template <bool RS> struct EpiBf16 {
    static constexpr bool PERM = true, USE_RS = RS;
    bf16* O; int ldc; int pn_mask;
    __device__ __forceinline__ void operator()(const f32x4 (&acc)[2][2][4][2], const Unit& u, int wr, int wc, int fr, int fq, const LAS float* tab, const float* rsg) const {
        asm volatile("" : "+v"(fr), "+v"(fq));
        const int row0 = u.pm * BM + wr * 64 + fr, col0 = (u.pn & pn_mask) * BM + wc * 32 + 8 * fq;
#pragma unroll
        for (int ai = 0; ai < 2; ++ai)
#pragma unroll
            for (int m = 0; m < 4; ++m) { bf16* rowp = O + (size_t)(row0 + ai * HALF + m * 16) * ldc + col0;
                const float rs = RS ? rstd_of(TABV(ai * HALF + wr * 64 + m * 16 + fr)) : 1.f;
#pragma unroll
                for (int bj = 0; bj < 2; ++bj) { const f32x4 v0 = acc[ai][bj][m][0] * rs, v1 = acc[ai][bj][m][1] * rs;
                    u32x4 w; w.x = cvt_pk_bf16(v0[0], v0[1]); w.y = cvt_pk_bf16(v0[2], v0[3]); w.z = cvt_pk_bf16(v1[0], v1[1]); w.w = cvt_pk_bf16(v1[2], v1[3]);
                    *(u32x4*)(rowp + bj * HALF) = w; } }
    }
};
struct EpiGlaIn {
    static constexpr bool PERM = true, USE_RS = true;
    bf16* O; float* alow;
    __device__ __forceinline__ void operator()(const f32x4 (&acc)[2][2][4][2], const Unit& u, int wr, int wc, int fr, int fq, const LAS float* tab, const float* rsg) const {
        const int row0 = u.pm * BM + wr * 64 + fr;
        if (u.pn == 14) {
            if (wc == 0 && fq < 2) {
#pragma unroll
                for (int ai = 0; ai < 2; ++ai)
#pragma unroll
                    for (int m = 0; m < 4; ++m) { const float rs = rstd_of(TABV(ai * HALF + wr * 64 + m * 16 + fr)); float* ap = alow + (size_t)(row0 + ai * HALF + m * 16) * 16 + 8 * fq;
                        *(f32x4*)ap = acc[ai][0][m][0] * rs; *(f32x4*)(ap + 4) = acc[ai][0][m][1] * rs; } }
            return;
        }
        const int col0 = u.pn * BM + wc * 32 + 8 * fq;
#pragma unroll
        for (int ai = 0; ai < 2; ++ai)
#pragma unroll
            for (int m = 0; m < 4; ++m) { bf16* rowp = O + (size_t)(row0 + ai * HALF + m * 16) * PG + col0;
                const float rs = rstd_of(TABV(ai * HALF + wr * 64 + m * 16 + fr));
#pragma unroll
                for (int bj = 0; bj < 2; ++bj) { const f32x4 v0 = acc[ai][bj][m][0] * rs, v1 = acc[ai][bj][m][1] * rs;
                    u32x4 w; w.x = cvt_pk_bf16(v0[0], v0[1]); w.y = cvt_pk_bf16(v0[2], v0[3]); w.z = cvt_pk_bf16(v1[0], v1[1]); w.w = cvt_pk_bf16(v1[2], v1[3]);
                    *(u32x4*)(rowp + bj * HALF) = w; } }
    }
};
struct EpiSwiGLU {
    static constexpr bool PERM = true, USE_RS = true;
    bf16* O; int ldc;
    __device__ __forceinline__ void operator()(const f32x4 (&acc)[2][2][4][2], const Unit& u, int wr, int wc, int fr, int fq, const LAS float* tab, const float* rsg) const {
        const int row0 = u.pm * BM + wr * 64 + fr, col0 = u.pn * HALF + wc * 32 + 8 * fq;
        float ss[2][4];
#pragma unroll
        for (int ai = 0; ai < 2; ++ai)
#pragma unroll
            for (int m = 0; m < 4; ++m) ss[ai][m] = TABV(ai * HALF + wr * 64 + m * 16 + fr);
#pragma unroll
        for (int ai = 0; ai < 2; ++ai)
#pragma unroll
            for (int m = 0; m < 4; ++m) { bf16* rowp = O + (size_t)(row0 + ai * HALF + m * 16) * ldc + col0;
                const float v = ss[ai][m] * (1.f / 1024.f) + EPS, c = -1.4426950408889634f * __builtin_amdgcn_rsqf(v);
                float h[8], e[8];
#pragma unroll
                for (int k = 0; k < 8; ++k) e[k] = acc[ai][0][m][k >> 2][k & 3] * c;
#pragma unroll
                for (int k = 0; k < 8; ++k) h[k] = acc[ai][0][m][k >> 2][k & 3] * acc[ai][1][m][k >> 2][k & 3];
                __builtin_amdgcn_sched_barrier(0);
#pragma unroll
                for (int k = 0; k < 8; ++k) e[k] = __builtin_amdgcn_exp2f(e[k]);
                __builtin_amdgcn_sched_barrier(0);
#pragma unroll
                for (int k = 0; k < 8; ++k) e[k] = __builtin_fmaf(e[k], v, v);
                __builtin_amdgcn_sched_barrier(0);
#pragma unroll
                for (int k = 0; k < 8; ++k) e[k] = __builtin_amdgcn_rcpf(e[k]);
                __builtin_amdgcn_sched_barrier(0);
#pragma unroll
                for (int k = 0; k < 8; ++k) h[k] *= e[k];
                u32x4 w; w.x = cvt_pk_bf16(h[0], h[1]); w.y = cvt_pk_bf16(h[2], h[3]); w.z = cvt_pk_bf16(h[4], h[5]); w.w = cvt_pk_bf16(h[6], h[7]);
                *(u32x4*)rowp = w; }
    }
};
struct EpiKV {
    static constexpr bool PERM = true, USE_RS = false;
    bf16* O; int ldc; const float* gkn; LAS float* part;
    __device__ __forceinline__ void operator()(const f32x4 (&acc)[2][2][4][2], const Unit& u, int wr, int wc, int fr, int fq, const LAS float*, const float*) const {
        asm volatile("" : "+v"(fr), "+v"(fq));
        const int row0 = u.pm * BM + wr * 64 + fr, col0 = u.pn * BM + wc * 32 + 8 * fq;
#pragma unroll
        for (int ai = 0; ai < 2; ++ai)
#pragma unroll
            for (int m = 0; m < 4; ++m) { const f32x4 a = acc[ai][0][m][0], b = acc[ai][0][m][1];
                float ss = ((a[0] * a[0] + a[1] * a[1]) + (a[2] * a[2] + a[3] * a[3])) + ((b[0] * b[0] + b[1] * b[1]) + (b[2] * b[2] + b[3] * b[3]));
                ss += __shfl_xor(ss, 16); ss += __shfl_xor(ss, 32);
                if (fq == 0) part[(ai * HALF + wr * 64 + m * 16 + fr) * 4 + wc] = ss; }
        asm volatile("s_waitcnt lgkmcnt(0)" ::: "memory"); __builtin_amdgcn_s_barrier(); asm volatile("" ::: "memory");
        const f32x4 g0 = *(const f32x4*)(gkn + wc * 32 + 8 * fq), g1 = *(const f32x4*)(gkn + wc * 32 + 8 * fq + 4);
#pragma unroll
        for (int ai = 0; ai < 2; ++ai)
#pragma unroll
            for (int m = 0; m < 4; ++m) { bf16* rowp = O + (size_t)(row0 + ai * HALF + m * 16) * ldc + col0;
                const f32x4 pp = *(const LAS f32x4*)(part + (ai * HALF + wr * 64 + m * 16 + fr) * 4);
                const float rs = __builtin_amdgcn_rsqf(((pp.x + pp.y) + (pp.z + pp.w)) * (1.f / 128.f) + EPS);
                { const f32x4 v0 = acc[ai][0][m][0] * rs * g0, v1 = acc[ai][0][m][1] * rs * g1;
                  u32x4 w; w.x = cvt_pk_bf16(v0[0], v0[1]); w.y = cvt_pk_bf16(v0[2], v0[3]); w.z = cvt_pk_bf16(v1[0], v1[1]); w.w = cvt_pk_bf16(v1[2], v1[3]); *(u32x4*)rowp = w; }
                { const f32x4 v0 = acc[ai][1][m][0], v1 = acc[ai][1][m][1];
                  u32x4 w; w.x = cvt_pk_bf16(v0[0], v0[1]); w.y = cvt_pk_bf16(v0[2], v0[3]); w.z = cvt_pk_bf16(v1[0], v1[1]); w.w = cvt_pk_bf16(v1[2], v1[3]); *(u32x4*)(rowp + HALF) = w; } }
    }
};
struct EpiResid {
    static constexpr bool PERM = true, USE_RS = false;
    bf16* XB; float* OUT; float* RS4; LAS float* part; int ldc; float scale;
    __device__ __forceinline__ void operator()(const f32x4 (&acc)[2][2][4][2], const Unit& u, int wr, int wc, int fr, int fq, const LAS float*, const float*) const {
        const int row0 = u.pm * BM + wr * 64 + fr, col0 = u.pn * BM + wc * 32 + 8 * fq;
#pragma unroll
        for (int ai = 0; ai < 2; ++ai) {
            const size_t off = (size_t)(row0 + ai * HALF) * ldc + col0;
            u32x4 xv[4][2];
#pragma unroll
            for (int m = 0; m < 4; ++m)
#pragma unroll
                for (int bj = 0; bj < 2; ++bj) xv[m][bj] = *(const u32x4*)(XB + off + (size_t)(m * 16) * ldc + bj * HALF);
#pragma unroll
            for (int m = 0; m < 4; ++m) { float ss = 0.f;
#pragma unroll
                for (int bj = 0; bj < 2; ++bj) { const u32x4 w = xv[m][bj]; const size_t o2 = off + (size_t)(m * 16) * ldc + bj * HALF;
                    f32x4 n0, n1;
                    n0[0] = __uint_as_float(w.x << 16) + acc[ai][bj][m][0][0] * scale; n0[1] = __uint_as_float(w.x & 0xffff0000u) + acc[ai][bj][m][0][1] * scale;
                    n0[2] = __uint_as_float(w.y << 16) + acc[ai][bj][m][0][2] * scale; n0[3] = __uint_as_float(w.y & 0xffff0000u) + acc[ai][bj][m][0][3] * scale;
                    n1[0] = __uint_as_float(w.z << 16) + acc[ai][bj][m][1][0] * scale; n1[1] = __uint_as_float(w.z & 0xffff0000u) + acc[ai][bj][m][1][1] * scale;
                    n1[2] = __uint_as_float(w.w << 16) + acc[ai][bj][m][1][2] * scale; n1[3] = __uint_as_float(w.w & 0xffff0000u) + acc[ai][bj][m][1][3] * scale;
                    if (OUT) { *(f32x4*)(OUT + o2) = n0; *(f32x4*)(OUT + o2 + 4) = n1; }
                    else { u32x4 o; o.x = cvt_pk_bf16(n0[0], n0[1]); o.y = cvt_pk_bf16(n0[2], n0[3]); o.z = cvt_pk_bf16(n1[0], n1[1]); o.w = cvt_pk_bf16(n1[2], n1[3]); *(u32x4*)(XB + o2) = o;
                        ss += ((n0[0] * n0[0] + n0[1] * n0[1]) + (n0[2] * n0[2] + n0[3] * n0[3])) + ((n1[0] * n1[0] + n1[1] * n1[1]) + (n1[2] * n1[2] + n1[3] * n1[3])); } }
                if (!OUT) { ss += __shfl_xor(ss, 16); ss += __shfl_xor(ss, 32); if (fq == 0) part[(ai * HALF + wr * 64 + m * 16 + fr) * 4 + wc] = ss; } }
            asm volatile("" ::: "memory"); }
        if (!OUT) {
            asm volatile("s_waitcnt lgkmcnt(0)" ::: "memory"); __builtin_amdgcn_s_barrier(); asm volatile("" ::: "memory");
            const int t = (wr * 4 + wc) * 64 + fq * 16 + fr;
            if (t < 256) { const f32x4 pp = *(const LAS f32x4*)(part + t * 4); RS4[((size_t)u.pm * BM + t) * 4 + u.pn] = (pp.x + pp.y) + (pp.z + pp.w); }
        }
    }
};

template <class Epi, class Sched, bool ALIGN_EPI = false, bool SP2 = false>
__device__ __forceinline__ void gemm_phase(LAS unsigned char* lds, const Gemm g, const Sched& S, const Epi& E, const float* rs = nullptr, LAS unsigned char* rstab = nullptr, const bool skip_epi = false) {
    int tid_ = threadIdx.x; asm volatile("" : "+v"(tid_));
    const int tid = tid_, wid = __builtin_amdgcn_readfirstlane(tid >> 6), lane = tid & 63, wr = wid >> 2, wc = wid & 3, fr = lane & 15, fq = lane >> 4;
    const int K = g.K, nt = K / BK, lda = g.lda, ldb = g.ldb;
    unsigned voffA[2], voffB[2];
#pragma unroll
    for (int i = 0; i < 2; ++i) { int R, C; stage_rc(tid * 16 + i * 8192, R, C); const int Rb = Epi::PERM ? ((R & ~31) + perm32(R & 31)) : R;
        voffA[i] = (unsigned)(R * lda + C) * 2u; voffB[i] = (unsigned)(Rb * ldb + C) * 2u; }
    const size_t kstep = (size_t)(BK * 2);
    const size_t hstepA = (size_t)HALF * lda * 2, hstepB = (size_t)HALF * ldb * 2;
    const size_t tstepA = 2 * hstepA, tstepB = 2 * hstepB;
    const unsigned ldsw = (unsigned)wid * 1024u;
    const int aoff = lds_byte(wr * 64 + fr, fq * 8), boff = lds_byte(wc * 32 + fr, fq * 8);
#define PG8_SA(b, h) (((b) * 2 + (h)) * HTB)
#define PG8_SB(b, h) ((4 + (b) * 2 + (h)) * HTB)
#define PG8_STAGE(bufoff, gbase, voff) do { _Pragma("unroll") for (int _i = 0; _i < 2; ++_i) \
        __builtin_amdgcn_global_load_lds((const unsigned*)((const char*)(gbase) + (voff)[_i]), (LAS unsigned*)(lds + (bufoff) + ldsw + _i * 8192), 16, 0, 0); } while (0)
#define PG8_LDA(dst, b, h) do { _Pragma("unroll") for (int m = 0; m < 4; ++m) _Pragma("unroll") for (int k = 0; k < 2; ++k) dst[m][k] = *(const LAS bf16x8*)(lds + PG8_SA(b, h) + aoff + m * 2048 + k * 1024); } while (0)
#define PG8_LDB(dst, b, h) do { _Pragma("unroll") for (int n = 0; n < 2; ++n) _Pragma("unroll") for (int k = 0; k < 2; ++k) dst[n][k] = *(const LAS bf16x8*)(lds + PG8_SB(b, h) + boff + n * 2048 + k * 1024); } while (0)
#define PG8_MMA(ai, bj, At, Bt) do { __builtin_amdgcn_s_setprio(1); _Pragma("unroll") for (int m = 0; m < 4; ++m) _Pragma("unroll") for (int n = 0; n < 2; ++n) _Pragma("unroll") for (int k = 0; k < 2; ++k) \
        acc[ai][bj][m][n] = __builtin_amdgcn_mfma_f32_16x16x32_bf16(Bt[n][k], At[m][k], acc[ai][bj][m][n], 0, 0, 0); __builtin_amdgcn_s_setprio(0); } while (0)
#define PG8_WAIT_V(n) asm volatile("s_waitcnt vmcnt(" #n ")" ::: "memory")
#define PG8_WAIT_L(n) asm volatile("s_waitcnt lgkmcnt(" #n ")" ::: "memory")
#define PG8_BAR __builtin_amdgcn_s_barrier()
#define PG8_SCHED __builtin_amdgcn_sched_barrier(0)
    Unit cur, nxt; int ui = 0;
    if (!S.next(0, cur)) return;
    f32x4 acc[2][2][4][2];
#pragma unroll
    for (int a = 0; a < 2; ++a)
#pragma unroll
        for (int b = 0; b < 2; ++b)
#pragma unroll
            for (int m = 0; m < 4; ++m)
#pragma unroll
                for (int n = 0; n < 2; ++n) acc[a][b][m][n] = (f32x4){0.f, 0.f, 0.f, 0.f};
    bf16x8 At[4][2], B0[2][2], B1[2][2];
    const char* cA = (const char*)g.A + (size_t)cur.pm * tstepA; const char* cB = (const char*)g.Bt + (size_t)cur.pn * tstepB;
#define PG8_RSDMA(unit, par) do { if (Epi::USE_RS && wid < 4) __builtin_amdgcn_global_load_lds((const unsigned*)(rs + ((size_t)(unit).pm * BM + wid * 64 + lane) * 4), (LAS unsigned*)(rstab + (par) * 4096 + wid * 1024), 16, 0, 0); } while (0)
    PG8_RSDMA(cur, 0);
    if constexpr (SP2) {
        PG8_STAGE(PG8_SB(0, 0), cB, voffB); PG8_STAGE(PG8_SB(0, 1), cB + hstepB, voffB); PG8_STAGE(PG8_SA(0, 0), cA, voffA); PG8_STAGE(PG8_SA(0, 1), cA + hstepA, voffA);
        if (wr == 1) PG8_BAR;
        PG8_WAIT_V(2); PG8_BAR;
        PG8_STAGE(PG8_SB(1, 0), cB + kstep, voffB); PG8_STAGE(PG8_SA(1, 0), cA + kstep, voffA); PG8_STAGE(PG8_SB(1, 1), cB + hstepB + kstep, voffB);
        PG8_WAIT_V(6); PG8_BAR;
    } else {
        PG8_STAGE(PG8_SB(0, 0), cB, voffB); PG8_STAGE(PG8_SA(0, 0), cA, voffA); PG8_STAGE(PG8_SB(0, 1), cB + hstepB, voffB); PG8_STAGE(PG8_SA(0, 1), cA + hstepA, voffA);
        if (wr == 1) PG8_BAR;
        PG8_WAIT_V(4); PG8_BAR;
        PG8_STAGE(PG8_SB(1, 0), cB + kstep, voffB); PG8_STAGE(PG8_SA(1, 0), cA + kstep, voffA); PG8_STAGE(PG8_SB(1, 1), cB + hstepB + kstep, voffB);
        PG8_WAIT_V(6); PG8_BAR;
    }
    for (;;) {
        const bool has_next = S.next(ui + 1, nxt);
        const char* nA = has_next ? (const char*)g.A + (size_t)nxt.pm * tstepA : cA; const char* nB = has_next ? (const char*)g.Bt + (size_t)nxt.pn * tstepB : cB;
        for (int t = 0; t < nt; t += 2) {
            const bool last = (t == nt - 2);
            const char* a1 = cA + (size_t)(t + 1) * kstep;
            const char* a2 = last ? nA : cA + (size_t)(t + 2) * kstep; const char* b2 = last ? nB : cB + (size_t)(t + 2) * kstep;
            const char* a3 = a2 + kstep; const char* b3 = b2 + kstep;
            if (last && has_next) PG8_RSDMA(nxt, (ui + 1) & 1);
            if constexpr (SP2) {
            PG8_LDB(B0, 0, 0); PG8_LDB(B1, 0, 1); PG8_SCHED; PG8_LDA(At, 0, 0); PG8_STAGE(PG8_SA(1, 1), a1 + hstepA, voffA);
            PG8_WAIT_V(8); PG8_WAIT_L(0); PG8_BAR; PG8_MMA(0, 0, At, B0); PG8_MMA(0, 1, At, B1); PG8_BAR; PG8_SCHED;
            PG8_LDA(At, 0, 1); PG8_STAGE(PG8_SB(0, 0), b2, voffB); PG8_STAGE(PG8_SB(0, 1), b2 + hstepB, voffB); PG8_STAGE(PG8_SA(0, 0), a2, voffA);
            PG8_WAIT_V(8); PG8_WAIT_L(0); PG8_BAR; PG8_MMA(1, 0, At, B0); PG8_MMA(1, 1, At, B1); PG8_BAR; PG8_SCHED;
            PG8_LDB(B0, 1, 0); PG8_LDB(B1, 1, 1); PG8_SCHED; PG8_LDA(At, 1, 0); PG8_STAGE(PG8_SA(0, 1), a2 + hstepA, voffA);
            PG8_WAIT_V(8); PG8_WAIT_L(0); PG8_BAR; PG8_MMA(0, 0, At, B0); PG8_MMA(0, 1, At, B1); PG8_BAR; PG8_SCHED;
            PG8_LDA(At, 1, 1); PG8_STAGE(PG8_SB(1, 0), b3, voffB); PG8_STAGE(PG8_SB(1, 1), b3 + hstepB, voffB); PG8_STAGE(PG8_SA(1, 0), a3, voffA);
            PG8_WAIT_V(8); PG8_WAIT_L(0); PG8_BAR; PG8_MMA(1, 0, At, B0); PG8_MMA(1, 1, At, B1); PG8_BAR; PG8_SCHED;
            } else {
            PG8_LDB(B0, 0, 0); PG8_SCHED; PG8_LDA(At, 0, 0); PG8_STAGE(PG8_SA(1, 1), a1 + hstepA, voffA);
            PG8_WAIT_L(8); PG8_BAR; PG8_WAIT_L(0); PG8_MMA(0, 0, At, B0); PG8_BAR; PG8_SCHED;
            PG8_LDB(B1, 0, 1); PG8_STAGE(PG8_SB(0, 0), b2, voffB);
            PG8_BAR; PG8_WAIT_L(0); PG8_MMA(0, 1, At, B1); PG8_BAR;
            PG8_LDA(At, 0, 1); PG8_STAGE(PG8_SA(0, 0), a2, voffA);
            PG8_BAR; PG8_WAIT_L(0); PG8_MMA(1, 0, At, B0); PG8_BAR; PG8_SCHED;
            PG8_STAGE(PG8_SB(0, 1), b2 + hstepB, voffB);
            PG8_WAIT_V(6); PG8_BAR; PG8_MMA(1, 1, At, B1); PG8_BAR;
            PG8_LDB(B0, 1, 0); PG8_SCHED; PG8_LDA(At, 1, 0); PG8_STAGE(PG8_SA(0, 1), a2 + hstepA, voffA);
            PG8_WAIT_L(8); PG8_BAR; PG8_WAIT_L(0); PG8_MMA(0, 0, At, B0); PG8_BAR; PG8_SCHED;
            PG8_LDB(B1, 1, 1); PG8_STAGE(PG8_SB(1, 0), b3, voffB);
            PG8_BAR; PG8_WAIT_L(0); PG8_MMA(0, 1, At, B1); PG8_BAR;
            PG8_LDA(At, 1, 1); PG8_STAGE(PG8_SA(1, 0), a3, voffA);
            PG8_BAR; PG8_WAIT_L(0); PG8_MMA(1, 0, At, B0); PG8_BAR; PG8_SCHED;
            PG8_STAGE(PG8_SB(1, 1), b3 + hstepB, voffB);
            PG8_WAIT_V(6); PG8_BAR; PG8_MMA(1, 1, At, B1); PG8_BAR;
            }
        }
        if constexpr (ALIGN_EPI) { if (wr == 0) PG8_BAR; }
        if (!skip_epi) E(acc, cur, wr, wc, fr, fq, (const LAS float*)(rstab + (ui & 1) * 4096), rs + (size_t)cur.pm * BM * 4);
        if (!has_next) break;
#pragma unroll
        for (int a = 0; a < 2; ++a)
#pragma unroll
            for (int b = 0; b < 2; ++b)
#pragma unroll
                for (int m = 0; m < 4; ++m)
#pragma unroll
                    for (int n = 0; n < 2; ++n) { typedef double f64x2_ __attribute__((ext_vector_type(2))); double z0, z1;
                        asm volatile("v_mov_b64 %0, 0\n\tv_mov_b64 %1, 0" : "=v"(z0), "=v"(z1)); f64x2_ zz = {z0, z1}; acc[a][b][m][n] = __builtin_bit_cast(f32x4, zz); }
        cur = nxt; cA = nA; cB = nB; ++ui;
        if constexpr (ALIGN_EPI) { if (wr == 1) PG8_BAR; }
    }
    PG8_WAIT_V(0);
    if constexpr (!ALIGN_EPI) { if (wr == 0) PG8_BAR; }
    PG8_BAR;
#undef PG8_RSDMA
#undef PG8_SA
#undef PG8_SB
#undef PG8_STAGE
#undef PG8_LDA
#undef PG8_LDB
#undef PG8_MMA
#undef PG8_WAIT_V
#undef PG8_WAIT_L
#undef PG8_BAR
#undef PG8_SCHED
}
}
#ifndef PG8_SP2
#define PG8_SP2 true
#endif
#ifndef PG8_ALIGN
#define PG8_ALIGN true
#endif

#define XB_TMO      128
#define XB_XCNT(j)  (256  + 64 * (j))
#define XB_XSUB(j)  (1280 + 64 * (j))
#define XB_XGEN(j)  (2304 + 64 * (j))
#define XB_TOP      3328
#define XB_TOPGEN   3392
#define XCD_BAR_WORDS 3456
#define XB_SPIN_CAP (1u << 18)
__device__ __forceinline__ unsigned xb_ld(unsigned* p)              { return __hip_atomic_load(p, __ATOMIC_RELAXED, __HIP_MEMORY_SCOPE_AGENT); }
__device__ __forceinline__ unsigned xb_add(unsigned* p, unsigned v) { return __hip_atomic_fetch_add(p, v, __ATOMIC_RELAXED, __HIP_MEMORY_SCOPE_AGENT); }
__device__ __forceinline__ unsigned xb_xcc_id() { return (unsigned)__builtin_amdgcn_s_getreg((3 << 11) | 20) & 0xFu; }
#define XB_SPIN(cond, bar) do { unsigned _sp = 0; while (cond) { __builtin_amdgcn_s_sleep(1); \
    if ((++_sp & 255u) == 0u) { if (xb_ld(&(bar)[XB_TMO])) break; if (_sp > XB_SPIN_CAP) { atomicAdd(&(bar)[XB_TMO], 1u); break; } } } } while (0)
struct XcdBarrier { unsigned* bar; unsigned x; volatile LAS unsigned* st; };
__device__ __forceinline__ XcdBarrier xcd_barrier_post(unsigned* bar, volatile LAS unsigned* st) {
    XcdBarrier b; b.bar = bar; b.x = xb_xcc_id(); b.st = st;
    if (threadIdx.x == 0) (void)xb_add(&bar[XB_XCNT(b.x)], 1u);
    return b;
}
__device__ __forceinline__ void xcd_barrier_complete(unsigned* bar, unsigned x, unsigned& nloc, unsigned& nx) {
    const unsigned G = gridDim.x * gridDim.y * gridDim.z;
    unsigned sum, cnt, mine, sp = 0u;
    for (;;) {
        sum = 0u; cnt = 0u; mine = 0u;
#pragma unroll
        for (unsigned j = 0; j < 16; ++j) { const unsigned c = xb_ld(&bar[XB_XCNT(j)]); sum += c; cnt += (c > 0u) ? 1u : 0u; mine = (j == x) ? c : mine; }
        if (sum == G) break;
        __builtin_amdgcn_s_sleep(1);
        if ((++sp & 255u) == 0u) { if (xb_ld(&bar[XB_TMO])) break; if (sp > XB_SPIN_CAP) { atomicAdd(&bar[XB_TMO], 1u); break; } }
    }
    nloc = mine > 0u ? mine : 1u; nx = cnt > 0u ? cnt : 1u;
}
__device__ __forceinline__ void xcd_barrier(const XcdBarrier& b) {
    asm volatile("s_waitcnt vmcnt(0)" ::: "memory");
    __syncthreads();
    if (threadIdx.x == 0) {
        unsigned* bar = b.bar;
        __builtin_amdgcn_s_waitcnt(0);
        unsigned nloc = b.st[0], nx = b.st[1];
        if (nloc == 0u) { xcd_barrier_complete(bar, b.x, nloc, nx); b.st[0] = nloc; b.st[1] = nx; }
        const unsigned old = xb_add(&bar[XB_XSUB(b.x)], 1u);
        const unsigned gen = old / nloc;
        if (old + 1u == (gen + 1u) * nloc) {
            __builtin_amdgcn_fence(__ATOMIC_RELEASE, "agent");
            asm volatile("s_waitcnt vmcnt(0)" ::: "memory");
            const unsigned og = xb_add(&bar[XB_TOP], 1u);
            const unsigned tg = og / nx;
            if (og + 1u == (tg + 1u) * nx) xb_add(&bar[XB_TOPGEN], 1u);
            else XB_SPIN(xb_ld(&bar[XB_TOPGEN]) == tg, bar);
            __builtin_amdgcn_fence(__ATOMIC_ACQUIRE, "agent");
            xb_add(&bar[XB_XGEN(b.x)], 1u);
            asm volatile("s_waitcnt vmcnt(0)" ::: "memory");
        } else {
            XB_SPIN(xb_ld(&bar[XB_XGEN(b.x)]) == gen, bar);
            __builtin_amdgcn_fence(__ATOMIC_ACQUIRE, "agent");
            asm volatile("s_waitcnt vmcnt(0)" ::: "memory");
        }
    }
    __syncthreads();
}
namespace att {
typedef float f32x16 __attribute__((ext_vector_type(16)));
typedef short s16x4 __attribute__((ext_vector_type(4)));
constexpr int SHM_V = 16384, SHM_KN = 16384, SHM_KR = 8192;
constexpr int NKS = 3, NVS = 4;
constexpr int L_KN = 0, L_KR = L_KN + NKS * SHM_KN, L_V = L_KR + NKS * SHM_KR, L_WS = L_V + NVS * SHM_V, L_END = L_WS + 8 * 64 * 4;
static_assert(L_END <= 160 * 1024 - 1024, "attention LDS map");
constexpr float THR = 8.f;
#define KSWZ(row, chunk) ((row) * 256 + ((((chunk) ^ (row)) & 15) << 4))
#define KRSWZ(row, chunk) ((row) * 128 + ((((chunk) ^ ((row) >> 1)) & 7) << 4))
#define SBAR() __builtin_amdgcn_sched_barrier(0)
__device__ __forceinline__ int v_st(int k, int c) { const int kk = (k & ~0xC) | ((k & 4) << 1) | ((k & 8) >> 1); return ((kk >> 3) * 4 + (c >> 5)) * 512 + ((kk & 7) * 32 + (c & 31)) * 2; }
__device__ __forceinline__ int v_rd_base(int lane) { return ((lane & 3) << 3) | (((lane >> 2) & 3) << 6) | (((lane >> 4) & 1) << 5) | (((lane >> 5) & 1) << 8); }
constexpr int v_rd_off(int d0, int ks, int half) { return d0 * 512 + ks * 4096 + half * 2048; }
__device__ __forceinline__ int crow(int r, int hi) { return (r & 3) + 8 * (r >> 2) + 4 * hi; }
__device__ __forceinline__ bf16x8 pack8(f32x4 a, f32x4 b) { u32x4 w = {cvt_pk_bf16(a[0], a[1]), cvt_pk_bf16(a[2], a[3]), cvt_pk_bf16(b[0], b[1]), cvt_pk_bf16(b[2], b[3])}; return __builtin_bit_cast(bf16x8, w); }
__device__ __forceinline__ void mask_tile(f32x16& p0, f32x16& p1, int dq) {
    const float NEG = -__builtin_inff();
#pragma unroll
    for (int r = 0; r < 16; ++r) { const int c = (r & 3) + 8 * (r >> 2); if (dq - c < 0) p0[r] = NEG; if (dq - c - 32 < 0) p1[r] = NEG; }
}
__device__ __forceinline__ void partialSM(f32x16& p0, f32x16& p1, float& m_reg, float& mn, float& alpha, const float SCALE) {
    float pmax = p0[0];
#pragma unroll
    for (int r = 1; r < 16; ++r) pmax = fmaxf(pmax, p0[r]);
#pragma unroll
    for (int r = 0; r < 16; ++r) pmax = fmaxf(pmax, p1[r]);
    { auto rr = __builtin_amdgcn_permlane32_swap(__float_as_uint(pmax), __float_as_uint(pmax), false, false);
      pmax = fmaxf(__uint_as_float(rr[0]), __uint_as_float(rr[1])); }
    const float C2 = 1.4426950408889634f * SCALE;
    if (__builtin_expect(__all((pmax - m_reg) * SCALE <= THR), 1)) { mn = m_reg; alpha = 1.f; }
    else { mn = fmaxf(m_reg, pmax); alpha = __builtin_amdgcn_exp2f((m_reg - mn) * C2); m_reg = mn; }
    const float mnL = -mn * C2;
#pragma unroll
    for (int r = 0; r < 16; ++r) p0[r] = fmaf(p0[r], C2, mnL);
#pragma unroll
    for (int r = 0; r < 16; ++r) p1[r] = fmaf(p1[r], C2, mnL);
#pragma unroll
    for (int r = 0; r < 16; ++r) p0[r] = __builtin_amdgcn_exp2f(p0[r]);
}
__device__ __forceinline__ void finishSM(f32x16& p0, f32x16& p1, float alpha, float& l_reg, bf16x8& pa0, bf16x8& pa1, bf16x8& pa2, bf16x8& pa3) {
#pragma unroll
    for (int r = 0; r < 16; ++r) p1[r] = __builtin_amdgcn_exp2f(p1[r]);
    float ps = 0;
#pragma unroll
    for (int r = 0; r < 16; ++r) ps += p0[r];
#pragma unroll
    for (int r = 0; r < 16; ++r) ps += p1[r];
    { auto rr = __builtin_amdgcn_permlane32_swap(__float_as_uint(ps), __float_as_uint(ps), false, false);
      ps = __uint_as_float(rr[0]) + __uint_as_float(rr[1]); }
    l_reg = l_reg * alpha + ps;
#define PK4(P, B_, OUT) do { unsigned a0 = cvt_pk_bf16(P[B_+0], P[B_+1]), a1 = cvt_pk_bf16(P[B_+2], P[B_+3]);                          \
        unsigned b0 = cvt_pk_bf16(P[B_+4], P[B_+5]), b1 = cvt_pk_bf16(P[B_+6], P[B_+7]);                                             \
        auto r0 = __builtin_amdgcn_permlane32_swap(a0, b0, false, false); auto r1 = __builtin_amdgcn_permlane32_swap(a1, b1, false, false); \
        u32x4 w = {r0[0], r1[0], r0[1], r1[1]}; OUT = __builtin_bit_cast(bf16x8, w); } while (0)
    PK4(p0, 0, pa0); PK4(p0, 8, pa1); PK4(p1, 0, pa2); PK4(p1, 8, pa3);
#undef PK4
}
__device__ __forceinline__ void staticSM(f32x16& p0, f32x16& p1, float& l_reg, bf16x8& pa0, bf16x8& pa1, bf16x8& pa2, bf16x8& pa3) {
#pragma unroll
    for (int r = 0; r < 16; ++r) p0[r] = __builtin_amdgcn_exp2f(p0[r]);
#pragma unroll
    for (int r = 0; r < 16; ++r) p1[r] = __builtin_amdgcn_exp2f(p1[r]);
    float ps = 0;
#pragma unroll
    for (int r = 0; r < 16; ++r) ps += p0[r];
#pragma unroll
    for (int r = 0; r < 16; ++r) ps += p1[r];
    { auto rr = __builtin_amdgcn_permlane32_swap(__float_as_uint(ps), __float_as_uint(ps), false, false);
      ps = __uint_as_float(rr[0]) + __uint_as_float(rr[1]); }
    l_reg += ps;
#define PK4(P, B_, OUT) do { unsigned a0 = cvt_pk_bf16(P[B_+0], P[B_+1]), a1 = cvt_pk_bf16(P[B_+2], P[B_+3]);                          \
        unsigned b0 = cvt_pk_bf16(P[B_+4], P[B_+5]), b1 = cvt_pk_bf16(P[B_+6], P[B_+7]);                                             \
        auto r0 = __builtin_amdgcn_permlane32_swap(a0, b0, false, false); auto r1 = __builtin_amdgcn_permlane32_swap(a1, b1, false, false); \
        u32x4 w = {r0[0], r1[0], r0[1], r1[1]}; OUT = __builtin_bit_cast(bf16x8, w); } while (0)
    PK4(p0, 0, pa0); PK4(p0, 8, pa1); PK4(p1, 0, pa2); PK4(p1, 8, pa3);
#undef PK4
}
template <int NR>
__device__ __forceinline__ void qkt(f32x16& p0, f32x16& p1, const int (&kaddr)[8], const int (&raddr)[4], const bf16x8* qr, const float init) {
#pragma unroll
    for (int r = 0; r < 16; ++r) { p0[r] = init; p1[r] = init; }
    bf16x8 a0, a1, a2, a3, b0, b1, b2, b3;
#define KRD(dst, addr, off) asm volatile("ds_read_b128 %0, %1 offset:%2" : "=&v"(dst) : "v"(addr), "i"(off) : "memory")
#define KLD(d, x0, x1) do { if ((d) < 8) { KRD(x0, kaddr[(d) & 7], 0); KRD(x1, kaddr[(d) & 7], 8192); } else { KRD(x0, raddr[((d) - 8) & 3], 0); KRD(x1, raddr[((d) - 8) & 3], 4096); } } while (0)
#define KWAIT(n) do { asm volatile("s_waitcnt lgkmcnt(" #n ")" : "+v"(a0), "+v"(a1), "+v"(a2), "+v"(a3), "+v"(b0), "+v"(b1), "+v"(b2), "+v"(b3) :: "memory"); SBAR(); } while (0)
#define KMMA(d, x0, x1) do { p0 = __builtin_amdgcn_mfma_f32_32x32x16_bf16(x0, qr[d], p0, 0, 0, 0); p1 = __builtin_amdgcn_mfma_f32_32x32x16_bf16(x1, qr[d], p1, 0, 0, 0); } while (0)
    constexpr int NS = 8 + NR;
    KLD(0, a0, a1); KLD(1, a2, a3); KLD(2, b0, b1); KLD(3, b2, b3);
    KWAIT(4); KMMA(0, a0, a1); KMMA(1, a2, a3); KLD(4, a0, a1); KLD(5, a2, a3);
    KWAIT(4); KMMA(2, b0, b1); KMMA(3, b2, b3); KLD(6, b0, b1); KLD(7, b2, b3);
    if constexpr (NS > 8) {
        KWAIT(4); KMMA(4, a0, a1); KMMA(5, a2, a3); KLD(8, a0, a1); KLD(9, a2, a3);
        KWAIT(4); KMMA(6, b0, b1); KMMA(7, b2, b3); KLD(10, b0, b1); KLD(11, b2, b3);
        KWAIT(4); KMMA(8, a0, a1); KMMA(9, a2, a3);
        KWAIT(0); KMMA(10, b0, b1); KMMA(11, b2, b3);
    } else {
        KWAIT(4); KMMA(4, a0, a1); KMMA(5, a2, a3);
        KWAIT(0); KMMA(6, b0, b1); KMMA(7, b2, b3);
    }
#undef KMMA
#undef KWAIT
#undef KLD
#undef KRD
}
__device__ __forceinline__ void pv_tile(f32x16* o, int vb0  , bf16x8 pa0, bf16x8 pa1, bf16x8 pa2, bf16x8 pa3) {
#define TRRD(dst, off) asm volatile("ds_read_b64_tr_b16 %0, %1 offset:%2" : "=&v"(dst) : "v"(vb0), "i"(off) : "memory")
#define PV_LOAD(L, H, ks) do { constexpr int b_ = (ks) * 4096; \
        TRRD(L[0], b_); TRRD(H[0], b_ + 2048); TRRD(L[1], b_ + 512); TRRD(H[1], b_ + 512 + 2048); TRRD(L[2], b_ + 1024); TRRD(H[2], b_ + 1024 + 2048); TRRD(L[3], b_ + 1536); TRRD(H[3], b_ + 1536 + 2048); } while (0)
#define PV_WAIT(n) do { asm volatile("s_waitcnt lgkmcnt(" #n ")" : "+v"(la[0]), "+v"(ha[0]), "+v"(la[1]), "+v"(ha[1]), "+v"(la[2]), "+v"(ha[2]), "+v"(la[3]), "+v"(ha[3]), "+v"(lb[0]), "+v"(hb[0]), "+v"(lb[1]), "+v"(hb[1]), "+v"(lb[2]), "+v"(hb[2]), "+v"(lb[3]), "+v"(hb[3]) :: "memory"); SBAR(); } while (0)
#define PV_MMA(pa, L, H) do { _Pragma("unroll") for (int d0 = 0; d0 < 4; ++d0) \
        o[d0] = __builtin_amdgcn_mfma_f32_32x32x16_bf16(pa, (bf16x8){L[d0][0], L[d0][1], L[d0][2], L[d0][3], H[d0][0], H[d0][1], H[d0][2], H[d0][3]}, o[d0], 0, 0, 0); } while (0)
    s16x4 la[4], ha[4], lb[4], hb[4];
    PV_LOAD(la, ha, 0); PV_LOAD(lb, hb, 1);
    PV_WAIT(8); PV_MMA(pa0, la, ha);
    PV_LOAD(la, ha, 2);
    PV_WAIT(8); PV_MMA(pa1, lb, hb);
    PV_LOAD(lb, hb, 3);
    PV_WAIT(8); PV_MMA(pa2, la, ha);
    PV_WAIT(0); PV_MMA(pa3, lb, hb);
#undef PV_MMA
#undef PV_WAIT
#undef PV_LOAD
#undef TRRD
}

template <int NR, bool CAUSAL, int QMODE>
__device__ __forceinline__ void attn_block(LAS char* lds, const bf16* Q, int ldq, const bf16* Kn, int ldk, const bf16* Kr, const bf16* V, int ldv, bf16* O, int ldo,
                                           int NT, int P0, const float SCALE, const float BND  , const float* qgain, const float* qgain2, const float* rope, const bool dry = false) {
    int tid_ = threadIdx.x; asm volatile("" : "+v"(tid_));
    const int tid = tid_, wid = __builtin_amdgcn_readfirstlane(tid >> 6), lane = tid & 63, r32 = lane & 31, hi = lane >> 5;
#ifndef ATT_STAGGER
#define ATT_STAGGER 1
#endif
    const bool late = ATT_STAGGER && wid >= 4;
#ifndef ABL
#define ABL 0
#endif
#ifndef ATT_PRIO
#define ATT_PRIO 1
#endif
    const int abl = dry ? ABL : 0;
    constexpr int NOPS = 4 + (NR > 0 ? 1 : 0);
    int so_k[2], so_v[2], so_r = 0;
#pragma unroll
    for (int i = 0; i < 2; ++i) {
        const int p = 2 * wid + i;
        { const int row = 4 * p + (lane >> 4), c = (lane ^ row) & 15; so_k[i] = row * ldk + c * 8; }
        { const int st = 2 * p + (lane >> 5), kk = (st >> 2) * 8 + ((lane & 31) >> 2), key = (kk & ~0xC) | ((kk & 4) << 1) | ((kk & 8) >> 1), col = (st & 3) * 32 + (lane & 3) * 8; so_v[i] = key * ldv + col; }
    }
    if constexpr (NR > 0) { const int row = 8 * wid + (lane >> 3), c = ((lane & 7) ^ (row >> 1)) & 7; so_r = row * 64 + c * 8; }
#define DMA16(gp, loff) __builtin_amdgcn_global_load_lds((const unsigned*)(gp), (LAS unsigned*)(lds + (loff)), 16, 0, 0)
#define ISSUE(tile, ks_, vs_) do { const int k0_ = (tile) * 64; \
        DMA16(Kn + (size_t)k0_ * ldk + so_k[0], L_KN + (ks_) * SHM_KN + (2 * wid) * 1024); DMA16(Kn + (size_t)k0_ * ldk + so_k[1], L_KN + (ks_) * SHM_KN + (2 * wid + 1) * 1024); \
        if constexpr (NR > 0) DMA16(Kr + (size_t)k0_ * 64 + so_r, L_KR + (ks_) * SHM_KR + wid * 1024); \
        DMA16(V + (size_t)k0_ * ldv + so_v[0], L_V + (vs_) * SHM_V + (2 * wid) * 1024); DMA16(V + (size_t)k0_ * ldv + so_v[1], L_V + (vs_) * SHM_V + (2 * wid + 1) * 1024); } while (0)
    ISSUE(0, 0, 0); ISSUE(1, 1, 1);
    bf16x8 qr[8 + NR];
#pragma unroll
    for (int d0 = 0; d0 < 8 + NR; ++d0) qr[d0] = *(const bf16x8*)(Q + (size_t)(wid * 32 + r32) * ldq + d0 * 16 + hi * 8);
    if constexpr (QMODE >= 1) {
        float ss = 0.f;
#pragma unroll
        for (int d0 = 0; d0 < 8; ++d0)
#pragma unroll
            for (int e = 0; e < 8; ++e) { const float v = bf2f((bf16)qr[d0][e]); ss += v * v; }
        { auto rr = __builtin_amdgcn_permlane32_swap(__float_as_uint(ss), __float_as_uint(ss), false, false); ss = __uint_as_float(rr[0]) + __uint_as_float(rr[1]); }
        const float rstdc = (1.0f / sqrtf(ss * (1.f / 128.f) + EPS)) * (1.4426950408889634f * SCALE);
#pragma unroll
        for (int d0 = 0; d0 < 8; ++d0) { const f32x4 g0 = *(const f32x4*)(qgain + d0 * 16 + hi * 8), g1 = *(const f32x4*)(qgain + d0 * 16 + hi * 8 + 4); f32x4 a, b;
#pragma unroll
            for (int e = 0; e < 4; ++e) { a[e] = bf2f((bf16)qr[d0][e]) * rstdc * g0[e]; b[e] = bf2f((bf16)qr[d0][4 + e]) * rstdc * g1[e]; }
            qr[d0] = pack8(a, b); }
    }
    if constexpr (QMODE == 2 && NR == 4) {
        float ss = 0.f;
#pragma unroll
        for (int d0 = 8; d0 < 12; ++d0)
#pragma unroll
            for (int e = 0; e < 8; ++e) { const float v = bf2f((bf16)qr[d0][e]); ss += v * v; }
        { auto rr = __builtin_amdgcn_permlane32_swap(__float_as_uint(ss), __float_as_uint(ss), false, false); ss = __uint_as_float(rr[0]) + __uint_as_float(rr[1]); }
        const float rstd = (1.0f / sqrtf(ss * (1.f / 64.f) + EPS)) * (1.4426950408889634f * SCALE);
        const int pos = P0 + wid * 32 + r32;
#pragma unroll
        for (int dd = 0; dd < 2; ++dd) {
            const float* cp = rope + pos * 32 + dd * 16 + hi * 8; const float* sp = cp + SEQ * 32;
            const float* g1 = qgain2 + dd * 16 + hi * 8; const float* g2 = g1 + 32;
            f32x4 a, b, c, d;
#pragma unroll
            for (int e = 0; e < 8; ++e) { const float t1 = bf2f((bf16)qr[8 + dd][e]) * rstd * g1[e], t2 = bf2f((bf16)qr[10 + dd][e]) * rstd * g2[e], cs = cp[e], sn = sp[e];
                const float n1 = t1 * cs - t2 * sn, n2 = t1 * sn + t2 * cs;
                if (e < 4) { a[e] = n1; c[e] = n2; } else { b[e - 4] = n1; d[e - 4] = n2; } }
            qr[8 + dd] = pack8(a, b); qr[10 + dd] = pack8(c, d); }
    }
    LAS float* ws = (LAS float*)(lds + L_WS) + wid * 64; LAS float* li_l = ws; LAS float* al_l = ws + 32;
    float m_reg = -1e30f, l_reg = 0.f; f32x16 o[4] = {};
    int kbase[8], krbase[4];
#pragma unroll
    for (int d0 = 0; d0 < 8; ++d0) kbase[d0] = KSWZ(r32, 2 * d0 + hi);
#pragma unroll
    for (int dr = 0; dr < 4; ++dr) krbase[dr] = KRSWZ(r32, 2 * dr + hi);
    const int vrd = (int)(uintptr_t)lds + L_V + v_rd_base(lane), kn0 = (int)(uintptr_t)lds + L_KN, kr0 = (int)(uintptr_t)lds + L_KR;
    const int qlo = P0 + wid * 32, qm = qlo + r32 - 4 * hi;
#define RESC(a) do { if (__any((a) < 1.f)) { if (hi == 0) al_l[r32] = (a); asm volatile("s_waitcnt lgkmcnt(0)" ::: "memory");              \
        _Pragma("unroll") for (int d_ = 0; d_ < 4; ++d_) _Pragma("unroll") for (int r = 0; r < 16; ++r) o[d_][r] *= al_l[crow(r, hi)]; } } while (0)
    f32x16 p0, p1; float mn, al; bf16x8 pa0, pa1, pa2, pa3;
    const float pinit = 0.f;
    asm volatile("s_waitcnt vmcnt(0)" ::: "memory");
    int ks = 0, vs = 0;
    for (int t = 0; t < NT; ++t) {
        if constexpr (NOPS == 5) asm volatile("s_waitcnt vmcnt(5)" ::: "memory"); else asm volatile("s_waitcnt vmcnt(4)" ::: "memory");
        asm volatile("s_waitcnt lgkmcnt(0)" ::: "memory"); if (abl != 4 && abl != 5) __builtin_amdgcn_s_barrier(); asm volatile("" ::: "memory");
        if (abl != 5) { const int tn = (t + 2 < NT) ? t + 2 : NT - 1;
          int ks2 = ks + 2; if (ks2 >= NKS) ks2 -= NKS; int vs2 = vs + 2; if (vs2 >= NVS) vs2 -= NVS;
          ISSUE(tn, ks2, vs2); }
        const int kb_ = t * 64;
        if (late && t > 0 && abl != 2) { int vp = vs - 1; if (vp < 0) vp += NVS; SBAR(); __builtin_amdgcn_s_setprio(ATT_PRIO); pv_tile(o, vrd + vp * SHM_V, pa0, pa1, pa2, pa3); __builtin_amdgcn_s_setprio(0); }
        { int kaddr[8], raddr[4];
#pragma unroll
          for (int d0 = 0; d0 < 8; ++d0) kaddr[d0] = kn0 + ks * SHM_KN + kbase[d0];
#pragma unroll
          for (int dr = 0; dr < 4; ++dr) raddr[dr] = kr0 + ks * SHM_KR + krbase[dr];
          SBAR(); __builtin_amdgcn_s_setprio(ATT_PRIO); if (abl != 3) qkt<NR>(p0, p1, kaddr, raddr, qr, pinit); else { p0 = f32x16{}; p1 = f32x16{}; } __builtin_amdgcn_s_setprio(0); }
        if (CAUSAL && kb_ + 63 > qlo) mask_tile(p0, p1, qm - kb_);
        if (abl != 1) { if (BND > 0.f) staticSM(p0, p1, l_reg, pa0, pa1, pa2, pa3);
                        else { partialSM(p0, p1, m_reg, mn, al, 0.6931471805599453f); finishSM(p0, p1, al, l_reg, pa0, pa1, pa2, pa3); RESC(al); } }
        else { u32x4 w0 = {cvt_pk_bf16(p0[0], p0[1]), cvt_pk_bf16(p0[2], p0[3]), cvt_pk_bf16(p0[4], p0[5]), cvt_pk_bf16(p0[6], p0[7])}, w1 = {cvt_pk_bf16(p0[8], p0[9]), cvt_pk_bf16(p0[10], p0[11]), cvt_pk_bf16(p0[12], p0[13]), cvt_pk_bf16(p0[14], p0[15])},
                     w2 = {cvt_pk_bf16(p1[0], p1[1]), cvt_pk_bf16(p1[2], p1[3]), cvt_pk_bf16(p1[4], p1[5]), cvt_pk_bf16(p1[6], p1[7])}, w3 = {cvt_pk_bf16(p1[8], p1[9]), cvt_pk_bf16(p1[10], p1[11]), cvt_pk_bf16(p1[12], p1[13]), cvt_pk_bf16(p1[14], p1[15])};
               pa0 = __builtin_bit_cast(bf16x8, w0); pa1 = __builtin_bit_cast(bf16x8, w1); pa2 = __builtin_bit_cast(bf16x8, w2); pa3 = __builtin_bit_cast(bf16x8, w3); l_reg = 1.f; }
        SBAR();
        if (!late && abl != 2) { __builtin_amdgcn_s_setprio(ATT_PRIO); pv_tile(o, vrd + vs * SHM_V, pa0, pa1, pa2, pa3); __builtin_amdgcn_s_setprio(0); }
        if (++ks == NKS) ks = 0; if (++vs == NVS) vs = 0;
    }
    if (late) { int vp = vs - 1; if (vp < 0) vp += NVS; SBAR(); pv_tile(o, vrd + vp * SHM_V, pa0, pa1, pa2, pa3); }
    if (hi == 0) li_l[r32] = l_reg;
    asm volatile("s_waitcnt lgkmcnt(0)" ::: "memory");
    bf16* Ow = O + (size_t)(wid * 32) * ldo;
#pragma unroll
    for (int r = 0; r < 16; ++r) { const int orow = crow(r, hi); const float rli = __builtin_amdgcn_rcpf(li_l[orow]);
#pragma unroll
        for (int d0 = 0; d0 < 4; ++d0) { const float v = o[d0][r] * rli; const float vn = __shfl_xor(v, 1);
            if ((r32 & 1) == 0 && !dry) *(unsigned*)(Ow + (size_t)orow * ldo + d0 * 32 + r32) = cvt_pk_bf16(v, vn); } }
    asm volatile("s_waitcnt vmcnt(0) lgkmcnt(0)" ::: "memory"); __builtin_amdgcn_s_barrier(); asm volatile("" ::: "memory");
#undef DMA16
#undef ISSUE
#undef RESC
}
}
constexpr int NWAVES = 8;
constexpr int RING_OFF = 0, RING_BYTES = 131072;
constexpr int XTRA_OFF = RING_BYTES, XTRA_BYTES = 32256;
constexpr int MISC_OFF = XTRA_OFF + XTRA_BYTES;
constexpr int LDS_BYTES = MISC_OFF + 512;
static_assert(LDS_BYTES == 163840, "LDS map");

constexpr size_t WB_GU0 = 0, WB_D0 = 11 * MiB, WB_GU1 = WB_D0 + (size_t)DM * FF * 2, WB_D1 = WB_GU1 + 11 * MiB, WB_WO = 33 * MiB, WB_IN = 36 * MiB, WB_UQ = 43 * MiB, WB_UKV = 45 * MiB;
static_assert(WB_D1 + (size_t)DM * FF * 2 <= WB_WO && WB_UKV + 1 * MiB <= 52 * MiB && WS_WB + 52 * MiB <= WS_XN, "weight map");
constexpr size_t WS_MEMW = WS_BIG;

constexpr int CW_BAR = 4096;
constexpr size_t WS_RS = 78 * MiB;
constexpr size_t CTL_ZERO_BYTES = 1 * MiB;
static_assert(WS_WB + 46 * MiB <= WS_RS && WS_RS + 12 * (size_t)M * 16 <= WS_XN, "row sums sit between the weight copies and XN");

struct MArgs { const float* in[29]; float* out; unsigned char* ws; int lo, hi, region, pad; };
static_assert(sizeof(MArgs) == 264, "no padding in the argument struct");

struct Frame {
    LAS unsigned char* lds;
    int vcu, G;
    float* X; unsigned char* ws; bf16* OC;
};
#define PH_IDS() int tid_ = threadIdx.x; asm volatile("" : "+v"(tid_)); const int tid = tid_, lane = tid & 63, wave = __builtin_amdgcn_readfirstlane(tid >> 6); (void)tid; (void)lane; (void)wave

__device__ __forceinline__ void tr_item(const float* W, int ldw, int scol, int k0, bf16* WT, int K, int drow, LAS float* scr, int lane, int nv, const float* gain) {
    const int c = lane & 7;
    if (nv == 0) {
#pragma unroll
        for (int j = 0; j < 4; ++j) { const int n = (lane >> 3) + 8 * j; *(GAS u32x4*)(WT + (size_t)(drow + n) * K + k0 + 8 * c) = (u32x4){0u, 0u, 0u, 0u}; }
        return;
    }
    const int n4 = (lane & 7) * 4, kq = lane >> 3;
    const GAS float* Wg = (const GAS float*)W + (size_t)(k0 + kq) * ldw + scol + n4;
    const bool val = n4 < nv;
    f32x4 wv[8];
#pragma unroll
    for (int i = 0; i < 8; ++i) wv[i] = val ? *(const GAS f32x4*)(Wg + (size_t)(8 * i) * ldw) : (f32x4){0.f, 0.f, 0.f, 0.f};
#pragma unroll
    for (int i = 0; i < 8; ++i) { LAS float* d = scr + (kq + 8 * i) * 33 + n4; d[0] = wv[i].x; d[1] = wv[i].y; d[2] = wv[i].z; d[3] = wv[i].w; }
    f32x4 g0 = (f32x4){1.f, 1.f, 1.f, 1.f}, g1 = g0;
    if (gain) { g0 = *(const GAS f32x4*)(gain + k0 + 8 * c); g1 = *(const GAS f32x4*)(gain + k0 + 8 * c + 4); }
    LDS_WAIT(); asm volatile("" ::: "memory");
#pragma unroll
    for (int j = 0; j < 4; ++j) { const int n = (lane >> 3) + 8 * j; const LAS float* s = scr + (8 * c) * 33 + n;
        u32x4 o; o.x = cvt_pk_bf16(s[0 * 33] * g0[0], s[1 * 33] * g0[1]); o.y = cvt_pk_bf16(s[2 * 33] * g0[2], s[3 * 33] * g0[3]); o.z = cvt_pk_bf16(s[4 * 33] * g1[0], s[5 * 33] * g1[1]); o.w = cvt_pk_bf16(s[6 * 33] * g1[2], s[7 * 33] * g1[3]);
        *(GAS u32x4*)(WT + (size_t)(drow + n) * K + k0 + 8 * c) = o; }
    LDS_WAIT(); asm volatile("" ::: "memory");
}

__device__ __forceinline__ void norm_row(const float* xrow, const f32x4 (&gg)[4], bf16* orow, int lane, f32x4 (&v)[4]) {
    const GAS f32x4* xr = (const GAS f32x4*)xrow + lane; float s = 0.f;
#pragma unroll
    for (int j = 0; j < 4; ++j) { v[j] = xr[64 * j]; s += (v[j].x * v[j].x + v[j].y * v[j].y) + (v[j].z * v[j].z + v[j].w * v[j].w); }
    const float rstd = 1.0f / sqrtf(wave_sum(s) * (1.f / DM) + EPS);
    GAS u32x2* o8 = (GAS u32x2*)orow + lane;
#pragma unroll
    for (int j = 0; j < 4; ++j) { v[j] = v[j] * rstd * gg[j]; u32x2 w; w.x = cvt_pk_bf16(v[j].x, v[j].y); w.y = cvt_pk_bf16(v[j].z, v[j].w); o8[64 * j] = w; }
}

__device__ __forceinline__ void raw_row(const float* xrow, bf16* orow, float* rs_out, int lane) {
    const GAS f32x4* xr = (const GAS f32x4*)xrow + lane; f32x4 v[4]; float s = 0.f;
#pragma unroll
    for (int j = 0; j < 4; ++j) { v[j] = xr[64 * j]; s += (v[j].x * v[j].x + v[j].y * v[j].y) + (v[j].z * v[j].z + v[j].w * v[j].w); }
    s = wave_sum(s);
    GAS u32x2* o8 = (GAS u32x2*)orow + lane;
#pragma unroll
    for (int j = 0; j < 4; ++j) { u32x2 w; w.x = cvt_pk_bf16(v[j].x, v[j].y); w.y = cvt_pk_bf16(v[j].z, v[j].w); o8[64 * j] = w; }
    if (lane == 0) *(GAS f32x4*)rs_out = (f32x4){s, 0.f, 0.f, 0.f};
}
__device__ __forceinline__ void ph_prologue(Frame& F, const float* x, const float* mem, const float* mn, const float* memw) {
    PH_IDS();
    const int gt = F.vcu * 512 + tid, NT = F.G * 512, gw = F.vcu * NWAVES + wave, NGW = F.G * NWAVES;
    { bf16* XB = (bf16*)(F.ws + WS_XN); float* RS0 = (float*)(F.ws + WS_RS);
      for (int m = gw; m < M; m += NGW) raw_row(x + (size_t)m * DM, XB + (size_t)m * DM, RS0 + (size_t)m * 4, lane); }
    { float* cs = (float*)(F.ws + WS_ROPE);
      const int f = gt & 31; const float ex = (float)(2 * f) / 64.0f; const float inv = (float)(1.0 / pow(10000.0, (double)ex));
      for (int i = gt; i < SEQ * 32; i += NT) { const int pos = i >> 5; const float ang = (float)pos * inv; float sn, cn; sincosf(ang, &sn, &cn);
          cs[i] = cn; cs[SEQ * 32 + i] = sn; } }
    { bf16* MEMH = (bf16*)(F.ws + WS_MEMH);
      for (int r = gw; r < 4 * 1024; r += NGW) { const int l = r >> 10, row = r & 1023; f32x4 gg[4], v[4];
#pragma unroll
          for (int j = 0; j < 4; ++j) gg[j] = ((const f32x4*)(mn + l * DM))[lane + 64 * j];
          norm_row(mem + (size_t)row * DM, gg, MEMH + (size_t)r * DM, lane, v); } }
    { LAS float* scr = (LAS float*)(F.lds + RING_OFF + wave * 16384); bf16* MW = (bf16*)(F.ws + WS_MEMW);
      for (int it = gw; it < 4 * 512; it += NGW) { const int l = it >> 9, r = it & 511, kb = r >> 5, nb = r & 31;
          tr_item(memw + (size_t)l * DM * DM, DM, 32 * nb, 64 * kb, MW + (size_t)l * DM * DM, DM, 32 * nb, scr, lane, 32, nullptr); } }
}
__device__ __forceinline__ void ph_memknorm(Frame& F, const float* memk_norm) {
    PH_IDS();
    const int gw = F.vcu * NWAVES + wave, NGW = F.G * NWAVES; bf16* KVm = (bf16*)(F.ws + WS_MEMKV);
    for (int idx = gw; idx < 4096 * 4; idx += NGW) { const int row = idx >> 2, h = idx & 3, l = row >> 10;
        bf16* p = KVm + (size_t)row * 1024 + h * 128 + lane * 2; const float* g = memk_norm + l * 128;
        const float a = bf2f(p[0]), b = bf2f(p[1]);
        const float rstd = 1.0f / sqrtf(wave_sum(a * a + b * b) * (1.f / 128.f) + EPS);
        *(GAS unsigned*)p = cvt_pk_bf16(a * rstd * g[lane * 2], b * rstd * g[lane * 2 + 1]); }
}
struct ConvPtrs { const float *g0, *u0, *d0, *g1, *u1, *d1, *wo, *gin, *min, *uq, *ukv, *n1, *n2, *nm; };
template <int MAP>
__device__ __forceinline__ void conv_job(Frame& F, const float* W, int ldw, int nkb, int nblk, bf16* dst, int K, int& rot, LAS float* scr, int wave, int lane, const float* gain) {
    const int NGW = F.G * NWAVES; int gw = F.vcu * NWAVES + wave - rot; if (gw < 0) gw += NGW;
    const int total = nkb * nblk;
    for (int r = gw; r < total; r += NGW) {
        const int kb = r / nblk, nb = r - kb * nblk; int scol = 32 * nb, drow = 32 * nb, nv = 32;
        if (MAP == 1) drow = 32 * ((nb >> 2) * 8 + (nb & 3));
        if (MAP == 2) drow = 32 * ((nb >> 2) * 8 + 4 + (nb & 3));
        if (MAP == 3) { scol = drow < 1024 ? drow : drow < 2048 ? drow + 1040 : drow < 3072 ? drow - 1024 : drow < 3584 ? drow + 16 : 2048; nv = drow < 3584 ? 32 : drow == 3584 ? 16 : 0; }
        if (MAP == 4) nv = drow >= MLA_IN ? 0 : 32;
        tr_item(W, ldw, scol, 64 * kb, dst, K, drow, scr, lane, nv, gain);
    }
    rot = (rot + total) % NGW;
}
__device__ __forceinline__ void conv_layer(Frame& F, int i, const ConvPtrs& cp) {
    PH_IDS();
    const int j = i >> 1; const bool gla = !(i & 1);
    LAS float* scr = (LAS float*)(F.lds + RING_OFF + wave * 16384);
    unsigned char* wb = F.ws + WS_WB; int rot = 0;
    conv_job<1>(F, cp.g0 + (size_t)i * DM * FF, FF, 16, 88, (bf16*)(wb + WB_GU0), DM, rot, scr, wave, lane, cp.n1 + i * DM);
    conv_job<2>(F, cp.u0 + (size_t)i * DM * FF, FF, 16, 88, (bf16*)(wb + WB_GU0), DM, rot, scr, wave, lane, cp.n1 + i * DM);
    conv_job<1>(F, cp.g1 + (size_t)i * DM * FF, FF, 16, 88, (bf16*)(wb + WB_GU1), DM, rot, scr, wave, lane, cp.n2 + i * DM);
    conv_job<2>(F, cp.u1 + (size_t)i * DM * FF, FF, 16, 88, (bf16*)(wb + WB_GU1), DM, rot, scr, wave, lane, cp.n2 + i * DM);
    conv_job<0>(F, cp.d0 + (size_t)i * FF * DM, DM, 44, 32, (bf16*)(wb + WB_D0), FF, rot, scr, wave, lane, nullptr);
    conv_job<0>(F, cp.d1 + (size_t)i * FF * DM, DM, 44, 32, (bf16*)(wb + WB_D1), FF, rot, scr, wave, lane, nullptr);
    conv_job<0>(F, cp.wo + (size_t)i * 1536 * DM, DM, 24, 32, (bf16*)(wb + WB_WO), 1536, rot, scr, wave, lane, nullptr);
    if (gla) conv_job<3>(F, cp.gin + (size_t)j * DM * GLA_IN, GLA_IN, 16, 120, (bf16*)(wb + WB_IN), DM, rot, scr, wave, lane, cp.nm + i * DM);
    else {
        conv_job<4>(F, cp.min + (size_t)j * DM * MLA_IN, MLA_IN, 16, 40, (bf16*)(wb + WB_IN), DM, rot, scr, wave, lane, cp.nm + i * DM);
        conv_job<0>(F, cp.uq + (size_t)j * 384 * QW, QW, 6, 48, (bf16*)(wb + WB_UQ), 384, rot, scr, wave, lane, nullptr);
        conv_job<0>(F, cp.ukv + (size_t)j * 256 * KVW, KVW, 4, 64, (bf16*)(wb + WB_UKV), 256, rot, scr, wave, lane, nullptr);
    }
}
__device__ __forceinline__ void ph_mla_rowprep(Frame& F, const float* gq, const float* gkv, const float* gkr, const bool dry = false) {
    PH_IDS();
    const int gw = F.vcu * NWAVES + wave, NGW = F.G * NWAVES;
    bf16* P = (bf16*)(F.ws + WS_PM); bf16* KR = (bf16*)(F.ws + WS_KR); const float* rope = (const float*)(F.ws + WS_ROPE);
    f32x4 ga[2], gb[2];
    { const float* g = lane < 48 ? gq + 8 * lane : gkv + 8 * (lane - 48); ga[0] = *(const f32x4*)g; ga[1] = *(const f32x4*)(g + 4); }
    { const float* g = lane < 16 ? gkv + 8 * (16 + lane) : gkr + 8 * ((lane - 16) & 7); gb[0] = *(const f32x4*)g; gb[1] = *(const f32x4*)(g + 4); }
    for (int m = gw; m < M; m += NGW) {
        bf16* p = P + (size_t)m * PM;
        const bf16x8 c0 = *(const bf16x8*)(p + 8 * lane);
        bf16x8 c1 = (bf16x8){0, 0, 0, 0, 0, 0, 0, 0}; if (lane < 24) c1 = *(const bf16x8*)(p + 512 + 8 * lane);
        float a[8], b[8]; float s0 = 0.f, s1 = 0.f;
#pragma unroll
        for (int e = 0; e < 8; ++e) { a[e] = bf2f((bf16)c0[e]); b[e] = bf2f((bf16)c1[e]); s0 += a[e] * a[e]; s1 += b[e] * b[e]; }
        const float sq = wave_sum(lane < 48 ? s0 : 0.f), skv = wave_sum((lane >= 48 ? s0 : 0.f) + (lane < 16 ? s1 : 0.f)), skr = wave_sum((lane >= 16 && lane < 24) ? s1 : 0.f);
        const float rq = 1.0f / sqrtf(sq * (1.f / 384.f) + EPS), rkv = 1.0f / sqrtf(skv * (1.f / 256.f) + EPS), rkr = 1.0f / sqrtf(skr * (1.f / 64.f) + EPS);
        const float r0 = lane < 48 ? rq : rkv, r1 = lane < 16 ? rkv : rkr;
        f32x4 x0, x1, y0, y1;
#pragma unroll
        for (int e = 0; e < 4; ++e) { x0[e] = a[e] * r0 * ga[0][e]; x1[e] = a[4 + e] * r0 * ga[1][e]; y0[e] = b[e] * r1 * gb[0][e]; y1[e] = b[4 + e] * r1 * gb[1][e]; }
        if (!dry) *(bf16x8*)(p + 8 * lane) = att::pack8(x0, x1);
        if (lane < 16 && !dry) *(bf16x8*)(p + 512 + 8 * lane) = att::pack8(y0, y1);
        const int ck = (lane - 16) & 7, pos = m % SEQ; const float* cp = rope + pos * 32 + 8 * (ck & 3); const float* sp = cp + SEQ * 32;
        const f32x4 cs0 = *(const f32x4*)cp, cs1 = *(const f32x4*)(cp + 4), sn0 = *(const f32x4*)sp, sn1 = *(const f32x4*)(sp + 4);
        f32x4 o0, o1;
#pragma unroll
        for (int e = 0; e < 4; ++e) { const float t0 = __shfl_xor(y0[e], 4), t1 = __shfl_xor(y1[e], 4);
            o0[e] = ck < 4 ? (y0[e] * cs0[e] - t0 * sn0[e]) : (t0 * sn0[e] + y0[e] * cs0[e]);
            o1[e] = ck < 4 ? (y1[e] * cs1[e] - t1 * sn1[e]) : (t1 * sn1[e] + y1[e] * cs1[e]); }
        if (lane >= 16 && lane < 24 && !dry) *(bf16x8*)(KR + (size_t)m * 64 + 8 * ck) = att::pack8(o0, o1);
    }
}
__device__ __forceinline__ void ph_mla_knorm(Frame& F, const float* gkn, const bool dry = false) {
    PH_IDS();
    const int gw = F.vcu * NWAVES + wave, NGW = F.G * NWAVES; bf16* KV = (bf16*)(F.ws + WS_KV);
    f32x4 g[4];
#pragma unroll
    for (int q = 0; q < 4; ++q) g[q] = *(const f32x4*)(gkn + (lane & 7) * 16 + 4 * q);
    for (int m = gw; m < M; m += NGW) {
        bf16* p = KV + (size_t)m * KVW + (lane >> 3) * 256 + (lane & 7) * 16;
        const bf16x8 c0 = *(const bf16x8*)p, c1 = *(const bf16x8*)(p + 8);
        float a[16]; float s = 0.f;
#pragma unroll
        for (int e = 0; e < 8; ++e) { a[e] = bf2f((bf16)c0[e]); a[8 + e] = bf2f((bf16)c1[e]); s += a[e] * a[e] + a[8 + e] * a[8 + e]; }
        s += __shfl_xor(s, 1); s += __shfl_xor(s, 2); s += __shfl_xor(s, 4);
        const float rstd = 1.0f / sqrtf(s * (1.f / 128.f) + EPS);
        f32x4 x[4];
#pragma unroll
        for (int q = 0; q < 4; ++q)
#pragma unroll
            for (int e = 0; e < 4; ++e) x[q][e] = a[4 * q + e] * rstd * g[q][e];
        if (!dry) { *(bf16x8*)p = att::pack8(x[0], x[1]); *(bf16x8*)(p + 8) = att::pack8(x[2], x[3]); }
    }
}
__device__ __forceinline__ float wave_absmax(const float* g, int n, int lane) {
    float m = fabsf(g[lane]); if (n > 64) m = fmaxf(m, fabsf(g[64 + lane]));
#pragma unroll
    for (int o = 1; o < 64; o <<= 1) m = fmaxf(m, __shfl_xor(m, o));
    return m;
}
__device__ __forceinline__ void ph_memattn(Frame& F, int layer, bool gla, const float* qgain, const float* kgain, const bool dry = false) {
    float bnd; { PH_IDS(); bnd = 0.08838834764831845f * 128.f * wave_absmax(qgain, 128, lane) * wave_absmax(kgain, 128, lane) * 1.03f; if (!(bnd < 40.f)) bnd = 0.f; }
    const bf16* memkv = (const bf16*)(F.ws + WS_MEMKV) + (size_t)layer * 1024 * 1024;
    for (int x = F.vcu; x < 512; x += F.G) {
        const int b = x >> 7, h = (x >> 5) & 3, qb = x & 31; const size_t row0 = (size_t)b * SEQ + 256 * qb;
        const bf16* Q; bf16* O; int ldq, ldo;
        if (gla) { bf16* P = (bf16*)(F.ws + WS_PG); Q = P + row0 * PG + PG_QM + h * 128; O = P + row0 * PG + PG_QM + h * 128; ldq = PG; ldo = PG; }
        else { Q = (const bf16*)(F.ws + WS_PM) + row0 * PM + PM_QM + h * 128; O = F.OC + row0 * OCW + 1024 + h * 128; ldq = PM; ldo = OCW; }
        const bf16* Kn = memkv + (size_t)b * NMEM * 1024 + h * 128;
        att::attn_block<0, false, 1>((LAS char*)F.lds, Q, ldq, Kn, 1024, nullptr, Kn + 512, 1024, O, ldo, 4, 0, 0.08838834764831845f, bnd, qgain, nullptr, nullptr, dry);
    }
}

__device__ __forceinline__ void ph_mla_attn(Frame& F, const float* gqn, const float* gqr, const float* gkn, const float* gkr, const bool dry = false) {
    float bnd; { PH_IDS(); bnd = 0.07216878364870322f * (128.f * wave_absmax(gqn, 128, lane) * wave_absmax(gkn, 128, lane) + 64.f * wave_absmax(gqr, 64, lane) * wave_absmax(gkr, 64, lane)) * 1.03f; if (!(bnd < 40.f)) bnd = 0.f; }
    const bf16* Qb = (const bf16*)(F.ws + WS_Q); const bf16* KVb = (const bf16*)(F.ws + WS_KV); const bf16* KRb = (const bf16*)(F.ws + WS_KR); bf16* OC = F.OC;
    const float* rope = (const float*)(F.ws + WS_ROPE);
    for (int x = F.vcu; x < 512; x += F.G) {
        const int bh = x >> 4, y = x & 15, b = bh >> 3, h = bh & 7;
        for (int pass = 0; pass < 2; ++pass) {
            const int qb = pass ? y : 31 - y; const size_t row0 = (size_t)b * SEQ + 256 * qb; const bf16* Kn = KVb + (size_t)b * SEQ * KVW + h * 256;
            att::attn_block<4, true, 2>((LAS char*)F.lds, Qb + row0 * QW + h * 192, QW, Kn, KVW, KRb + (size_t)b * SEQ * 64, Kn + 128, KVW, OC + row0 * OCW + h * 128, OCW,
                                        4 * (qb + 1), 256 * qb, 0.07216878364870322f, bnd, gqn, gqr, rope, dry);
        }
    }
}

constexpr int GCH = 128, GNU = 1024;
__device__ __forceinline__ void ph_gla_prep(Frame& F, const float* wa  , const float* ba  , const bool dry = false) {
    PH_IDS();
    const int u4 = wave >> 1, c = tid & 127;
    bf16* P = (bf16*)(F.ws + WS_PG); const float* ALOW = (const float*)(F.ws + WS_ALOW); float* GV = (float*)(F.ws + WS_GV);
    LAS float* EQ = (LAS float*)F.lds;
    LAS float* AL = (LAS float*)(F.lds + 131072);
    for (int ub = F.vcu * 4; ub < GNU; ub += F.G * 4) {
        const int unit = ub + u4, h = unit & 3; const size_t row0 = (size_t)(unit >> 2) * GCH;
        ((LAS f32x4*)AL)[tid] = ((const f32x4*)(ALOW + (size_t)(ub >> 2) * GCH * 16))[tid];
        float w[16];
#pragma unroll
        for (int k = 0; k < 16; ++k) w[k] = wa[k * 512 + h * 128 + c];
        const float bias = ba[h * 128 + c];
        float run = 0.f, bref = 0.f;
        __syncthreads();
#pragma unroll 1
        for (int hf = 0; hf < 2; ++hf) {
            float bc[64];
            const LAS float* al = AL + (64 * hf) * 16;
#pragma unroll
            for (int r = 0; r < 64; ++r) { float z = bias;
#pragma unroll
                for (int k = 0; k < 16; ++k) z += al[r * 16 + k] * w[k];
                const float ls = fminf(z, 0.f) - 0.6931471805599453f * __builtin_amdgcn_logf(1.0f + __builtin_amdgcn_exp2f(-1.4426950408889634f * fabsf(z)));
                run += ls * (1.f / 16.f); bc[r] = run; }
            if (hf == 0) bref = bc[63];
            LAS float* eqp = EQ + (size_t)(u4 * 64) * 128 + c;
#pragma unroll
            for (int r = 0; r < 64; ++r) eqp[r * 128] = __builtin_amdgcn_exp2f(1.4426950408889634f * (bc[r] - bref));
            __syncthreads();
            int tl = tid; asm volatile("" : "+v"(tl));
#pragma unroll
            for (int q8 = 0; q8 < 8; ++q8) { const int idx = tl + 512 * q8, us = idx >> 10, row = (idx >> 4) & 63, ch = idx & 15;
                const int un2 = ub + us, h2 = un2 & 3; const size_t rw = (size_t)(un2 >> 2) * GCH + 64 * hf + row;
                bf16* qp = P + rw * PG + PG_Q + h2 * 128 + ch * 8; bf16* kp = P + rw * PG + PG_K + h2 * 128 + ch * 8;
                const u32x4 qv = *(const u32x4*)qp, kv = *(const u32x4*)kp;
                const f32x4 e0 = *(const LAS f32x4*)(EQ + (size_t)(us * 64 + row) * 128 + ch * 8), e1 = *(const LAS f32x4*)(EQ + (size_t)(us * 64 + row) * 128 + ch * 8 + 4);
                u32x4 qo, ko;
#define GP2(xw, ea, eb, OUTQ) cvt_pk_bf16(__uint_as_float((xw) << 16) * (ea) * (OUTQ ? 0.08838834764831845f : 1.f), __uint_as_float((xw) & 0xffff0000u) * (eb) * (OUTQ ? 0.08838834764831845f : 1.f))
                qo.x = GP2(qv.x, e0[0], e0[1], true); qo.y = GP2(qv.y, e0[2], e0[3], true); qo.z = GP2(qv.z, e1[0], e1[1], true); qo.w = GP2(qv.w, e1[2], e1[3], true);
                const f32x4 i0 = {__builtin_amdgcn_rcpf(e0[0]), __builtin_amdgcn_rcpf(e0[1]), __builtin_amdgcn_rcpf(e0[2]), __builtin_amdgcn_rcpf(e0[3])}, i1 = {__builtin_amdgcn_rcpf(e1[0]), __builtin_amdgcn_rcpf(e1[1]), __builtin_amdgcn_rcpf(e1[2]), __builtin_amdgcn_rcpf(e1[3])};
                ko.x = GP2(kv.x, i0[0], i0[1], false); ko.y = GP2(kv.y, i0[2], i0[3], false); ko.z = GP2(kv.z, i1[0], i1[1], false); ko.w = GP2(kv.w, i1[2], i1[3], false);
#undef GP2
                if (!dry) { *(u32x4*)qp = qo; *(u32x4*)kp = ko; } }
            __syncthreads();
        }
        const float blast = run;
        float* gv = GV + (size_t)unit * 384 + c;
        if (!dry) { gv[0] = __builtin_amdgcn_exp2f(1.4426950408889634f * blast); gv[128] = __builtin_amdgcn_exp2f(1.4426950408889634f * (blast - bref)); gv[256] = __builtin_amdgcn_exp2f(1.4426950408889634f * bref); }
    }
}
#define GL_TRRD(dst, base, off) asm volatile("ds_read_b64_tr_b16 %0, %1 offset:%2" : "=&v"(dst) : "v"(base), "i"(off) : "memory")
#define GL_FRAG(out, base, d0, ks) do { att::s16x4 l_, h_; GL_TRRD(l_, base, (d0) * 512 + (ks) * 4096); GL_TRRD(h_, base, (d0) * 512 + (ks) * 4096 + 2048); \
        asm volatile("s_waitcnt lgkmcnt(0)" ::: "memory"); __builtin_amdgcn_sched_barrier(0); out = (bf16x8){l_[0], l_[1], l_[2], l_[3], h_[0], h_[1], h_[2], h_[3]}; } while (0)
#define GL_STAGE_V() do { const bf16* vp = P + (row0 + sr) * PG + PG_V + h * 256 + sc; \
        _Pragma("unroll") for (int q4 = 0; q4 < 4; ++q4) { const bf16x8 x0 = *(const bf16x8*)(vp + (size_t)(32 * q4) * PG), x1 = *(const bf16x8*)(vp + (size_t)(32 * q4) * PG + 128); \
            const int o_ = (q4 >> 1) * 32768 + ((q4 & 1) ? vst1 : vst0); *(LAS bf16x8*)(lds + o_) = x0; *(LAS bf16x8*)(lds + o_ + 16384) = x1; } } while (0)
__device__ __forceinline__ void ph_gla_u(Frame& F) {
    PH_IDS();
    const int r32 = lane & 31, hi = lane >> 5, sr = tid >> 4, sc = (tid & 15) * 8;
    const bf16* P = (const bf16*)(F.ws + WS_PG); bf16* US = (bf16*)(F.ws + WS_US); const float* GV = (const float*)(F.ws + WS_GV);
    LAS char* lds = (LAS char*)F.lds;
    const int vst0 = att::v_st(sr, sc), vst1 = att::v_st(32 + sr, sc);
    const int vbA = (int)(uintptr_t)lds + att::v_rd_base(lane) + (wave >> 2) * 16384 + (wave & 3) * 512, vbB = (int)(uintptr_t)lds + att::v_rd_base(lane) + 65536;
    for (int unit = F.vcu; unit < GNU; unit += F.G) {
        const int h = unit & 3; const size_t row0 = (size_t)(unit >> 2) * GCH;
        GL_STAGE_V();
        { const bf16* kp = P + (row0 + sr) * PG + PG_K + h * 128 + sc;
#pragma unroll
          for (int q4 = 0; q4 < 4; ++q4) { const bf16x8 x0 = *(const bf16x8*)(kp + (size_t)(32 * q4) * PG); *(LAS bf16x8*)(lds + 65536 + (q4 >> 1) * 16384 + ((q4 & 1) ? vst1 : vst0)) = x0; } }
        __syncthreads();
        att::f32x16 acc[4] = {};
#pragma unroll
        for (int jh = 0; jh < 2; ++jh)
#pragma unroll
            for (int ks = 0; ks < 4; ++ks) { bf16x8 a; GL_FRAG(a, vbA + jh * 32768, 0, ks);
#pragma unroll
                for (int nb = 0; nb < 4; ++nb) { bf16x8 b; GL_FRAG(b, vbB + jh * 16384, nb, ks); acc[nb] = __builtin_amdgcn_mfma_f32_32x32x16_bf16(a, b, acc[nb], 0, 0, 0); } }
        bf16* up = US + (size_t)unit * 32768 + (size_t)(wave * 32) * 128 + r32;
#pragma unroll
        for (int nb = 0; nb < 4; ++nb) { const float e2 = GV[(size_t)unit * 384 + 128 + nb * 32 + r32];
#pragma unroll
            for (int r = 0; r < 16; ++r) up[(size_t)att::crow(r, hi) * 128 + nb * 32] = f2bf(acc[nb][r] * e2); }
        __syncthreads();
    }
}
__device__ __forceinline__ void ph_gla_scan(Frame& F, const bool dry = false) {
    PH_IDS();
    bf16* US = (bf16*)(F.ws + WS_US); const float* GV = (const float*)(F.ws + WS_GV);
    for (int e = F.vcu * 512 + tid; e < 131072; e += F.G * 512) {
        const int dkq = e & 31, dv = (e >> 5) & 255, bh = e >> 13, b = bh >> 2, h = bh & 3;
        f32x4 S = (f32x4){0.f, 0.f, 0.f, 0.f};
        const size_t ustride = (size_t)4 * 32768;
        bf16* up = US + ((size_t)(b * 64) * 4 + h) * 32768 + (size_t)dv * 128 + dkq * 4;
        const float* gp = GV + ((size_t)(b * 64) * 4 + h) * 384 + dkq * 4;
        for (int n = 0; n < 64; n += 4) {
            u32x2 uu[4]; f32x4 dc[4], e1[4];
#pragma unroll
            for (int q = 0; q < 4; ++q) { uu[q] = *(const GAS u32x2*)(up + (size_t)(n + q) * ustride); dc[q] = *(const GAS f32x4*)(gp + (size_t)(n + q) * 4 * 384); e1[q] = *(const GAS f32x4*)(gp + (size_t)(n + q) * 4 * 384 + 256); }
#pragma unroll
            for (int q = 0; q < 4; ++q) {
                const f32x4 s1 = S * e1[q]; u32x2 w; w.x = cvt_pk_bf16(s1.x, s1.y); w.y = cvt_pk_bf16(s1.z, s1.w);
                if (!dry) *(GAS u32x2*)(up + (size_t)(n + q) * ustride) = w;
                f32x4 u; u.x = __uint_as_float(uu[q].x << 16); u.y = __uint_as_float(uu[q].x & 0xffff0000u); u.z = __uint_as_float(uu[q].y << 16); u.w = __uint_as_float(uu[q].y & 0xffff0000u);
                S = S * dc[q] + u; }
        }
    }
}
template <int B_> __device__ __forceinline__ bf16x8 gl_pk4(const att::f32x16& P) {
    const unsigned a0 = cvt_pk_bf16(P[B_ + 0], P[B_ + 1]), a1 = cvt_pk_bf16(P[B_ + 2], P[B_ + 3]), b0 = cvt_pk_bf16(P[B_ + 4], P[B_ + 5]), b1 = cvt_pk_bf16(P[B_ + 6], P[B_ + 7]);
    auto r0 = __builtin_amdgcn_permlane32_swap(a0, b0, false, false); auto r1 = __builtin_amdgcn_permlane32_swap(a1, b1, false, false);
    u32x4 w = {r0[0], r1[0], r0[1], r1[1]}; return __builtin_bit_cast(bf16x8, w);
}
__device__ __forceinline__ void ph_gla_out(Frame& F, const float* gout  , const bool dry = false) {
    PH_IDS();
    const int r32 = lane & 31, hi = lane >> 5, sr = tid >> 4, sc = (tid & 15) * 8, it = wave & 3, grp = wave >> 2;
    bf16* P = (bf16*)(F.ws + WS_PG); const bf16* US = (const bf16*)(F.ws + WS_US);
    constexpr int L_K = 65536, L_PART = 135168, L_RSTD = 136192, TP = 1040;
    LAS char* lds = (LAS char*)F.lds; LAS float* part = (LAS float*)(lds + L_PART); LAS float* rstd_l = (LAS float*)(lds + L_RSTD);
    const int vst0 = att::v_st(sr, sc), vst1 = att::v_st(32 + sr, sc);
    const int vb = (int)(uintptr_t)lds + att::v_rd_base(lane) + grp * 16384;
    int kbase[8];
#pragma unroll
    for (int d0 = 0; d0 < 8; ++d0) kbase[d0] = (int)(uintptr_t)lds + L_K + KSWZ(r32, 2 * d0 + hi);
    float g4[4];
#pragma unroll
    for (int blk = 0; blk < 4; ++blk) g4[blk] = gout[grp * 128 + blk * 32 + r32];
    for (int unit = F.vcu; unit < GNU; unit += F.G) {
        const int h = unit & 3; const size_t row0 = (size_t)(unit >> 2) * GCH;
        GL_STAGE_V();
        { const bf16* kp = P + (row0 + sr) * PG + PG_K + h * 128 + sc;
#pragma unroll
          for (int q4 = 0; q4 < 4; ++q4) { const bf16x8 x0 = *(const bf16x8*)(kp + (size_t)(32 * q4) * PG); const int row = sr + 32 * q4; *(LAS bf16x8*)(lds + L_K + KSWZ(row, tid & 15)) = x0; } }
        bf16x8 qr[8];
        { const bf16* qp = P + (row0 + 32 * it + r32) * PG + PG_Q + h * 128 + hi * 8;
#pragma unroll
          for (int d0 = 0; d0 < 8; ++d0) qr[d0] = *(const bf16x8*)(qp + d0 * 16); }
        const bf16* sp = US + (size_t)unit * 32768 + (size_t)(grp * 128 + r32) * 128 + hi * 8;
        bf16x8 ub[8];
#pragma unroll
        for (int ks = 0; ks < 2; ++ks)
#pragma unroll
            for (int blk = 0; blk < 4; ++blk) ub[ks * 4 + blk] = *(const bf16x8*)(sp + (size_t)(blk * 32) * 128 + ks * 16);
        __syncthreads();
        att::f32x16 o[4] = {};
#define GL_KRD(dst, addr, off) asm volatile("ds_read_b128 %0, %1 offset:%2" : "=&v"(dst) : "v"(addr), "i"(off) : "memory")
#define GL_JT(jt) do { att::f32x16 p = {}; bf16x8 kf[8]; \
            _Pragma("unroll") for (int d0 = 0; d0 < 8; ++d0) GL_KRD(kf[d0], kbase[d0], (jt) * 8192); \
            asm volatile("s_waitcnt lgkmcnt(0)" : "+v"(kf[0]), "+v"(kf[1]), "+v"(kf[2]), "+v"(kf[3]), "+v"(kf[4]), "+v"(kf[5]), "+v"(kf[6]), "+v"(kf[7]) :: "memory"); __builtin_amdgcn_sched_barrier(0); \
            _Pragma("unroll") for (int d0 = 0; d0 < 8; ++d0) p = __builtin_amdgcn_mfma_f32_32x32x16_bf16(kf[d0], qr[d0], p, 0, 0, 0); \
            __builtin_amdgcn_sched_barrier(0); \
            att::s16x4 vl[8], vh[8]; \
            _Pragma("unroll") for (int f = 0; f < 8; ++f) { GL_TRRD(vl[f], vb + ((jt) >> 1) * 32768, (f >> 1) * 512 + (2 * ((jt) & 1) + (f & 1)) * 4096); GL_TRRD(vh[f], vb + ((jt) >> 1) * 32768, (f >> 1) * 512 + (2 * ((jt) & 1) + (f & 1)) * 4096 + 2048); } \
            if ((jt) == it) { _Pragma("unroll") for (int r = 0; r < 16; ++r) if (att::crow(r, hi) > r32) p[r] = 0.f; } \
            const bf16x8 paA = gl_pk4<0>(p), paB = gl_pk4<8>(p); \
            asm volatile("s_waitcnt lgkmcnt(0)" : "+v"(vl[0]), "+v"(vh[0]), "+v"(vl[1]), "+v"(vh[1]), "+v"(vl[2]), "+v"(vh[2]), "+v"(vl[3]), "+v"(vh[3]), "+v"(vl[4]), "+v"(vh[4]), "+v"(vl[5]), "+v"(vh[5]), "+v"(vl[6]), "+v"(vh[6]), "+v"(vl[7]), "+v"(vh[7]) :: "memory"); __builtin_amdgcn_sched_barrier(0); \
            _Pragma("unroll") for (int blk = 0; blk < 4; ++blk) { \
                o[blk] = __builtin_amdgcn_mfma_f32_32x32x16_bf16(paA, (bf16x8){vl[2 * blk][0], vl[2 * blk][1], vl[2 * blk][2], vl[2 * blk][3], vh[2 * blk][0], vh[2 * blk][1], vh[2 * blk][2], vh[2 * blk][3]}, o[blk], 0, 0, 0); \
                o[blk] = __builtin_amdgcn_mfma_f32_32x32x16_bf16(paB, (bf16x8){vl[2 * blk + 1][0], vl[2 * blk + 1][1], vl[2 * blk + 1][2], vl[2 * blk + 1][3], vh[2 * blk + 1][0], vh[2 * blk + 1][1], vh[2 * blk + 1][2], vh[2 * blk + 1][3]}, o[blk], 0, 0, 0); } } while (0)
        GL_JT(0);
        if (it >= 1) GL_JT(1);
        if (it >= 2) GL_JT(2);
        if (it >= 3) GL_JT(3);
#undef GL_JT
#undef GL_KRD
#pragma unroll
        for (int kp = 0; kp < 4; ++kp) {
            bf16x8 un[8];
            if (kp < 3) {
#pragma unroll
                for (int ks = 0; ks < 2; ++ks)
#pragma unroll
                    for (int blk = 0; blk < 4; ++blk) un[ks * 4 + blk] = *(const bf16x8*)(sp + (size_t)(blk * 32) * 128 + (2 * kp + 2 + ks) * 16);
            }
#pragma unroll
            for (int ks = 0; ks < 2; ++ks)
#pragma unroll
                for (int blk = 0; blk < 4; ++blk) o[blk] = __builtin_amdgcn_mfma_f32_32x32x16_bf16(qr[2 * kp + ks], ub[ks * 4 + blk], o[blk], 0, 0, 0);
            if (kp < 3) {
#pragma unroll
                for (int e = 0; e < 8; ++e) ub[e] = un[e];
            }
        }
        int tl = tid; asm volatile("" : "+v"(tl));
        const int lnb = tl & 63, r32b = tl & 31, hib = (tl >> 5) & 1;
        u32x4 rg[8];
#pragma unroll
        for (int q8 = 0; q8 < 8; ++q8) { const int idx = tl + 512 * q8; rg[q8] = *(const u32x4*)(P + (row0 + (idx >> 5)) * PG + PG_R + h * 256 + (idx & 31) * 8); }
        float v16[16];
#pragma unroll
        for (int r = 0; r < 16; ++r) v16[r] = (o[0][r] * o[0][r] + o[1][r] * o[1][r]) + (o[2][r] * o[2][r] + o[3][r] * o[3][r]);
        float w8[8], w4[4], w2[2], w1;
        { const bool up = (lnb & 16) != 0;
#pragma unroll
          for (int q = 0; q < 8; ++q) { const float keep = up ? v16[8 + q] : v16[q], send = up ? v16[q] : v16[8 + q]; w8[q] = keep + __shfl_xor(send, 16); } }
        { const bool up = (lnb & 8) != 0;
#pragma unroll
          for (int q = 0; q < 4; ++q) { const float keep = up ? w8[4 + q] : w8[q], send = up ? w8[q] : w8[4 + q]; w4[q] = keep + __shfl_xor(send, 8); } }
        { const bool up = (lnb & 4) != 0;
#pragma unroll
          for (int q = 0; q < 2; ++q) { const float keep = up ? w4[2 + q] : w4[q], send = up ? w4[q] : w4[2 + q]; w2[q] = keep + __shfl_xor(send, 4); } }
        { const bool up = (lnb & 2) != 0; const float keep = up ? w2[1] : w2[0], send = up ? w2[0] : w2[1]; w1 = keep + __shfl_xor(send, 2); }
        w1 += __shfl_xor(w1, 1);
        if ((lnb & 1) == 0) part[(it * 32 + att::crow(r32b >> 1, hib)) * 2 + grp] = w1;
        __syncthreads();
        if (tl < 128) rstd_l[tl] = 1.0f / sqrtf((part[tl * 2] + part[tl * 2 + 1]) * (1.f / 256.f) + EPS);
        __syncthreads();
#pragma unroll
        for (int r = 0; r < 16; ++r) { const int i = 32 * it + att::crow(r, hib); const float rs = rstd_l[i];
            LAS float* tp = (LAS float*)(lds + i * TP) + grp * 128 + r32b;
#pragma unroll
            for (int blk = 0; blk < 4; ++blk) tp[blk * 32] = o[blk][r] * rs * g4[blk]; }
        __syncthreads();
#pragma unroll
        for (int q8 = 0; q8 < 8; ++q8) { const int idx = tl + 512 * q8, row = idx >> 5, ch = idx & 31;
            const f32x4 t0 = *(const LAS f32x4*)(lds + row * TP + ch * 32), t1 = *(const LAS f32x4*)(lds + row * TP + ch * 32 + 16); const u32x4 gv = rg[q8]; u32x4 w;
#define GL_O2(ta, tb, gw) cvt_pk_bf16((ta) * fast_silu(__uint_as_float((gw) << 16)), (tb) * fast_silu(__uint_as_float((gw) & 0xffff0000u)))
            w.x = GL_O2(t0[0], t0[1], gv.x); w.y = GL_O2(t0[2], t0[3], gv.y); w.z = GL_O2(t1[0], t1[1], gv.z); w.w = GL_O2(t1[2], t1[3], gv.w);
#undef GL_O2
            if (!dry) *(u32x4*)(P + (row0 + row) * PG + PG_V + h * 256 + ch * 8) = w; }
        __syncthreads();
    }
}
#undef GL_STAGE_V

constexpr int PID_END = 16 * 9;
#ifndef PROBE_PID
#define PROBE_PID (-1)
#endif
#ifndef PROBE_N
#define PROBE_N 1
#endif
#ifndef PROBE_PID2
#define PROBE_PID2 (-1)
#endif
#ifndef PROBE_PID3
#define PROBE_PID3 (-1)
#endif
#define NREP(k) ((((k) == PROBE_PID) || ((k) == PROBE_PID2) || ((k) == PROBE_PID3)) ? PROBE_N : 1)
#ifndef GU_ALIGN
#define GU_ALIGN true
#endif
#ifndef REV_GU
#define REV_GU 0
#endif
#ifndef REV_DOWN
#define REV_DOWN 1
#endif
#ifndef REV_OUT
#define REV_OUT 1
#endif
#ifndef REV_IN
#define REV_IN 0
#endif
#define REP(k) for (int rep_ = 0; rep_ < NREP(k); ++rep_)
#define DRY(k) (rep_ + 1 < NREP(k))
__global__ void __launch_bounds__(NWAVES * 64, 2) mk_fwd(MArgs args) {
    extern __shared__ __attribute__((aligned(16))) unsigned char lds_raw[];
    Frame F;
    F.lds = (LAS unsigned char*)lds_raw;
    F.G = gridDim.x; { const int bx = blockIdx.x; F.vcu = (F.G % 8 == 0) ? (bx % 8) * (F.G / 8) + bx / 8 : bx; }
    F.X = args.out; F.ws = args.ws; F.OC = (bf16*)args.out;
    volatile LAS unsigned* MISC = (volatile LAS unsigned*)(F.lds + MISC_OFF);
    for (int u = threadIdx.x; u < 128; u += NWAVES * 64) MISC[u] = 0u;
    __syncthreads();
    XcdBarrier bar = xcd_barrier_post((unsigned*)(F.ws + WS_CTL) + CW_BAR + args.region * XCD_BAR_WORDS, MISC + 8);
    const int lo = args.lo, hi = args.hi;
#define IN(k) (lo <= (k) && (k) < hi)
#ifdef TGRP
    unsigned long long tph_prev = __builtin_amdgcn_s_memrealtime(), tph_acc = 0; int tph_gla = 0;
#define TSLOT(k) ((k) < 16 ? 16 + (k) : ((k) & 15))
#define TSEL(k) (TGRP == 1 ? (tph_gla && TSLOT(k) >= 2 && TSLOT(k) <= 5) : TGRP == 2 ? (!tph_gla && (TSLOT(k) == 2 || TSLOT(k) == 4)) : TGRP == 3 ? (TSLOT(k) >= 16 || TSLOT(k) == 7) : TGRP == 4 ? (!tph_gla && TSLOT(k) == 5) : \
                 TGRP == 5 ? (TSLOT(k) == 1 || TSLOT(k) == 6 || (!tph_gla && TSLOT(k) == 3)) : TGRP == 6 ? (TSLOT(k) == 9 || TSLOT(k) == 10) : TGRP >= 32 ? (TSLOT(k) == TGRP - 32 && (TGLA < 0 || tph_gla == TGLA)) : false)
#ifndef TGLA
#define TGLA (-1)
#endif
#define SEAM(k) do { if ((k) + 1 < hi) xcd_barrier(bar); { const unsigned long long tn_ = __builtin_amdgcn_s_memrealtime(); if (TSEL(k)) tph_acc += tn_ - tph_prev; tph_prev = tn_; } } while (0)
#else
#define SEAM(k) do { if ((k) + 1 < hi) xcd_barrier(bar); } while (0)
#endif
    unsigned char* ws = F.ws; unsigned char* wb = ws + WS_WB;

    LAS unsigned char* rstab = F.lds + XTRA_OFF;
    float* RS = (float*)(ws + WS_RS); LAS float* rspart = (LAS float*)(F.lds + XTRA_OFF + 8192);
#define OPQ(k) ({ const float* p_ = args.in[k]; asm volatile("" : "+s"(p_)); p_; })
#define CONV(layer) do { const ConvPtrs cp{OPQ(3), OPQ(4), OPQ(5), OPQ(7), OPQ(8), OPQ(9), OPQ(11), OPQ(16), OPQ(20), OPQ(23), OPQ(24), OPQ(2), OPQ(6), OPQ(10)}; conv_layer(F, (layer), cp); } while (0)

    if (IN(0)) { REP(0) { ph_prologue(F, args.in[0], args.in[1], args.in[12], args.in[13]); CONV(0); } SEAM(0); }
    if (IN(1)) {
        pg8::Gemm g{(const bf16*)(ws + WS_MEMH), (const bf16*)(ws + WS_MEMW), 4096, 4096, DM, DM, DM}; pg8::DiagOrder S{F.G, (int)blockIdx.x, 4};
        pg8::EpiBf16<false> E{(bf16*)(ws + WS_MEMKV), 1024, 3};
        pg8::gemm_phase<pg8::EpiBf16<false>, pg8::DiagOrder, PG8_ALIGN, PG8_SP2>(F.lds + RING_OFF, g, S, E);
        SEAM(1);
    }
    if (IN(2)) { ph_memknorm(F, args.in[15]); SEAM(2); }

    for (int it = 0; it < 8; ++it) {
        const int pb = 16 * (it + 1), i = it >> 1, half = it & 1, j = i >> 1;
        if (pb + 16 <= lo || pb >= hi) continue;
        if (half) {
            const bool gla = !(i & 1);
#ifdef TGRP
            tph_gla = gla ? 1 : 0;
#endif
            if (IN(pb + 1)) REP(pb + 1) {
                if (gla) {
                    pg8::Gemm g{(const bf16*)(ws + WS_XN), (const bf16*)(wb + WB_IN), M, 3840, DM, DM, DM}; pg8::StaticOrder S; S.init(M, 3840, F.G, (int)blockIdx.x, REV_IN);
                    pg8::EpiGlaIn E{(bf16*)(ws + WS_PG), (float*)(ws + WS_ALOW)};
                    pg8::gemm_phase<pg8::EpiGlaIn, pg8::StaticOrder, PG8_ALIGN, PG8_SP2>(F.lds + RING_OFF, g, S, E, RS + (size_t)(3 * i + 1) * 4 * M, rstab);
                } else {
                    pg8::Gemm g{(const bf16*)(ws + WS_XN), (const bf16*)(wb + WB_IN), M, PM, DM, DM, DM}; pg8::StaticOrder S; S.init(M, PM, F.G, (int)blockIdx.x, REV_IN);
                    pg8::EpiBf16<true> E{(bf16*)(ws + WS_PM), PM, 0x7fffffff};
                    pg8::gemm_phase<pg8::EpiBf16<true>, pg8::StaticOrder, PG8_ALIGN, PG8_SP2>(F.lds + RING_OFF, g, S, E, RS + (size_t)(3 * i + 1) * 4 * M, rstab);
                }
                if (rep_ + 1 == NREP(pb + 1)) SEAM(pb + 1);
            }
            if (gla) {
                if (IN(pb + 2)) { REP(pb + 2) { ph_gla_prep(F, args.in[17] + (size_t)j * 16 * 512, args.in[18] + j * 512, DRY(pb + 2)); ph_memattn(F, i, true, args.in[14] + i * 128, args.in[15] + i * 128, DRY(pb + 2)); } SEAM(pb + 2); }
                if (IN(pb + 3)) { REP(pb + 3) ph_gla_u(F); SEAM(pb + 3); }
                if (IN(pb + 4)) { REP(pb + 4) ph_gla_scan(F, DRY(pb + 4)); SEAM(pb + 4); }
                if (IN(pb + 5)) { REP(pb + 5) ph_gla_out(F, args.in[19] + j * 256, DRY(pb + 5)); SEAM(pb + 5); }
            }
            if (IN(pb + 2) && !gla) { REP(pb + 2) { ph_mla_rowprep(F, args.in[21] + j * 384, args.in[22] + j * 256, args.in[28] + j * 64, DRY(pb + 2)); ph_memattn(F, i, false, args.in[14] + i * 128, args.in[15] + i * 128, DRY(pb + 2)); } SEAM(pb + 2); }
            if (IN(pb + 3) && !gla) REP(pb + 3) {
                int kq_ = 384, kkv_ = 256; asm volatile("" : "+s"(kq_), "+s"(kkv_));
                { pg8::Gemm g{(const bf16*)(ws + WS_PM) + PM_CQ, (const bf16*)(wb + WB_UQ), M, QW, kq_, PM, 384}; pg8::StaticOrder S; S.init(M, QW, F.G, (int)blockIdx.x);
                  pg8::EpiBf16<false> E{(bf16*)(ws + WS_Q), QW, 0x7fffffff};
                  pg8::gemm_phase<pg8::EpiBf16<false>, pg8::StaticOrder, PG8_ALIGN, PG8_SP2>(F.lds + RING_OFF, g, S, E); }
                { pg8::Gemm g{(const bf16*)(ws + WS_PM) + PM_CKV, (const bf16*)(wb + WB_UKV), M, KVW, kkv_, PM, 256}; pg8::StaticOrder S; S.init(M, KVW, F.G, (int)blockIdx.x);
#ifdef KV_FUSED
                  pg8::EpiKV E{(bf16*)(ws + WS_KV), KVW, args.in[27] + j * 128, rspart};
                  pg8::gemm_phase<pg8::EpiKV, pg8::StaticOrder, true, PG8_SP2>(F.lds + RING_OFF, g, S, E); }
#else
                  pg8::EpiBf16<false> E{(bf16*)(ws + WS_KV), KVW, 0x7fffffff};
                  pg8::gemm_phase<pg8::EpiBf16<false>, pg8::StaticOrder, PG8_ALIGN, PG8_SP2>(F.lds + RING_OFF, g, S, E); }
#endif
                if (rep_ + 1 == NREP(pb + 3)) SEAM(pb + 3);
            }
#ifndef KV_FUSED
            if (IN(pb + 4) && !gla) { REP(pb + 4) ph_mla_knorm(F, args.in[27] + j * 128, DRY(pb + 4)); SEAM(pb + 4); }
#endif
            if (IN(pb + 5) && !gla) { REP(pb + 5) ph_mla_attn(F, args.in[25] + j * 128, args.in[26] + j * 64, args.in[27] + j * 128, args.in[28] + j * 64, DRY(pb + 5)); SEAM(pb + 5); }
            if (IN(pb + 6)) {
                pg8::Gemm g{gla ? (const bf16*)(ws + WS_PG) + PG_V : (const bf16*)F.OC, (const bf16*)(wb + WB_WO), M, DM, 1536, gla ? PG : OCW, 1536};
                pg8::StaticOrder S; S.init(M, DM, F.G, (int)blockIdx.x, REV_OUT);
                REP(pb + 6) { pg8::EpiResid E{(bf16*)(ws + WS_XN), nullptr, RS + (size_t)(3 * i + 2) * 4 * M, rspart, DM, rep_ ? 0.0f : 1.0f};
                pg8::gemm_phase<pg8::EpiResid, pg8::StaticOrder, PG8_ALIGN, PG8_SP2>(F.lds + RING_OFF, g, S, E); }
                SEAM(pb + 6);
            }
        }
        if (IN(pb + 7) && !half && it > 0) { REP(pb + 7) CONV(i); SEAM(pb + 7); }
        if (IN(pb + 9)) {
            pg8::Gemm g{(const bf16*)(ws + WS_XN), (const bf16*)(wb + (half ? WB_GU1 : WB_GU0)), M, 2 * FF, DM, DM, DM}; pg8::StaticOrder S; S.init(M, 2 * FF, F.G, (int)blockIdx.x, REV_GU);
            pg8::EpiSwiGLU E{(bf16*)(ws + WS_H), FF};
#ifndef DN_SKIP
#define DN_SKIP 0
#endif
#ifdef GU_PK
#ifndef GU_SKIP
#define GU_SKIP 0
#endif
            REP(pb + 9) { pg8::Gemm g2 = g; if (DRY(pb + 9)) g2.K = GU_PK; pg8::gemm_phase<pg8::EpiSwiGLU, pg8::StaticOrder, GU_ALIGN, PG8_SP2>(F.lds + RING_OFF, g2, S, E, RS + (size_t)(3 * i + (half ? 2 : 0)) * 4 * M, rstab, GU_SKIP && DRY(pb + 9)); }
#else
            REP(pb + 9) pg8::gemm_phase<pg8::EpiSwiGLU, pg8::StaticOrder, GU_ALIGN, PG8_SP2>(F.lds + RING_OFF, g, S, E, RS + (size_t)(3 * i + (half ? 2 : 0)) * 4 * M, rstab);
#endif
            SEAM(pb + 9);
        }
        if (IN(pb + 10)) {
            pg8::Gemm g{(const bf16*)(ws + WS_H), (const bf16*)(wb + (half ? WB_D1 : WB_D0)), M, DM, FF, FF, FF}; pg8::StaticOrder S; S.init(M, DM, F.G, (int)blockIdx.x, REV_DOWN);
            const bool lastp = (it == 7);
            REP(pb + 10) { pg8::EpiResid E{(bf16*)(ws + WS_XN), lastp ? F.X : nullptr, RS + (size_t)(half ? 3 * (i + 1) : 3 * i + 1) * 4 * M, rspart, DM, rep_ ? 0.0f : 0.5f};
            pg8::gemm_phase<pg8::EpiResid, pg8::StaticOrder, PG8_ALIGN, PG8_SP2>(F.lds + RING_OFF, g, S, E, nullptr, nullptr, DN_SKIP && rep_ > 0); }
            SEAM(pb + 10);
        }
    }
#ifdef TGRP
    if (blockIdx.x == 0 && threadIdx.x == 0) { const unsigned long long s0 = __builtin_amdgcn_s_memrealtime(); while (__builtin_amdgcn_s_memrealtime() - s0 < 4ull * tph_acc) __builtin_amdgcn_s_sleep(8); }
#endif
#undef OPQ
#undef CONV
#undef IN
#undef SEAM
}
#ifndef FAST_GLA
#define FAST_GLA 0
#endif
#ifndef FAST_MLA_PREP
#define FAST_MLA_PREP 0
#endif
#ifndef FAST_MLA_ATT
#define FAST_MLA_ATT 0
#endif
extern "C" void kernel_launch(void* const* d_in, const int* in_sizes, int n_in, void* d_out, int out_size, void* d_ws, size_t ws_size, hipStream_t stream) {
    static int grid = 0;
    if (grid == 0) {
        if (n_in != 29 || out_size != M * DM || ws_size < WS_END) { fprintf(stderr, "kernel_launch: unexpected shapes (n_in %d out %d ws %zu)\n", n_in, out_size, ws_size); grid = -1; return; }
        int dev = 0, cus = 0, per_cu = 0;
        if (hipGetDevice(&dev) != hipSuccess || hipDeviceGetAttribute(&cus, hipDeviceAttributeMultiprocessorCount, dev) != hipSuccess) { grid = -1; return; }
        if (hipFuncSetAttribute((const void*)mk_fwd, hipFuncAttributeMaxDynamicSharedMemorySize, LDS_BYTES) != hipSuccess) { fprintf(stderr, "kernel_launch: hipFuncSetAttribute failed\n"); grid = -1; return; }
        if (hipOccupancyMaxActiveBlocksPerMultiprocessor(&per_cu, (const void*)mk_fwd, NWAVES * 64, LDS_BYTES) != hipSuccess || per_cu < 1)
            fprintf(stderr, "kernel_launch: note: occupancy query reports %d workgroups per CU\n", per_cu);
        (void)hipGetLastError();
        grid = cus;
    }
    if (grid < 0) return;
    const float* mem = (const float*)d_in[1]; (void)mem;
    const float* memq_norm = (const float*)d_in[14];
    const float* gla_w_alpha = (const float*)d_in[17]; const float* gla_b_alpha = (const float*)d_in[18]; const float* gla_out_norm = (const float*)d_in[19];
    const float* mla_q_norm = (const float*)d_in[21]; const float* mla_kv_norm = (const float*)d_in[22];
    const float* mla_qn = (const float*)d_in[25]; const float* mla_qr = (const float*)d_in[26]; const float* mla_kn = (const float*)d_in[27]; const float* mla_kr = (const float*)d_in[28];
    unsigned char* ws = (unsigned char*)d_ws;
    float* ROPE = (float*)(ws + WS_ROPE); bf16* MEMKV = (bf16*)(ws + WS_MEMKV); float* ALOW = (float*)(ws + WS_ALOW);
    bf16* KR = (bf16*)(ws + WS_KR); bf16* PGb = (bf16*)(ws + WS_PG); float* ALPHA = (float*)(ws + WS_US);
    bf16* OC = (bf16*)d_out; bf16* PMb = (bf16*)(ws + WS_PM); bf16* Qb = (bf16*)(ws + WS_Q); bf16* KVb = (bf16*)(ws + WS_KV);

    (void)hipMemsetAsync(ws + WS_CTL, 0, CTL_ZERO_BYTES, stream);
    MArgs a{};
    for (int k = 0; k < 29; ++k) a.in[k] = (const float*)d_in[k];
    a.out = (float*)d_out; a.ws = ws;
    int region = 0;
    auto mk = [&](int lo, int hi) { if (lo >= hi) return; a.lo = lo; a.hi = hi; a.region = region++; a.pad = 0; hipLaunchKernelGGL(mk_fwd, dim3(grid), dim3(NWAVES * 64), LDS_BYTES, stream, a); };
    int cur_lo = 0;
    for (int it = 1; it < 8; it += 2) {
        const int pb = 16 * (it + 1), i = it >> 1, j = i >> 1; const bool gla = !(i & 1);
        const bf16* memkv = MEMKV + (size_t)i * 1024 * 1024;
        if (gla) {
            if (!FAST_GLA) {
                mk(cur_lo, pb + 2);
                nv_gla_alpha<<<M * 512 / 256, 256, 0, stream>>>(ALOW, gla_w_alpha + (size_t)j * 16 * 512, gla_b_alpha + j * 512, ALPHA);
                nv_attn<128, false><<<dim3(SEQ / 64, 4, BATCH), 64, 0, stream>>>(PGb + PG_QM, PG, 128, memkv, 1024, 128, nullptr, 0, memkv + 512, 1024, 128, PGb + PG_QM, PG, 128, 4, SEQ, NMEM, 0.08838834764831845f, memq_norm + i * 128);
                nv_gla_rec<<<16, 256, 0, stream>>>(PGb, ALPHA, gla_out_norm + j * 256);
                cur_lo = pb + 6;
            }
        } else {
            if (!FAST_MLA_PREP) {
                mk(cur_lo, pb + 2);
                nv_attn<128, false><<<dim3(SEQ / 64, 4, BATCH), 64, 0, stream>>>(PMb + PM_QM, PM, 128, memkv, 1024, 128, nullptr, 0, memkv + 512, 1024, 128, OC + 1024, OCW, 128, 4, SEQ, NMEM, 0.08838834764831845f, memq_norm + i * 128);
                nv_mla_rowprep<<<M / 4, 256, 0, stream>>>(PMb, mla_q_norm + j * 384, mla_kv_norm + j * 256, mla_kr + j * 64, ROPE, KR);
                cur_lo = pb + 3;
            }
            if (!FAST_MLA_ATT) {
                mk(cur_lo, pb + 4);
                nv_mla_headprep<<<M * 8 / 4, 256, 0, stream>>>(Qb, KVb, mla_qn + j * 128, mla_qr + j * 64, mla_kn + j * 128, ROPE);
                nv_attn<192, true><<<dim3(SEQ / 64, 8, BATCH), 64, 0, stream>>>(Qb, QW, 192, KVb, KVW, 256, KR, 64, KVb + 128, KVW, 256, OC, OCW, 128, 8, SEQ, SEQ, 0.07216878364870322f, nullptr);
                cur_lo = pb + 6;
            }
        }
    }
    mk(cur_lo, PID_END);
}
```

```cpp
#define FAST_GLA 1
#define FAST_MLA_PREP 1
#define FAST_MLA_ATT 1
#define KV_FUSED 1
#include <hip/hip_runtime.h>
#include <cstdio>
#include <cstdint>

typedef unsigned short bf16;
typedef short bf16x8 __attribute__((ext_vector_type(8)));
typedef float f32x4 __attribute__((ext_vector_type(4)));

constexpr int BATCH = 4, SEQ = 8192, DM = 1024, DEPTH = 4, NMEM = 256, FF = 2816;
constexpr int M = BATCH * SEQ;
constexpr float EPS = 1e-6f;
constexpr int GLA_IN = 3600, MLA_IN = 1216;
constexpr int PG = 3584;
constexpr int PG_Q = 0, PG_K = 512, PG_R = 1024, PG_V = 2048, PG_QM = 3072;
constexpr int PM = 1280;
constexpr int PM_CQ = 0, PM_CKV = 384, PM_KR = 640, PM_QM = 704;
constexpr int QW = 1536, KVW = 2048, OCW = 1536;

constexpr size_t MiB = 1u << 20;
constexpr size_t WS_CTL = 0;
constexpr size_t WS_ROPE = 28 * MiB;
constexpr size_t WS_MEMKV = 3 * MiB;
constexpr size_t WS_MEMH = 11 * MiB;
constexpr size_t WS_ALOW = 19 * MiB;
constexpr size_t WS_GV = 21 * MiB;
constexpr size_t WS_KR = 24 * MiB;
constexpr size_t WS_WB = 32 * MiB;
constexpr size_t WS_XN = 84 * MiB;
constexpr size_t WS_BIG = 148 * MiB;
constexpr size_t WS_H = WS_BIG;
constexpr size_t WS_PG = WS_BIG;
constexpr size_t WS_US = 372 * MiB;
constexpr size_t WS_PM = 180 * MiB;
constexpr size_t WS_Q = 260 * MiB;
constexpr size_t WS_KV = 356 * MiB;
constexpr size_t WS_END = 500 * MiB;

__device__ __forceinline__ float bf2f(bf16 b) { return __uint_as_float(((unsigned)b) << 16); }
__device__ __forceinline__ bf16 f2bf(float f) { unsigned u = __float_as_uint(f); return (bf16)((u + 0x7fffu + ((u >> 16) & 1u)) >> 16); }
__device__ __forceinline__ float wave_sum(float v) {
#pragma unroll
    for (int o = 1; o < 64; o <<= 1) v += __shfl_xor(v, o);
    return v;
}
__device__ __forceinline__ float silu_f(float x) { return x / (1.f + __expf(-x)); }

struct ColMap { int t0, a0, t1, a1, t2, a2, a3, nvalid; };
__device__ __forceinline__ int cm_src(const ColMap& c, int n) { return n + (n < c.t0 ? c.a0 : n < c.t1 ? c.a1 : n < c.t2 ? c.a2 : c.a3); }
static ColMap cm_identity(int nvalid) { ColMap c; c.t0 = 1 << 30; c.a0 = 0; c.t1 = 1 << 30; c.a1 = 0; c.t2 = 1 << 30; c.a2 = 0; c.a3 = 0; c.nvalid = nvalid; return c; }

template <int EPI>
__global__ __launch_bounds__(256) void nv_gemm(const bf16* __restrict__ A, int lda, const float* __restrict__ W, const float* __restrict__ W2, int ldw, ColMap cm,
                                               int K, void* Cv, int ldc, float scale, int nstore) {
    __shared__ __attribute__((aligned(16))) bf16 sA[64][40];
    __shared__ __attribute__((aligned(16))) bf16 sB[64][40];
    __shared__ __attribute__((aligned(16))) bf16 sB2[64][40];
    const int tid = threadIdx.x, lane = tid & 63, wid = tid >> 6;
    const int m0 = blockIdx.y * 64, n0 = blockIdx.x * 64;
    const int wm = (wid >> 1) * 32, wn = (wid & 1) * 32;
    f32x4 acc[2][2], acc2[2][2];
#pragma unroll
    for (int i = 0; i < 2; ++i)
#pragma unroll
        for (int j = 0; j < 2; ++j) { acc[i][j] = (f32x4){0.f, 0.f, 0.f, 0.f}; acc2[i][j] = (f32x4){0.f, 0.f, 0.f, 0.f}; }
    const int ar = tid >> 2, ac = (tid & 3) * 8;
    const int bk = tid >> 3, bn = (tid & 7) * 8;
    const int ncol = n0 + bn; const bool nval = ncol < cm.nvalid; const int src = cm_src(cm, ncol);
    for (int k0 = 0; k0 < K; k0 += 32) {
        const bf16x8 av = *(const bf16x8*)(A + (size_t)(m0 + ar) * lda + k0 + ac);
        f32x4 w0 = (f32x4){0.f, 0.f, 0.f, 0.f}, w1 = w0, u0 = w0, u1 = w0;
        if (nval) { const float* wp = W + (size_t)(k0 + bk) * ldw + src; w0 = *(const f32x4*)wp; w1 = *(const f32x4*)(wp + 4);
            if (EPI == 1) { const float* up = W2 + (size_t)(k0 + bk) * ldw + src; u0 = *(const f32x4*)up; u1 = *(const f32x4*)(up + 4); } }
        *(bf16x8*)&sA[ar][ac] = av;
#pragma unroll
        for (int j = 0; j < 4; ++j) { sB[bn + j][bk] = f2bf(w0[j]); sB[bn + 4 + j][bk] = f2bf(w1[j]); }
        if (EPI == 1) {
#pragma unroll
            for (int j = 0; j < 4; ++j) { sB2[bn + j][bk] = f2bf(u0[j]); sB2[bn + 4 + j][bk] = f2bf(u1[j]); } }
        __syncthreads();
        bf16x8 a[2], b[2], b2[2];
#pragma unroll
        for (int i = 0; i < 2; ++i) { a[i] = *(const bf16x8*)&sA[wm + i * 16 + (lane & 15)][(lane >> 4) * 8]; b[i] = *(const bf16x8*)&sB[wn + i * 16 + (lane & 15)][(lane >> 4) * 8];
            if (EPI == 1) b2[i] = *(const bf16x8*)&sB2[wn + i * 16 + (lane & 15)][(lane >> 4) * 8]; }
#pragma unroll
        for (int i = 0; i < 2; ++i)
#pragma unroll
            for (int j = 0; j < 2; ++j) { acc[i][j] = __builtin_amdgcn_mfma_f32_16x16x32_bf16(a[i], b[j], acc[i][j], 0, 0, 0);
                if (EPI == 1) acc2[i][j] = __builtin_amdgcn_mfma_f32_16x16x32_bf16(a[i], b2[j], acc2[i][j], 0, 0, 0); }
        __syncthreads();
    }
#pragma unroll
    for (int i = 0; i < 2; ++i)
#pragma unroll
        for (int j = 0; j < 2; ++j)
#pragma unroll
            for (int r = 0; r < 4; ++r) {
                const int row = m0 + wm + i * 16 + (lane >> 4) * 4 + r, col = n0 + wn + j * 16 + (lane & 15);
                const float v = acc[i][j][r];
                if (EPI == 0) ((bf16*)Cv)[(size_t)row * ldc + col] = f2bf(v);
                if (EPI == 1) ((bf16*)Cv)[(size_t)row * ldc + col] = f2bf(silu_f(v) * acc2[i][j][r]);
                if (EPI == 2) { float* p = (float*)Cv + (size_t)row * ldc + col; *p = *p + scale * v; }
                if (EPI == 3) { if (col < nstore) ((float*)Cv)[(size_t)row * ldc + col] = v; }
            }
}

__global__ __launch_bounds__(256) void nv_rmsnorm(const float* __restrict__ X, const float* __restrict__ g, bf16* __restrict__ out, int rows) {
    const int lane = threadIdx.x & 63, row = blockIdx.x * 4 + (threadIdx.x >> 6);
    if (row >= rows) return;
    const f32x4* xr = (const f32x4*)(X + (size_t)row * DM) + lane; f32x4 v[4]; float s = 0.f;
#pragma unroll
    for (int j = 0; j < 4; ++j) { v[j] = xr[64 * j]; s += v[j].x * v[j].x + v[j].y * v[j].y + v[j].z * v[j].z + v[j].w * v[j].w; }
    const float rstd = 1.0f / sqrtf(wave_sum(s) * (1.f / DM) + EPS);
#pragma unroll
    for (int j = 0; j < 4; ++j) { const f32x4 gg = ((const f32x4*)g)[lane + 64 * j]; bf16* o = out + (size_t)row * DM + (lane + 64 * j) * 4;
        o[0] = f2bf(v[j].x * rstd * gg.x); o[1] = f2bf(v[j].y * rstd * gg.y); o[2] = f2bf(v[j].z * rstd * gg.z); o[3] = f2bf(v[j].w * rstd * gg.w); }
}

__global__ void nv_rope_table(float* cs) {
    const int i = blockIdx.x * blockDim.x + threadIdx.x; if (i >= SEQ * 32) return;
    const int pos = i >> 5, f = i & 31;
    const float ex = (float)(2 * f) / 64.0f;
    const float inv = (float)(1.0 / pow(10000.0, (double)ex));
    const float ang = (float)pos * inv;
    cs[i] = (float)cos((double)ang); cs[SEQ * 32 + i] = (float)sin((double)ang);
}

__global__ __launch_bounds__(256) void nv_headnorm128(bf16* __restrict__ buf, int ld, int col0, int hstride, int nheads, const float* __restrict__ g, int rows) {
    const int lane = threadIdx.x & 63, idx = blockIdx.x * 4 + (threadIdx.x >> 6);
    if (idx >= rows * nheads) return;
    const int row = idx / nheads, h = idx % nheads;
    bf16* p = buf + (size_t)row * ld + col0 + h * hstride + lane * 2;
    const float a = bf2f(p[0]), b = bf2f(p[1]);
    const float rstd = 1.0f / sqrtf(wave_sum(a * a + b * b) * (1.f / 128.f) + EPS);
    p[0] = f2bf(a * rstd * g[lane * 2]); p[1] = f2bf(b * rstd * g[lane * 2 + 1]);
}

__global__ __launch_bounds__(256) void nv_mla_rowprep(bf16* __restrict__ P, const float* __restrict__ gq, const float* __restrict__ gkv, const float* __restrict__ gkr,
                                                      const float* __restrict__ rope, bf16* __restrict__ KR) {
    const int lane = threadIdx.x & 63, row = blockIdx.x * 4 + (threadIdx.x >> 6);
    bf16* p = P + (size_t)row * PM;
    float q[6]; float s = 0.f;
#pragma unroll
    for (int j = 0; j < 6; ++j) { q[j] = bf2f(p[PM_CQ + lane + 64 * j]); s += q[j] * q[j]; }
    float rstd = 1.0f / sqrtf(wave_sum(s) * (1.f / 384.f) + EPS);
#pragma unroll
    for (int j = 0; j < 6; ++j) p[PM_CQ + lane + 64 * j] = f2bf(q[j] * rstd * gq[lane + 64 * j]);
    float c[4]; s = 0.f;
#pragma unroll
    for (int j = 0; j < 4; ++j) { c[j] = bf2f(p[PM_CKV + lane + 64 * j]); s += c[j] * c[j]; }
    rstd = 1.0f / sqrtf(wave_sum(s) * (1.f / 256.f) + EPS);
#pragma unroll
    for (int j = 0; j < 4; ++j) p[PM_CKV + lane + 64 * j] = f2bf(c[j] * rstd * gkv[lane + 64 * j]);
    float k = bf2f(p[PM_KR + lane]);
    rstd = 1.0f / sqrtf(wave_sum(k * k) * (1.f / 64.f) + EPS);
    k = k * rstd * gkr[lane];
    const float other = __shfl_xor(k, 32);
    const int pos = row % SEQ, f = lane & 31;
    const float cs = rope[pos * 32 + f], sn = rope[SEQ * 32 + pos * 32 + f];
    const float o = lane < 32 ? (k * cs - other * sn) : (other * sn + k * cs);
    KR[(size_t)row * 64 + lane] = f2bf(o);
}

__global__ __launch_bounds__(256) void nv_mla_headprep(bf16* __restrict__ Q, bf16* __restrict__ KV, const float* __restrict__ gqn, const float* __restrict__ gqr, const float* __restrict__ gkn,
                                                       const float* __restrict__ rope) {
    const int lane = threadIdx.x & 63, idx = blockIdx.x * 4 + (threadIdx.x >> 6);
    const int row = idx >> 3, h = idx & 7;
    bf16* q = Q + (size_t)row * QW + h * 192;
    { const float a = bf2f(q[lane * 2]), b = bf2f(q[lane * 2 + 1]);
      const float rstd = 1.0f / sqrtf(wave_sum(a * a + b * b) * (1.f / 128.f) + EPS);
      q[lane * 2] = f2bf(a * rstd * gqn[lane * 2]); q[lane * 2 + 1] = f2bf(b * rstd * gqn[lane * 2 + 1]); }
    { float k = bf2f(q[128 + lane]);
      const float rstd = 1.0f / sqrtf(wave_sum(k * k) * (1.f / 64.f) + EPS);
      k = k * rstd * gqr[lane];
      const float other = __shfl_xor(k, 32);
      const int pos = row % SEQ, f = lane & 31;
      const float cs = rope[pos * 32 + f], sn = rope[SEQ * 32 + pos * 32 + f];
      q[128 + lane] = f2bf(lane < 32 ? (k * cs - other * sn) : (other * sn + k * cs)); }
    bf16* kk = KV + (size_t)row * KVW + h * 256;
    { const float a = bf2f(kk[lane * 2]), b = bf2f(kk[lane * 2 + 1]);
      const float rstd = 1.0f / sqrtf(wave_sum(a * a + b * b) * (1.f / 128.f) + EPS);
      kk[lane * 2] = f2bf(a * rstd * gkn[lane * 2]); kk[lane * 2 + 1] = f2bf(b * rstd * gkn[lane * 2 + 1]); }
}

template <int DQK, bool CAUSAL>
__global__ __launch_bounds__(64) void nv_attn(const bf16* __restrict__ Q, int ldq, int qhs, const bf16* __restrict__ Kn, int ldkn, int knhs, const bf16* __restrict__ Kr, int ldkr,
                                              const bf16* __restrict__ V, int ldv, int vhs, bf16* __restrict__ O, int ldo, int ohs, int nheads, int sq, int skv, float scale, const float* __restrict__ qgain) {
    __shared__ float sQ[64][DQK + 1];
    const int lane = threadIdx.x;
    const int qb = blockIdx.x, h = blockIdx.y, b = blockIdx.z;
    const int q0 = qb * 64;
    const size_t qrow = (size_t)b * sq + q0 + lane;
    { const bf16* qp = Q + qrow * ldq + h * qhs; float s = 0.f;
      for (int d = 0; d < DQK; ++d) { const float v = bf2f(qp[d]); sQ[lane][d] = v; s += v * v; }
      if (qgain) { const float rstd = 1.0f / sqrtf(s * (1.f / DQK) + EPS); for (int d = 0; d < DQK; ++d) sQ[lane][d] = sQ[lane][d] * rstd * qgain[d]; } }
    float acc[128];
#pragma unroll
    for (int d = 0; d < 128; ++d) acc[d] = 0.f;
    float mx = -1e30f, l = 0.f;
    const int jend = CAUSAL ? (q0 + 64) : skv;
    for (int j = 0; j < jend; ++j) {
        const size_t krow = (size_t)b * skv + j;
        const bf16* kn = Kn + krow * ldkn + h * knhs;
        float s = 0.f;
#pragma unroll 8
        for (int d = 0; d < 128; ++d) s += sQ[lane][d] * bf2f(kn[d]);
        if (DQK > 128) { const bf16* kr = Kr + krow * ldkr;
#pragma unroll 8
            for (int d = 0; d < DQK - 128; ++d) s += sQ[lane][128 + d] * bf2f(kr[d]); }
        s *= scale;
        const bool ok = !CAUSAL || (j <= q0 + lane);
        if (ok) {
            const float mn = fmaxf(mx, s), al = __expf(mx - mn), p = __expf(s - mn);
            l = l * al + p; mx = mn;
            const bf16* vp = V + krow * ldv + h * vhs;
#pragma unroll
            for (int d = 0; d < 128; ++d) acc[d] = acc[d] * al + p * bf2f(vp[d]);
        }
    }
    const float inv = 1.0f / l;
    bf16* op = O + qrow * ldo + h * ohs;
#pragma unroll
    for (int d = 0; d < 128; ++d) op[d] = f2bf(acc[d] * inv);
}

__global__ __launch_bounds__(256) void nv_gla_alpha(const float* __restrict__ alow, const float* __restrict__ wa, const float* __restrict__ ba, float* __restrict__ alpha) {
    const size_t i = (size_t)blockIdx.x * 256 + threadIdx.x; const int m = (int)(i >> 9), c = (int)(i & 511);
    float z = ba[c];
#pragma unroll
    for (int r = 0; r < 16; ++r) z += alow[(size_t)m * 16 + r] * wa[r * 512 + c];
    const float ls = fminf(z, 0.f) - log1pf(expf(-fabsf(z)));
    alpha[i] = expf(ls * (1.f / 16.f));
}
__global__ __launch_bounds__(256) void nv_gla_rec(bf16* __restrict__ P, const float* __restrict__ alpha, const float* __restrict__ gout) {
    __shared__ float red[2][4];
    const int dv = threadIdx.x, h = blockIdx.x & 3, b = blockIdx.x >> 2, lane = dv & 63, wv = dv >> 6;
    float S[128];
#pragma unroll
    for (int d = 0; d < 128; ++d) S[d] = 0.f;
    const float g = gout[dv];
    const float scale = 0.08838834764831845f;
    for (int t = 0; t < SEQ; ++t) {
        const size_t row = (size_t)b * SEQ + t;
        bf16* p = P + row * PG;
        const bf16* q = p + PG_Q + h * 128; const bf16* k = p + PG_K + h * 128; const float* al = alpha + row * 512 + h * 128;
        const float v = bf2f(p[PG_V + h * 256 + dv]);
        float o = 0.f;
#pragma unroll
        for (int d = 0; d < 128; ++d) { S[d] = al[d] * S[d] + bf2f(k[d]) * v; o += bf2f(q[d]) * S[d]; }
        o *= scale;
        float ss = wave_sum(o * o);
        if (lane == 0) red[t & 1][wv] = ss;
        __syncthreads();
        ss = red[t & 1][0] + red[t & 1][1] + red[t & 1][2] + red[t & 1][3];
        const float rstd = 1.0f / sqrtf(ss * (1.f / 256.f) + EPS);
        const float r = bf2f(p[PG_R + h * 256 + dv]);
        p[PG_V + h * 256 + dv] = f2bf(o * rstd * g * silu_f(r));
    }
}

#define LAS __attribute__((address_space(3)))
#define GAS __attribute__((address_space(1)))
typedef unsigned u32x4 __attribute__((ext_vector_type(4)));
typedef unsigned u32x2 __attribute__((ext_vector_type(2)));
typedef float f32x2 __attribute__((ext_vector_type(2)));
typedef GAS unsigned gu32;
#define RLX_AGENT __ATOMIC_RELAXED, __HIP_MEMORY_SCOPE_AGENT
#define LDS_WAIT() asm volatile("s_waitcnt lgkmcnt(0)" ::: "memory")
#define VM_WAIT() asm volatile("s_waitcnt vmcnt(0)" ::: "memory")
__device__ __forceinline__ unsigned cvt_pk_bf16(float lo, float hi) { unsigned r; asm volatile("v_cvt_pk_bf16_f32 %0, %1, %2" : "=v"(r) : "v"(lo), "v"(hi)); return r; }
__device__ __forceinline__ float fast_silu(float x) { return x * __builtin_amdgcn_rcpf(1.0f + __builtin_amdgcn_exp2f(-1.4426950408889634f * x)); }

namespace pg8 {
constexpr int BM = 256, BK = 64, HALF = 128, HTB = HALF * BK * 2  , STAGE_BYTES = 8 * HTB, NXCD = 8, WGM = 8;
__host__ __device__ __forceinline__ int lds_byte(int r, int c) { const int st = (r >> 4) * 2 + (c >> 5), rr = r & 15, cc = c & 31, ob = rr * 64 + cc * 2; return st * 1024 + (ob ^ (((ob >> 9) & 1) << 5)); }
__host__ __device__ __forceinline__ void stage_rc(int b, int& R, int& C) { const int st = b / 1024, sb = b % 1024, swz = sb ^ (((sb >> 9) & 1) << 5); R = (st >> 1) * 16 + swz / 64; C = (st & 1) * 32 + (swz % 64) / 2; }
__host__ __device__ __forceinline__ int perm32(int rho) { const int n = rho >> 4, i = rho & 15; return 8 * (i >> 2) + 4 * n + (i & 3); }

struct Unit { int pm, pn; };
struct Gemm { const bf16* A; const bf16* Bt; int M, N, K, lda, ldb; };

struct StaticOrder {
    int nM, nN, nwg, G, c, rev;
    __device__ void init(int M_, int N_, int G_, int c_, int rev_ = 0) { nM = M_ / BM; nN = N_ / BM; nwg = nM * nN; G = G_; c = c_; rev = rev_; }
    __device__ bool next(int i, Unit& u) const {
        const int R = (nwg - c + G - 1) / G;
        if (i >= R) return false;
        const long L = (long)(rev ? R - 1 - i : i) * G + c;
        int wgid = (int)L; { const int q = nwg / NXCD, r = nwg % NXCD, xcd = wgid % NXCD, off = wgid / NXCD; wgid = (xcd < r ? xcd * (q + 1) : r * (q + 1) + (xcd - r) * q) + off; }
        const int nig = WGM * nN, gid = wgid / nig, fm = gid * WGM, gsz = (nM - fm) < WGM ? (nM - fm) : WGM;
        u.pm = fm + ((wgid % nig) % gsz); u.pn = (wgid % nig) / gsz; return true;
    }
};
struct DiagOrder {
    int G, c, nb;
    __device__ bool next(int i, Unit& u) const { const int L = i * G + c; if (L >= nb * 16) return false; const int blk = L >> 4, r = L & 15; u.pm = blk * 4 + (r >> 2); u.pn = blk * 4 + (r & 3); return true; }
};

__device__ __forceinline__ float rstd_of(float ss) { return __builtin_amdgcn_rsqf(ss * (1.f / 1024.f) + EPS); }
#ifndef RS_DIRECT
#define RS_DIRECT 0
#endif
#if RS_DIRECT
#define TABV(idx) ({ const f32x4 t_ = *(const f32x4*)(rsg + (idx) * 4); (t_.x + t_.y) + (t_.z + t_.w); })
#else
#define TABV(idx) ({ const f32x4 t_ = *(const LAS f32x4*)(tab + (idx) * 4); (t_.x + t_.y) + (t_.z + t_.w); })
#endif
template <bool RS> struct EpiBf16 {
    static constexpr bool PERM = true, USE_RS = RS;
    bf16* O; int ldc; int pn_mask;
    __device__ __forceinline__ void operator()(const f32x4 (&acc)[2][2][4][2], const Unit& u, int wr, int wc, int fr, int fq, const LAS float* tab, const float* rsg) const {
        asm volatile("" : "+v"(fr), "+v"(fq));
        const int row0 = u.pm * BM + wr * 64 + fr, col0 = (u.pn & pn_mask) * BM + wc * 32 + 8 * fq;
#pragma unroll
        for (int ai = 0; ai < 2; ++ai)
#pragma unroll
            for (int m = 0; m < 4; ++m) { bf16* rowp = O + (size_t)(row0 + ai * HALF + m * 16) * ldc + col0;
                const float rs = RS ? rstd_of(TABV(ai * HALF + wr * 64 + m * 16 + fr)) : 1.f;
#pragma unroll
                for (int bj = 0; bj < 2; ++bj) { const f32x4 v0 = acc[ai][bj][m][0] * rs, v1 = acc[ai][bj][m][1] * rs;
                    u32x4 w; w.x = cvt_pk_bf16(v0[0], v0[1]); w.y = cvt_pk_bf16(v0[2], v0[3]); w.z = cvt_pk_bf16(v1[0], v1[1]); w.w = cvt_pk_bf16(v1[2], v1[3]);
                    *(u32x4*)(rowp + bj * HALF) = w; } }
    }
};
struct EpiGlaIn {
    static constexpr bool PERM = true, USE_RS = true;
    bf16* O; float* alow;
    __device__ __forceinline__ void operator()(const f32x4 (&acc)[2][2][4][2], const Unit& u, int wr, int wc, int fr, int fq, const LAS float* tab, const float* rsg) const {
        const int row0 = u.pm * BM + wr * 64 + fr;
        if (u.pn == 14) {
            if (wc == 0 && fq < 2) {
#pragma unroll
                for (int ai = 0; ai < 2; ++ai)
#pragma unroll
                    for (int m = 0; m < 4; ++m) { const float rs = rstd_of(TABV(ai * HALF + wr * 64 + m * 16 + fr)); float* ap = alow + (size_t)(row0 + ai * HALF + m * 16) * 16 + 8 * fq;
                        *(f32x4*)ap = acc[ai][0][m][0] * rs; *(f32x4*)(ap + 4) = acc[ai][0][m][1] * rs; } }
            return;
        }
        const int col0 = u.pn * BM + wc * 32 + 8 * fq;
#pragma unroll
        for (int ai = 0; ai < 2; ++ai)
#pragma unroll
            for (int m = 0; m < 4; ++m) { bf16* rowp = O + (size_t)(row0 + ai * HALF + m * 16) * PG + col0;
                const float rs = rstd_of(TABV(ai * HALF + wr * 64 + m * 16 + fr));
#pragma unroll
                for (int bj = 0; bj < 2; ++bj) { const f32x4 v0 = acc[ai][bj][m][0] * rs, v1 = acc[ai][bj][m][1] * rs;
                    u32x4 w; w.x = cvt_pk_bf16(v0[0], v0[1]); w.y = cvt_pk_bf16(v0[2], v0[3]); w.z = cvt_pk_bf16(v1[0], v1[1]); w.w = cvt_pk_bf16(v1[2], v1[3]);
                    *(u32x4*)(rowp + bj * HALF) = w; } }
    }
};
struct EpiSwiGLU {
    static constexpr bool PERM = true, USE_RS = true;
    bf16* O; int ldc;
    __device__ __forceinline__ void operator()(const f32x4 (&acc)[2][2][4][2], const Unit& u, int wr, int wc, int fr, int fq, const LAS float* tab, const float* rsg) const {
        const int row0 = u.pm * BM + wr * 64 + fr, col0 = u.pn * HALF + wc * 32 + 8 * fq;
        float ss[2][4];
#pragma unroll
        for (int ai = 0; ai < 2; ++ai)
#pragma unroll
            for (int m = 0; m < 4; ++m) ss[ai][m] = TABV(ai * HALF + wr * 64 + m * 16 + fr);
#pragma unroll
        for (int ai = 0; ai < 2; ++ai)
#pragma unroll
            for (int m = 0; m < 4; ++m) { bf16* rowp = O + (size_t)(row0 + ai * HALF + m * 16) * ldc + col0;
                const float v = ss[ai][m] * (1.f / 1024.f) + EPS, c = -1.4426950408889634f * __builtin_amdgcn_rsqf(v);
                float h[8], e[8];
#pragma unroll
                for (int k = 0; k < 8; ++k) e[k] = acc[ai][0][m][k >> 2][k & 3] * c;
#pragma unroll
                for (int k = 0; k < 8; ++k) h[k] = acc[ai][0][m][k >> 2][k & 3] * acc[ai][1][m][k >> 2][k & 3];
                __builtin_amdgcn_sched_barrier(0);
#pragma unroll
                for (int k = 0; k < 8; ++k) e[k] = __builtin_amdgcn_exp2f(e[k]);
                __builtin_amdgcn_sched_barrier(0);
#pragma unroll
                for (int k = 0; k < 8; ++k) e[k] = __builtin_fmaf(e[k], v, v);
                __builtin_amdgcn_sched_barrier(0);
#pragma unroll
                for (int k = 0; k < 8; ++k) e[k] = __builtin_amdgcn_rcpf(e[k]);
                __builtin_amdgcn_sched_barrier(0);
#pragma unroll
                for (int k = 0; k < 8; ++k) h[k] *= e[k];
                u32x4 w; w.x = cvt_pk_bf16(h[0], h[1]); w.y = cvt_pk_bf16(h[2], h[3]); w.z = cvt_pk_bf16(h[4], h[5]); w.w = cvt_pk_bf16(h[6], h[7]);
                *(u32x4*)rowp = w; }
    }
};
struct EpiKV {
    static constexpr bool PERM = true, USE_RS = false;
    bf16* O; int ldc; const float* gkn; LAS float* part;
    __device__ __forceinline__ void operator()(const f32x4 (&acc)[2][2][4][2], const Unit& u, int wr, int wc, int fr, int fq, const LAS float*, const float*) const {
        asm volatile("" : "+v"(fr), "+v"(fq));
        const int row0 = u.pm * BM + wr * 64 + fr, col0 = u.pn * BM + wc * 32 + 8 * fq;
#pragma unroll
        for (int ai = 0; ai < 2; ++ai)
#pragma unroll
            for (int m = 0; m < 4; ++m) { const f32x4 a = acc[ai][0][m][0], b = acc[ai][0][m][1];
                float ss = ((a[0] * a[0] + a[1] * a[1]) + (a[2] * a[2] + a[3] * a[3])) + ((b[0] * b[0] + b[1] * b[1]) + (b[2] * b[2] + b[3] * b[3]));
                ss += __shfl_xor(ss, 16); ss += __shfl_xor(ss, 32);
                if (fq == 0) part[(ai * HALF + wr * 64 + m * 16 + fr) * 4 + wc] = ss; }
        asm volatile("s_waitcnt lgkmcnt(0)" ::: "memory"); __builtin_amdgcn_s_barrier(); asm volatile("" ::: "memory");
        const f32x4 g0 = *(const f32x4*)(gkn + wc * 32 + 8 * fq), g1 = *(const f32x4*)(gkn + wc * 32 + 8 * fq + 4);
#pragma unroll
        for (int ai = 0; ai < 2; ++ai)
#pragma unroll
            for (int m = 0; m < 4; ++m) { bf16* rowp = O + (size_t)(row0 + ai * HALF + m * 16) * ldc + col0;
                const f32x4 pp = *(const LAS f32x4*)(part + (ai * HALF + wr * 64 + m * 16 + fr) * 4);
                const float rs = __builtin_amdgcn_rsqf(((pp.x + pp.y) + (pp.z + pp.w)) * (1.f / 128.f) + EPS);
                { const f32x4 v0 = acc[ai][0][m][0] * rs * g0, v1 = acc[ai][0][m][1] * rs * g1;
                  u32x4 w; w.x = cvt_pk_bf16(v0[0], v0[1]); w.y = cvt_pk_bf16(v0[2], v0[3]); w.z = cvt_pk_bf16(v1[0], v1[1]); w.w = cvt_pk_bf16(v1[2], v1[3]); *(u32x4*)rowp = w; }
                { const f32x4 v0 = acc[ai][1][m][0], v1 = acc[ai][1][m][1];
                  u32x4 w; w.x = cvt_pk_bf16(v0[0], v0[1]); w.y = cvt_pk_bf16(v0[2], v0[3]); w.z = cvt_pk_bf16(v1[0], v1[1]); w.w = cvt_pk_bf16(v1[2], v1[3]); *(u32x4*)(rowp + HALF) = w; } }
    }
};
struct EpiResid {
    static constexpr bool PERM = true, USE_RS = false;
    bf16* XB; float* OUT; float* RS4; LAS float* part; int ldc; float scale;
    __device__ __forceinline__ void operator()(const f32x4 (&acc)[2][2][4][2], const Unit& u, int wr, int wc, int fr, int fq, const LAS float*, const float*) const {
        const int row0 = u.pm * BM + wr * 64 + fr, col0 = u.pn * BM + wc * 32 + 8 * fq;
#pragma unroll
        for (int ai = 0; ai < 2; ++ai) {
            const size_t off = (size_t)(row0 + ai * HALF) * ldc + col0;
            u32x4 xv[4][2];
#pragma unroll
            for (int m = 0; m < 4; ++m)
#pragma unroll
                for (int bj = 0; bj < 2; ++bj) xv[m][bj] = *(const u32x4*)(XB + off + (size_t)(m * 16) * ldc + bj * HALF);
#pragma unroll
            for (int m = 0; m < 4; ++m) { float ss = 0.f;
#pragma unroll
                for (int bj = 0; bj < 2; ++bj) { const u32x4 w = xv[m][bj]; const size_t o2 = off + (size_t)(m * 16) * ldc + bj * HALF;
                    f32x4 n0, n1;
                    n0[0] = __uint_as_float(w.x << 16) + acc[ai][bj][m][0][0] * scale; n0[1] = __uint_as_float(w.x & 0xffff0000u) + acc[ai][bj][m][0][1] * scale;
                    n0[2] = __uint_as_float(w.y << 16) + acc[ai][bj][m][0][2] * scale; n0[3] = __uint_as_float(w.y & 0xffff0000u) + acc[ai][bj][m][0][3] * scale;
                    n1[0] = __uint_as_float(w.z << 16) + acc[ai][bj][m][1][0] * scale; n1[1] = __uint_as_float(w.z & 0xffff0000u) + acc[ai][bj][m][1][1] * scale;
                    n1[2] = __uint_as_float(w.w << 16) + acc[ai][bj][m][1][2] * scale; n1[3] = __uint_as_float(w.w & 0xffff0000u) + acc[ai][bj][m][1][3] * scale;
                    if (OUT) { *(f32x4*)(OUT + o2) = n0; *(f32x4*)(OUT + o2 + 4) = n1; }
                    else { u32x4 o; o.x = cvt_pk_bf16(n0[0], n0[1]); o.y = cvt_pk_bf16(n0[2], n0[3]); o.z = cvt_pk_bf16(n1[0], n1[1]); o.w = cvt_pk_bf16(n1[2], n1[3]); *(u32x4*)(XB + o2) = o;
                        ss += ((n0[0] * n0[0] + n0[1] * n0[1]) + (n0[2] * n0[2] + n0[3] * n0[3])) + ((n1[0] * n1[0] + n1[1] * n1[1]) + (n1[2] * n1[2] + n1[3] * n1[3])); } }
                if (!OUT) { ss += __shfl_xor(ss, 16); ss += __shfl_xor(ss, 32); if (fq == 0) part[(ai * HALF + wr * 64 + m * 16 + fr) * 4 + wc] = ss; } }
            asm volatile("" ::: "memory"); }
        if (!OUT) {
            asm volatile("s_waitcnt lgkmcnt(0)" ::: "memory"); __builtin_amdgcn_s_barrier(); asm volatile("" ::: "memory");
            const int t = (wr * 4 + wc) * 64 + fq * 16 + fr;
            if (t < 256) { const f32x4 pp = *(const LAS f32x4*)(part + t * 4); RS4[((size_t)u.pm * BM + t) * 4 + u.pn] = (pp.x + pp.y) + (pp.z + pp.w); }
        }
    }
};

template <class Epi, class Sched, bool ALIGN_EPI = false, bool SP2 = false>
__device__ __forceinline__ void gemm_phase(LAS unsigned char* lds, const Gemm g, const Sched& S, const Epi& E, const float* rs = nullptr, LAS unsigned char* rstab = nullptr, const bool skip_epi = false) {
    int tid_ = threadIdx.x; asm volatile("" : "+v"(tid_));
    const int tid = tid_, wid = __builtin_amdgcn_readfirstlane(tid >> 6), lane = tid & 63, wr = wid >> 2, wc = wid & 3, fr = lane & 15, fq = lane >> 4;
    const int K = g.K, nt = K / BK, lda = g.lda, ldb = g.ldb;
    unsigned voffA[2], voffB[2];
#pragma unroll
    for (int i = 0; i < 2; ++i) { int R, C; stage_rc(tid * 16 + i * 8192, R, C); const int Rb = Epi::PERM ? ((R & ~31) + perm32(R & 31)) : R;
        voffA[i] = (unsigned)(R * lda + C) * 2u; voffB[i] = (unsigned)(Rb * ldb + C) * 2u; }
    const size_t kstep = (size_t)(BK * 2);
    const size_t hstepA = (size_t)HALF * lda * 2, hstepB = (size_t)HALF * ldb * 2;
    const size_t tstepA = 2 * hstepA, tstepB = 2 * hstepB;
    const unsigned ldsw = (unsigned)wid * 1024u;
    const int aoff = lds_byte(wr * 64 + fr, fq * 8), boff = lds_byte(wc * 32 + fr, fq * 8);
#define PG8_SA(b, h) (((b) * 2 + (h)) * HTB)
#define PG8_SB(b, h) ((4 + (b) * 2 + (h)) * HTB)
#define PG8_STAGE(bufoff, gbase, voff) do { _Pragma("unroll") for (int _i = 0; _i < 2; ++_i) \
        __builtin_amdgcn_global_load_lds((const unsigned*)((const char*)(gbase) + (voff)[_i]), (LAS unsigned*)(lds + (bufoff) + ldsw + _i * 8192), 16, 0, 0); } while (0)
#define PG8_LDA(dst, b, h) do { _Pragma("unroll") for (int m = 0; m < 4; ++m) _Pragma("unroll") for (int k = 0; k < 2; ++k) dst[m][k] = *(const LAS bf16x8*)(lds + PG8_SA(b, h) + aoff + m * 2048 + k * 1024); } while (0)
#define PG8_LDB(dst, b, h) do { _Pragma("unroll") for (int n = 0; n < 2; ++n) _Pragma("unroll") for (int k = 0; k < 2; ++k) dst[n][k] = *(const LAS bf16x8*)(lds + PG8_SB(b, h) + boff + n * 2048 + k * 1024); } while (0)
#define PG8_MMA(ai, bj, At, Bt) do { __builtin_amdgcn_s_setprio(1); _Pragma("unroll") for (int m = 0; m < 4; ++m) _Pragma("unroll") for (int n = 0; n < 2; ++n) _Pragma("unroll") for (int k = 0; k < 2; ++k) \
        acc[ai][bj][m][n] = __builtin_amdgcn_mfma_f32_16x16x32_bf16(Bt[n][k], At[m][k], acc[ai][bj][m][n], 0, 0, 0); __builtin_amdgcn_s_setprio(0); } while (0)
#define PG8_WAIT_V(n) asm volatile("s_waitcnt vmcnt(" #n ")" ::: "memory")
#define PG8_WAIT_L(n) asm volatile("s_waitcnt lgkmcnt(" #n ")" ::: "memory")
#define PG8_BAR __builtin_amdgcn_s_barrier()
#define PG8_SCHED __builtin_amdgcn_sched_barrier(0)
    Unit cur, nxt; int ui = 0;
    if (!S.next(0, cur)) return;
    f32x4 acc[2][2][4][2];
#pragma unroll
    for (int a = 0; a < 2; ++a)
#pragma unroll
        for (int b = 0; b < 2; ++b)
#pragma unroll
            for (int m = 0; m < 4; ++m)
#pragma unroll
                for (int n = 0; n < 2; ++n) acc[a][b][m][n] = (f32x4){0.f, 0.f, 0.f, 0.f};
    bf16x8 At[4][2], B0[2][2], B1[2][2];
    const char* cA = (const char*)g.A + (size_t)cur.pm * tstepA; const char* cB = (const char*)g.Bt + (size_t)cur.pn * tstepB;
#define PG8_RSDMA(unit, par) do { if (Epi::USE_RS && wid < 4) __builtin_amdgcn_global_load_lds((const unsigned*)(rs + ((size_t)(unit).pm * BM + wid * 64 + lane) * 4), (LAS unsigned*)(rstab + (par) * 4096 + wid * 1024), 16, 0, 0); } while (0)
    PG8_RSDMA(cur, 0);
    if constexpr (SP2) {
        PG8_STAGE(PG8_SB(0, 0), cB, voffB); PG8_STAGE(PG8_SB(0, 1), cB + hstepB, voffB); PG8_STAGE(PG8_SA(0, 0), cA, voffA); PG8_STAGE(PG8_SA(0, 1), cA + hstepA, voffA);
        if (wr == 1) PG8_BAR;
        PG8_WAIT_V(2); PG8_BAR;
        PG8_STAGE(PG8_SB(1, 0), cB + kstep, voffB); PG8_STAGE(PG8_SA(1, 0), cA + kstep, voffA); PG8_STAGE(PG8_SB(1, 1), cB + hstepB + kstep, voffB);
        PG8_WAIT_V(6); PG8_BAR;
    } else {
        PG8_STAGE(PG8_SB(0, 0), cB, voffB); PG8_STAGE(PG8_SA(0, 0), cA, voffA); PG8_STAGE(PG8_SB(0, 1), cB + hstepB, voffB); PG8_STAGE(PG8_SA(0, 1), cA + hstepA, voffA);
        if (wr == 1) PG8_BAR;
        PG8_WAIT_V(4); PG8_BAR;
        PG8_STAGE(PG8_SB(1, 0), cB + kstep, voffB); PG8_STAGE(PG8_SA(1, 0), cA + kstep, voffA); PG8_STAGE(PG8_SB(1, 1), cB + hstepB + kstep, voffB);
        PG8_WAIT_V(6); PG8_BAR;
    }
    for (;;) {
        const bool has_next = S.next(ui + 1, nxt);
        const char* nA = has_next ? (const char*)g.A + (size_t)nxt.pm * tstepA : cA; const char* nB = has_next ? (const char*)g.Bt + (size_t)nxt.pn * tstepB : cB;
        for (int t = 0; t < nt; t += 2) {
            const bool last = (t == nt - 2);
            const char* a1 = cA + (size_t)(t + 1) * kstep;
            const char* a2 = last ? nA : cA + (size_t)(t + 2) * kstep; const char* b2 = last ? nB : cB + (size_t)(t + 2) * kstep;
            const char* a3 = a2 + kstep; const char* b3 = b2 + kstep;
            if (last && has_next) PG8_RSDMA(nxt, (ui + 1) & 1);
            if constexpr (SP2) {
            PG8_LDB(B0, 0, 0); PG8_LDB(B1, 0, 1); PG8_SCHED; PG8_LDA(At, 0, 0); PG8_STAGE(PG8_SA(1, 1), a1 + hstepA, voffA);
            PG8_WAIT_V(8); PG8_WAIT_L(0); PG8_BAR; PG8_MMA(0, 0, At, B0); PG8_MMA(0, 1, At, B1); PG8_BAR; PG8_SCHED;
            PG8_LDA(At, 0, 1); PG8_STAGE(PG8_SB(0, 0), b2, voffB); PG8_STAGE(PG8_SB(0, 1), b2 + hstepB, voffB); PG8_STAGE(PG8_SA(0, 0), a2, voffA);
            PG8_WAIT_V(8); PG8_WAIT_L(0); PG8_BAR; PG8_MMA(1, 0, At, B0); PG8_MMA(1, 1, At, B1); PG8_BAR; PG8_SCHED;
            PG8_LDB(B0, 1, 0); PG8_LDB(B1, 1, 1); PG8_SCHED; PG8_LDA(At, 1, 0); PG8_STAGE(PG8_SA(0, 1), a2 + hstepA, voffA);
            PG8_WAIT_V(8); PG8_WAIT_L(0); PG8_BAR; PG8_MMA(0, 0, At, B0); PG8_MMA(0, 1, At, B1); PG8_BAR; PG8_SCHED;
            PG8_LDA(At, 1, 1); PG8_STAGE(PG8_SB(1, 0), b3, voffB); PG8_STAGE(PG8_SB(1, 1), b3 + hstepB, voffB); PG8_STAGE(PG8_SA(1, 0), a3, voffA);
            PG8_WAIT_V(8); PG8_WAIT_L(0); PG8_BAR; PG8_MMA(1, 0, At, B0); PG8_MMA(1, 1, At, B1); PG8_BAR; PG8_SCHED;
            } else {
            PG8_LDB(B0, 0, 0); PG8_SCHED; PG8_LDA(At, 0, 0); PG8_STAGE(PG8_SA(1, 1), a1 + hstepA, voffA);
            PG8_WAIT_L(8); PG8_BAR; PG8_WAIT_L(0); PG8_MMA(0, 0, At, B0); PG8_BAR; PG8_SCHED;
            PG8_LDB(B1, 0, 1); PG8_STAGE(PG8_SB(0, 0), b2, voffB);
            PG8_BAR; PG8_WAIT_L(0); PG8_MMA(0, 1, At, B1); PG8_BAR;
            PG8_LDA(At, 0, 1); PG8_STAGE(PG8_SA(0, 0), a2, voffA);
            PG8_BAR; PG8_WAIT_L(0); PG8_MMA(1, 0, At, B0); PG8_BAR; PG8_SCHED;
            PG8_STAGE(PG8_SB(0, 1), b2 + hstepB, voffB);
            PG8_WAIT_V(6); PG8_BAR; PG8_MMA(1, 1, At, B1); PG8_BAR;
            PG8_LDB(B0, 1, 0); PG8_SCHED; PG8_LDA(At, 1, 0); PG8_STAGE(PG8_SA(0, 1), a2 + hstepA, voffA);
            PG8_WAIT_L(8); PG8_BAR; PG8_WAIT_L(0); PG8_MMA(0, 0, At, B0); PG8_BAR; PG8_SCHED;
            PG8_LDB(B1, 1, 1); PG8_STAGE(PG8_SB(1, 0), b3, voffB);
            PG8_BAR; PG8_WAIT_L(0); PG8_MMA(0, 1, At, B1); PG8_BAR;
            PG8_LDA(At, 1, 1); PG8_STAGE(PG8_SA(1, 0), a3, voffA);
            PG8_BAR; PG8_WAIT_L(0); PG8_MMA(1, 0, At, B0); PG8_BAR; PG8_SCHED;
            PG8_STAGE(PG8_SB(1, 1), b3 + hstepB, voffB);
            PG8_WAIT_V(6); PG8_BAR; PG8_MMA(1, 1, At, B1); PG8_BAR;
            }
        }
        if constexpr (ALIGN_EPI) { if (wr == 0) PG8_BAR; }
        if (!skip_epi) E(acc, cur, wr, wc, fr, fq, (const LAS float*)(rstab + (ui & 1) * 4096), rs + (size_t)cur.pm * BM * 4);
        if (!has_next) break;
#pragma unroll
        for (int a = 0; a < 2; ++a)
#pragma unroll
            for (int b = 0; b < 2; ++b)
#pragma unroll
                for (int m = 0; m < 4; ++m)
#pragma unroll
                    for (int n = 0; n < 2; ++n) { typedef double f64x2_ __attribute__((ext_vector_type(2))); double z0, z1;
                        asm volatile("v_mov_b64 %0, 0\n\tv_mov_b64 %1, 0" : "=v"(z0), "=v"(z1)); f64x2_ zz = {z0, z1}; acc[a][b][m][n] = __builtin_bit_cast(f32x4, zz); }
        cur = nxt; cA = nA; cB = nB; ++ui;
        if constexpr (ALIGN_EPI) { if (wr == 1) PG8_BAR; }
    }
    PG8_WAIT_V(0);
    if constexpr (!ALIGN_EPI) { if (wr == 0) PG8_BAR; }
    PG8_BAR;
#undef PG8_RSDMA
#undef PG8_SA
#undef PG8_SB
#undef PG8_STAGE
#undef PG8_LDA
#undef PG8_LDB
#undef PG8_MMA
#undef PG8_WAIT_V
#undef PG8_WAIT_L
#undef PG8_BAR
#undef PG8_SCHED
}
}
#ifndef PG8_SP2
#define PG8_SP2 true
#endif
#ifndef PG8_ALIGN
#define PG8_ALIGN true
#endif

#define XB_TMO      128
#define XB_XCNT(j)  (256  + 64 * (j))
#define XB_XSUB(j)  (1280 + 64 * (j))
#define XB_XGEN(j)  (2304 + 64 * (j))
#define XB_TOP      3328
#define XB_TOPGEN   3392
#define XCD_BAR_WORDS 3456
#define XB_SPIN_CAP (1u << 18)
__device__ __forceinline__ unsigned xb_ld(unsigned* p)              { return __hip_atomic_load(p, __ATOMIC_RELAXED, __HIP_MEMORY_SCOPE_AGENT); }
__device__ __forceinline__ unsigned xb_add(unsigned* p, unsigned v) { return __hip_atomic_fetch_add(p, v, __ATOMIC_RELAXED, __HIP_MEMORY_SCOPE_AGENT); }
__device__ __forceinline__ unsigned xb_xcc_id() { return (unsigned)__builtin_amdgcn_s_getreg((3 << 11) | 20) & 0xFu; }
#define XB_SPIN(cond, bar) do { unsigned _sp = 0; while (cond) { __builtin_amdgcn_s_sleep(1); \
    if ((++_sp & 255u) == 0u) { if (xb_ld(&(bar)[XB_TMO])) break; if (_sp > XB_SPIN_CAP) { atomicAdd(&(bar)[XB_TMO], 1u); break; } } } } while (0)
struct XcdBarrier { unsigned* bar; unsigned x; volatile LAS unsigned* st; };
__device__ __forceinline__ XcdBarrier xcd_barrier_post(unsigned* bar, volatile LAS unsigned* st) {
    XcdBarrier b; b.bar = bar; b.x = xb_xcc_id(); b.st = st;
    if (threadIdx.x == 0) (void)xb_add(&bar[XB_XCNT(b.x)], 1u);
    return b;
}
__device__ __forceinline__ void xcd_barrier_complete(unsigned* bar, unsigned x, unsigned& nloc, unsigned& nx) {
    const unsigned G = gridDim.x * gridDim.y * gridDim.z;
    unsigned sum, cnt, mine, sp = 0u;
    for (;;) {
        sum = 0u; cnt = 0u; mine = 0u;
#pragma unroll
        for (unsigned j = 0; j < 16; ++j) { const unsigned c = xb_ld(&bar[XB_XCNT(j)]); sum += c; cnt += (c > 0u) ? 1u : 0u; mine = (j == x) ? c : mine; }
        if (sum == G) break;
        __builtin_amdgcn_s_sleep(1);
        if ((++sp & 255u) == 0u) { if (xb_ld(&bar[XB_TMO])) break; if (sp > XB_SPIN_CAP) { atomicAdd(&bar[XB_TMO], 1u); break; } }
    }
    nloc = mine > 0u ? mine : 1u; nx = cnt > 0u ? cnt : 1u;
}
__device__ __forceinline__ void xcd_barrier(const XcdBarrier& b) {
    asm volatile("s_waitcnt vmcnt(0)" ::: "memory");
    __syncthreads();
    if (threadIdx.x == 0) {
        unsigned* bar = b.bar;
        __builtin_amdgcn_s_waitcnt(0);
        unsigned nloc = b.st[0], nx = b.st[1];
        if (nloc == 0u) { xcd_barrier_complete(bar, b.x, nloc, nx); b.st[0] = nloc; b.st[1] = nx; }
        const unsigned old = xb_add(&bar[XB_XSUB(b.x)], 1u);
        const unsigned gen = old / nloc;
        if (old + 1u == (gen + 1u) * nloc) {
            __builtin_amdgcn_fence(__ATOMIC_RELEASE, "agent");
            asm volatile("s_waitcnt vmcnt(0)" ::: "memory");
            const unsigned og = xb_add(&bar[XB_TOP], 1u);
            const unsigned tg = og / nx;
            if (og + 1u == (tg + 1u) * nx) xb_add(&bar[XB_TOPGEN], 1u);
            else XB_SPIN(xb_ld(&bar[XB_TOPGEN]) == tg, bar);
            __builtin_amdgcn_fence(__ATOMIC_ACQUIRE, "agent");
            xb_add(&bar[XB_XGEN(b.x)], 1u);
            asm volatile("s_waitcnt vmcnt(0)" ::: "memory");
        } else {
            XB_SPIN(xb_ld(&bar[XB_XGEN(b.x)]) == gen, bar);
            __builtin_amdgcn_fence(__ATOMIC_ACQUIRE, "agent");
            asm volatile("s_waitcnt vmcnt(0)" ::: "memory");
        }
    }
    __syncthreads();
}
namespace att {
typedef float f32x16 __attribute__((ext_vector_type(16)));
typedef short s16x4 __attribute__((ext_vector_type(4)));
constexpr int SHM_V = 16384, SHM_KN = 16384, SHM_KR = 8192;
constexpr int NKS = 3, NVS = 4;
constexpr int L_KN = 0, L_KR = L_KN + NKS * SHM_KN, L_V = L_KR + NKS * SHM_KR, L_WS = L_V + NVS * SHM_V, L_END = L_WS + 8 * 64 * 4;
static_assert(L_END <= 160 * 1024 - 1024, "attention LDS map");
constexpr float THR = 8.f;
#define KSWZ(row, chunk) ((row) * 256 + ((((chunk) ^ (row)) & 15) << 4))
#define KRSWZ(row, chunk) ((row) * 128 + ((((chunk) ^ ((row) >> 1)) & 7) << 4))
#define SBAR() __builtin_amdgcn_sched_barrier(0)
__device__ __forceinline__ int v_st(int k, int c) { const int kk = (k & ~0xC) | ((k & 4) << 1) | ((k & 8) >> 1); return ((kk >> 3) * 4 + (c >> 5)) * 512 + ((kk & 7) * 32 + (c & 31)) * 2; }
__device__ __forceinline__ int v_rd_base(int lane) { return ((lane & 3) << 3) | (((lane >> 2) & 3) << 6) | (((lane >> 4) & 1) << 5) | (((lane >> 5) & 1) << 8); }
constexpr int v_rd_off(int d0, int ks, int half) { return d0 * 512 + ks * 4096 + half * 2048; }
__device__ __forceinline__ int crow(int r, int hi) { return (r & 3) + 8 * (r >> 2) + 4 * hi; }
__device__ __forceinline__ bf16x8 pack8(f32x4 a, f32x4 b) { u32x4 w = {cvt_pk_bf16(a[0], a[1]), cvt_pk_bf16(a[2], a[3]), cvt_pk_bf16(b[0], b[1]), cvt_pk_bf16(b[2], b[3])}; return __builtin_bit_cast(bf16x8, w); }
__device__ __forceinline__ void mask_tile(f32x16& p0, f32x16& p1, int dq) {
    const float NEG = -__builtin_inff();
#pragma unroll
    for (int r = 0; r < 16; ++r) { const int c = (r & 3) + 8 * (r >> 2); if (dq - c < 0) p0[r] = NEG; if (dq - c - 32 < 0) p1[r] = NEG; }
}
__device__ __forceinline__ void partialSM(f32x16& p0, f32x16& p1, float& m_reg, float& mn, float& alpha, const float SCALE) {
    float pmax = p0[0];
#pragma unroll
    for (int r = 1; r < 16; ++r) pmax = fmaxf(pmax, p0[r]);
#pragma unroll
    for (int r = 0; r < 16; ++r) pmax = fmaxf(pmax, p1[r]);
    { auto rr = __builtin_amdgcn_permlane32_swap(__float_as_uint(pmax), __float_as_uint(pmax), false, false);
      pmax = fmaxf(__uint_as_float(rr[0]), __uint_as_float(rr[1])); }
    const float C2 = 1.4426950408889634f * SCALE;
    if (__builtin_expect(__all((pmax - m_reg) * SCALE <= THR), 1)) { mn = m_reg; alpha = 1.f; }
    else { mn = fmaxf(m_reg, pmax); alpha = __builtin_amdgcn_exp2f((m_reg - mn) * C2); m_reg = mn; }
    const float mnL = -mn * C2;
#pragma unroll
    for (int r = 0; r < 16; ++r) p0[r] = fmaf(p0[r], C2, mnL);
#pragma unroll
    for (int r = 0; r < 16; ++r) p1[r] = fmaf(p1[r], C2, mnL);
#pragma unroll
    for (int r = 0; r < 16; ++r) p0[r] = __builtin_amdgcn_exp2f(p0[r]);
}
__device__ __forceinline__ void finishSM(f32x16& p0, f32x16& p1, float alpha, float& l_reg, bf16x8& pa0, bf16x8& pa1, bf16x8& pa2, bf16x8& pa3) {
#pragma unroll
    for (int r = 0; r < 16; ++r) p1[r] = __builtin_amdgcn_exp2f(p1[r]);
    float ps = 0;
#pragma unroll
    for (int r = 0; r < 16; ++r) ps += p0[r];
#pragma unroll
    for (int r = 0; r < 16; ++r) ps += p1[r];
    { auto rr = __builtin_amdgcn_permlane32_swap(__float_as_uint(ps), __float_as_uint(ps), false, false);
      ps = __uint_as_float(rr[0]) + __uint_as_float(rr[1]); }
    l_reg = l_reg * alpha + ps;
#define PK4(P, B_, OUT) do { unsigned a0 = cvt_pk_bf16(P[B_+0], P[B_+1]), a1 = cvt_pk_bf16(P[B_+2], P[B_+3]);                          \
        unsigned b0 = cvt_pk_bf16(P[B_+4], P[B_+5]), b1 = cvt_pk_bf16(P[B_+6], P[B_+7]);                                             \
        auto r0 = __builtin_amdgcn_permlane32_swap(a0, b0, false, false); auto r1 = __builtin_amdgcn_permlane32_swap(a1, b1, false, false); \
        u32x4 w = {r0[0], r1[0], r0[1], r1[1]}; OUT = __builtin_bit_cast(bf16x8, w); } while (0)
    PK4(p0, 0, pa0); PK4(p0, 8, pa1); PK4(p1, 0, pa2); PK4(p1, 8, pa3);
#undef PK4
}
__device__ __forceinline__ void staticSM(f32x16& p0, f32x16& p1, float& l_reg, bf16x8& pa0, bf16x8& pa1, bf16x8& pa2, bf16x8& pa3) {
#pragma unroll
    for (int r = 0; r < 16; ++r) p0[r] = __builtin_amdgcn_exp2f(p0[r]);
#pragma unroll
    for (int r = 0; r < 16; ++r) p1[r] = __builtin_amdgcn_exp2f(p1[r]);
    float ps = 0;
#pragma unroll
    for (int r = 0; r < 16; ++r) ps += p0[r];
#pragma unroll
    for (int r = 0; r < 16; ++r) ps += p1[r];
    { auto rr = __builtin_amdgcn_permlane32_swap(__float_as_uint(ps), __float_as_uint(ps), false, false);
      ps = __uint_as_float(rr[0]) + __uint_as_float(rr[1]); }
    l_reg += ps;
#define PK4(P, B_, OUT) do { unsigned a0 = cvt_pk_bf16(P[B_+0], P[B_+1]), a1 = cvt_pk_bf16(P[B_+2], P[B_+3]);                          \
        unsigned b0 = cvt_pk_bf16(P[B_+4], P[B_+5]), b1 = cvt_pk_bf16(P[B_+6], P[B_+7]);                                             \
        auto r0 = __builtin_amdgcn_permlane32_swap(a0, b0, false, false); auto r1 = __builtin_amdgcn_permlane32_swap(a1, b1, false, false); \
        u32x4 w = {r0[0], r1[0], r0[1], r1[1]}; OUT = __builtin_bit_cast(bf16x8, w); } while (0)
    PK4(p0, 0, pa0); PK4(p0, 8, pa1); PK4(p1, 0, pa2); PK4(p1, 8, pa3);
#undef PK4
}
template <int NR>
__device__ __forceinline__ void qkt(f32x16& p0, f32x16& p1, const int (&kaddr)[8], const int (&raddr)[4], const bf16x8* qr, const float init) {
#pragma unroll
    for (int r = 0; r < 16; ++r) { p0[r] = init; p1[r] = init; }
    bf16x8 a0, a1, a2, a3, b0, b1, b2, b3;
#define KRD(dst, addr, off) asm volatile("ds_read_b128 %0, %1 offset:%2" : "=&v"(dst) : "v"(addr), "i"(off) : "memory")
#define KLD(d, x0, x1) do { if ((d) < 8) { KRD(x0, kaddr[(d) & 7], 0); KRD(x1, kaddr[(d) & 7], 8192); } else { KRD(x0, raddr[((d) - 8) & 3], 0); KRD(x1, raddr[((d) - 8) & 3], 4096); } } while (0)
#define KWAIT(n) do { asm volatile("s_waitcnt lgkmcnt(" #n ")" : "+v"(a0), "+v"(a1), "+v"(a2), "+v"(a3), "+v"(b0), "+v"(b1), "+v"(b2), "+v"(b3) :: "memory"); SBAR(); } while (0)
#define KMMA(d, x0, x1) do { p0 = __builtin_amdgcn_mfma_f32_32x32x16_bf16(x0, qr[d], p0, 0, 0, 0); p1 = __builtin_amdgcn_mfma_f32_32x32x16_bf16(x1, qr[d], p1, 0, 0, 0); } while (0)
    constexpr int NS = 8 + NR;
    KLD(0, a0, a1); KLD(1, a2, a3); KLD(2, b0, b1); KLD(3, b2, b3);
    KWAIT(4); KMMA(0, a0, a1); KMMA(1, a2, a3); KLD(4, a0, a1); KLD(5, a2, a3);
    KWAIT(4); KMMA(2, b0, b1); KMMA(3, b2, b3); KLD(6, b0, b1); KLD(7, b2, b3);
    if constexpr (NS > 8) {
        KWAIT(4); KMMA(4, a0, a1); KMMA(5, a2, a3); KLD(8, a0, a1); KLD(9, a2, a3);
        KWAIT(4); KMMA(6, b0, b1); KMMA(7, b2, b3); KLD(10, b0, b1); KLD(11, b2, b3);
        KWAIT(4); KMMA(8, a0, a1); KMMA(9, a2, a3);
        KWAIT(0); KMMA(10, b0, b1); KMMA(11, b2, b3);
    } else {
        KWAIT(4); KMMA(4, a0, a1); KMMA(5, a2, a3);
        KWAIT(0); KMMA(6, b0, b1); KMMA(7, b2, b3);
    }
#undef KMMA
#undef KWAIT
#undef KLD
#undef KRD
}
__device__ __forceinline__ void pv_tile(f32x16* o, int vb0  , bf16x8 pa0, bf16x8 pa1, bf16x8 pa2, bf16x8 pa3) {
#define TRRD(dst, off) asm volatile("ds_read_b64_tr_b16 %0, %1 offset:%2" : "=&v"(dst) : "v"(vb0), "i"(off) : "memory")
#define PV_LOAD(L, H, ks) do { constexpr int b_ = (ks) * 4096; \
        TRRD(L[0], b_); TRRD(H[0], b_ + 2048); TRRD(L[1], b_ + 512); TRRD(H[1], b_ + 512 + 2048); TRRD(L[2], b_ + 1024); TRRD(H[2], b_ + 1024 + 2048); TRRD(L[3], b_ + 1536); TRRD(H[3], b_ + 1536 + 2048); } while (0)
#define PV_WAIT(n) do { asm volatile("s_waitcnt lgkmcnt(" #n ")" : "+v"(la[0]), "+v"(ha[0]), "+v"(la[1]), "+v"(ha[1]), "+v"(la[2]), "+v"(ha[2]), "+v"(la[3]), "+v"(ha[3]), "+v"(lb[0]), "+v"(hb[0]), "+v"(lb[1]), "+v"(hb[1]), "+v"(lb[2]), "+v"(hb[2]), "+v"(lb[3]), "+v"(hb[3]) :: "memory"); SBAR(); } while (0)
#define PV_MMA(pa, L, H) do { _Pragma("unroll") for (int d0 = 0; d0 < 4; ++d0) \
        o[d0] = __builtin_amdgcn_mfma_f32_32x32x16_bf16(pa, (bf16x8){L[d0][0], L[d0][1], L[d0][2], L[d0][3], H[d0][0], H[d0][1], H[d0][2], H[d0][3]}, o[d0], 0, 0, 0); } while (0)
    s16x4 la[4], ha[4], lb[4], hb[4];
    PV_LOAD(la, ha, 0); PV_LOAD(lb, hb, 1);
    PV_WAIT(8); PV_MMA(pa0, la, ha);
    PV_LOAD(la, ha, 2);
    PV_WAIT(8); PV_MMA(pa1, lb, hb);
    PV_LOAD(lb, hb, 3);
    PV_WAIT(8); PV_MMA(pa2, la, ha);
    PV_WAIT(0); PV_MMA(pa3, lb, hb);
#undef PV_MMA
#undef PV_WAIT
#undef PV_LOAD
#undef TRRD
}

struct ABlk { const bf16* Q; const bf16* Kn; const bf16* Kr; const bf16* V; bf16* O; int NT, P0; };
template <int NR, bool CAUSAL, int QMODE, class Get>
__device__ __forceinline__ void attn_blocks(LAS char* lds, const Get& get, const int nblk, int ldq, int ldk, int ldv, int ldo,
                                            const float SCALE, const float BND  , const float* qgain, const float* qgain2, const float* rope, const bool dry = false) {
    if (nblk <= 0) return;
    int tid_ = threadIdx.x; asm volatile("" : "+v"(tid_));
    const int tid = tid_, wid = __builtin_amdgcn_readfirstlane(tid >> 6), lane = tid & 63, r32 = lane & 31, hi = lane >> 5;
#ifndef ATT_STAGGER
#define ATT_STAGGER 1
#endif
    const bool late = ATT_STAGGER && wid >= 4;
#ifndef ABL
#define ABL 0
#endif
#ifndef ATT_PRIO
#define ATT_PRIO 1
#endif
    const int abl = dry ? ABL : 0;
    constexpr int NOPS = 4 + (NR > 0 ? 1 : 0);
    int so_k[2], so_v[2], so_r = 0;
#pragma unroll
    for (int i = 0; i < 2; ++i) {
        const int p = 2 * wid + i;
        { const int row = 4 * p + (lane >> 4), c = (lane ^ row) & 15; so_k[i] = row * ldk + c * 8; }
        { const int st = 2 * p + (lane >> 5), kk = (st >> 2) * 8 + ((lane & 31) >> 2), key = (kk & ~0xC) | ((kk & 4) << 1) | ((kk & 8) >> 1), col = (st & 3) * 32 + (lane & 3) * 8; so_v[i] = key * ldv + col; }
    }
    if constexpr (NR > 0) { const int row = 8 * wid + (lane >> 3), c = ((lane & 7) ^ (row >> 1)) & 7; so_r = row * 64 + c * 8; }
#define DMA16(gp, loff) __builtin_amdgcn_global_load_lds((const unsigned*)(gp), (LAS unsigned*)(lds + (loff)), 16, 0, 0)
#define ISSUE(Kn_, Kr_, V_, tile, ks_, vs_) do { const int k0_ = (tile) * 64; \
        DMA16((Kn_) + (size_t)k0_ * ldk + so_k[0], L_KN + (ks_) * SHM_KN + (2 * wid) * 1024); DMA16((Kn_) + (size_t)k0_ * ldk + so_k[1], L_KN + (ks_) * SHM_KN + (2 * wid + 1) * 1024); \
        if constexpr (NR > 0) DMA16((Kr_) + (size_t)k0_ * 64 + so_r, L_KR + (ks_) * SHM_KR + wid * 1024); \
        DMA16((V_) + (size_t)k0_ * ldv + so_v[0], L_V + (vs_) * SHM_V + (2 * wid) * 1024); DMA16((V_) + (size_t)k0_ * ldv + so_v[1], L_V + (vs_) * SHM_V + (2 * wid + 1) * 1024); } while (0)
#define LOADQ(Qp) do { _Pragma("unroll") for (int d0 = 0; d0 < 8 + NR; ++d0) qr[d0] = *(const bf16x8*)((Qp) + (size_t)(wid * 32 + r32) * ldq + d0 * 16 + hi * 8); } while (0)
    ABlk cur; get(0, cur);
    ISSUE(cur.Kn, cur.Kr, cur.V, 0, 0, 0); ISSUE(cur.Kn, cur.Kr, cur.V, 1, 1, 1);
    bf16x8 qr[8 + NR];
    LOADQ(cur.Q);
    int ks = 0, vs = 0;
    LAS float* ws = (LAS float*)(lds + L_WS) + wid * 64; LAS float* li_l = ws; LAS float* al_l = ws + 32;
    int kbase[8], krbase[4];
#pragma unroll
    for (int d0 = 0; d0 < 8; ++d0) kbase[d0] = KSWZ(r32, 2 * d0 + hi);
#pragma unroll
    for (int dr = 0; dr < 4; ++dr) krbase[dr] = KRSWZ(r32, 2 * dr + hi);
    const int vrd = (int)(uintptr_t)lds + L_V + v_rd_base(lane), kn0 = (int)(uintptr_t)lds + L_KN, kr0 = (int)(uintptr_t)lds + L_KR;
    for (int bn = 0; bn < nblk; ++bn) {
    const bool has_next = bn + 1 < nblk; ABlk nxt = cur; if (has_next) get(bn + 1, nxt);
    const int NT = cur.NT, P0 = cur.P0; bf16* const O = cur.O;
    asm volatile("s_waitcnt vmcnt(0)" ::: "memory");
    if constexpr (QMODE >= 1) {
        float ss = 0.f;
#pragma unroll
        for (int d0 = 0; d0 < 8; ++d0)
#pragma unroll
            for (int e = 0; e < 8; ++e) { const float v = bf2f((bf16)qr[d0][e]); ss += v * v; }
        { auto rr = __builtin_amdgcn_permlane32_swap(__float_as_uint(ss), __float_as_uint(ss), false, false); ss = __uint_as_float(rr[0]) + __uint_as_float(rr[1]); }
        const float rstdc = (1.0f / sqrtf(ss * (1.f / 128.f) + EPS)) * (1.4426950408889634f * SCALE);
#pragma unroll
        for (int d0 = 0; d0 < 8; ++d0) { const f32x4 g0 = *(const f32x4*)(qgain + d0 * 16 + hi * 8), g1 = *(const f32x4*)(qgain + d0 * 16 + hi * 8 + 4); f32x4 a, b;
#pragma unroll
            for (int e = 0; e < 4; ++e) { a[e] = bf2f((bf16)qr[d0][e]) * rstdc * g0[e]; b[e] = bf2f((bf16)qr[d0][4 + e]) * rstdc * g1[e]; }
            qr[d0] = pack8(a, b); }
    }
    if constexpr (QMODE == 2 && NR == 4) {
        float ss = 0.f;
#pragma unroll
        for (int d0 = 8; d0 < 12; ++d0)
#pragma unroll
            for (int e = 0; e < 8; ++e) { const float v = bf2f((bf16)qr[d0][e]); ss += v * v; }
        { auto rr = __builtin_amdgcn_permlane32_swap(__float_as_uint(ss), __float_as_uint(ss), false, false); ss = __uint_as_float(rr[0]) + __uint_as_float(rr[1]); }
        const float rstd = (1.0f / sqrtf(ss * (1.f / 64.f) + EPS)) * (1.4426950408889634f * SCALE);
        const int pos = P0 + wid * 32 + r32;
#pragma unroll
        for (int dd = 0; dd < 2; ++dd) {
            const float* cp = rope + pos * 32 + dd * 16 + hi * 8; const float* sp = cp + SEQ * 32;
            const float* g1 = qgain2 + dd * 16 + hi * 8; const float* g2 = g1 + 32;
            f32x4 a, b, c, d;
#pragma unroll
            for (int e = 0; e < 8; ++e) { const float t1 = bf2f((bf16)qr[8 + dd][e]) * rstd * g1[e], t2 = bf2f((bf16)qr[10 + dd][e]) * rstd * g2[e], cs = cp[e], sn = sp[e];
                const float n1 = t1 * cs - t2 * sn, n2 = t1 * sn + t2 * cs;
                if (e < 4) { a[e] = n1; c[e] = n2; } else { b[e - 4] = n1; d[e - 4] = n2; } }
            qr[8 + dd] = pack8(a, b); qr[10 + dd] = pack8(c, d); }
    }
    float m_reg = -1e30f, l_reg = 0.f; f32x16 o[4] = {};
    const int qlo = P0 + wid * 32, qm = qlo + r32 - 4 * hi;
#define RESC(a) do { if (__any((a) < 1.f)) { if (hi == 0) al_l[r32] = (a); asm volatile("s_waitcnt lgkmcnt(0)" ::: "memory");              \
        _Pragma("unroll") for (int d_ = 0; d_ < 4; ++d_) _Pragma("unroll") for (int r = 0; r < 16; ++r) o[d_][r] *= al_l[crow(r, hi)]; } } while (0)
    f32x16 p0, p1; float mn, al; bf16x8 pa0, pa1, pa2, pa3;
    const float pinit = 0.f;
    asm volatile("s_waitcnt vmcnt(0)" ::: "memory");
    for (int t = 0; t < NT; ++t) {
        if constexpr (NOPS == 5) asm volatile("s_waitcnt vmcnt(5)" ::: "memory"); else asm volatile("s_waitcnt vmcnt(4)" ::: "memory");
        asm volatile("s_waitcnt lgkmcnt(0)" ::: "memory"); if (abl != 4 && abl != 5) __builtin_amdgcn_s_barrier(); asm volatile("" ::: "memory");
        if (abl != 5) { int tn = t + 2; const bf16* kn_ = cur.Kn; const bf16* kr_ = cur.Kr; const bf16* v_ = cur.V;
          if (tn >= NT) { if (has_next) { tn -= NT; kn_ = nxt.Kn; kr_ = nxt.Kr; v_ = nxt.V; } else tn = NT - 1; }
          int ks2 = ks + 2; if (ks2 >= NKS) ks2 -= NKS; int vs2 = vs + 2; if (vs2 >= NVS) vs2 -= NVS;
          ISSUE(kn_, kr_, v_, tn, ks2, vs2); }
        const int kb_ = t * 64;
        if (late && t > 0 && abl != 2) { int vp = vs - 1; if (vp < 0) vp += NVS; SBAR(); __builtin_amdgcn_s_setprio(ATT_PRIO); pv_tile(o, vrd + vp * SHM_V, pa0, pa1, pa2, pa3); __builtin_amdgcn_s_setprio(0); }
        { int kaddr[8], raddr[4];
#pragma unroll
          for (int d0 = 0; d0 < 8; ++d0) kaddr[d0] = kn0 + ks * SHM_KN + kbase[d0];
#pragma unroll
          for (int dr = 0; dr < 4; ++dr) raddr[dr] = kr0 + ks * SHM_KR + krbase[dr];
          SBAR(); __builtin_amdgcn_s_setprio(ATT_PRIO); if (abl != 3) qkt<NR>(p0, p1, kaddr, raddr, qr, pinit); else { p0 = f32x16{}; p1 = f32x16{}; } __builtin_amdgcn_s_setprio(0); }
        if (CAUSAL && kb_ + 63 > qlo) mask_tile(p0, p1, qm - kb_);
        if (abl != 1) { if (BND > 0.f) staticSM(p0, p1, l_reg, pa0, pa1, pa2, pa3);
                        else { partialSM(p0, p1, m_reg, mn, al, 0.6931471805599453f); finishSM(p0, p1, al, l_reg, pa0, pa1, pa2, pa3); RESC(al); } }
        else { u32x4 w0 = {cvt_pk_bf16(p0[0], p0[1]), cvt_pk_bf16(p0[2], p0[3]), cvt_pk_bf16(p0[4], p0[5]), cvt_pk_bf16(p0[6], p0[7])}, w1 = {cvt_pk_bf16(p0[8], p0[9]), cvt_pk_bf16(p0[10], p0[11]), cvt_pk_bf16(p0[12], p0[13]), cvt_pk_bf16(p0[14], p0[15])},
                     w2 = {cvt_pk_bf16(p1[0], p1[1]), cvt_pk_bf16(p1[2], p1[3]), cvt_pk_bf16(p1[4], p1[5]), cvt_pk_bf16(p1[6], p1[7])}, w3 = {cvt_pk_bf16(p1[8], p1[9]), cvt_pk_bf16(p1[10], p1[11]), cvt_pk_bf16(p1[12], p1[13]), cvt_pk_bf16(p1[14], p1[15])};
               pa0 = __builtin_bit_cast(bf16x8, w0); pa1 = __builtin_bit_cast(bf16x8, w1); pa2 = __builtin_bit_cast(bf16x8, w2); pa3 = __builtin_bit_cast(bf16x8, w3); l_reg = 1.f; }
        SBAR();
        if (!late && abl != 2) { __builtin_amdgcn_s_setprio(ATT_PRIO); pv_tile(o, vrd + vs * SHM_V, pa0, pa1, pa2, pa3); __builtin_amdgcn_s_setprio(0); }
        if (++ks == NKS) ks = 0; if (++vs == NVS) vs = 0;
    }
    if (late) { int vp = vs - 1; if (vp < 0) vp += NVS; SBAR(); pv_tile(o, vrd + vp * SHM_V, pa0, pa1, pa2, pa3); }
    if (has_next) LOADQ(nxt.Q);
    if (hi == 0) li_l[r32] = l_reg;
    asm volatile("s_waitcnt lgkmcnt(0)" ::: "memory");
    { bf16* Ow = O + (size_t)(wid * 32) * ldo;
      const bool b0 = (r32 & 1) != 0, b1 = (r32 & 2) != 0;
#define QX1(v) __int_as_float(__builtin_amdgcn_update_dpp(0, __float_as_int(v), 0xB1, 0xf, 0xf, true))
#define QX2(v) __int_as_float(__builtin_amdgcn_update_dpp(0, __float_as_int(v), 0x4E, 0xf, 0xf, true))
#pragma unroll
      for (int rg = 0; rg < 4; ++rg) {
          float rl[4];
#pragma unroll
          for (int k = 0; k < 4; ++k) rl[k] = __builtin_amdgcn_rcpf(li_l[8 * rg + 4 * hi + k]);
          bf16* rowp = Ow + (size_t)(8 * rg + 4 * hi + (r32 & 3)) * ldo + (r32 & ~3);
#pragma unroll
          for (int d0 = 0; d0 < 4; ++d0) {
              float x0 = o[d0][4 * rg + 0] * rl[0], x1 = o[d0][4 * rg + 1] * rl[1], x2 = o[d0][4 * rg + 2] * rl[2], x3 = o[d0][4 * rg + 3] * rl[3];
              { const float s = b0 ? x0 : x1, rv = QX1(s); const float n0 = b0 ? rv : x0, n1 = b0 ? x1 : rv; x0 = n0; x1 = n1; }
              { const float s = b0 ? x2 : x3, rv = QX1(s); const float n2 = b0 ? rv : x2, n3 = b0 ? x3 : rv; x2 = n2; x3 = n3; }
              { const float s = b1 ? x0 : x2, rv = QX2(s); const float n0 = b1 ? rv : x0, n2 = b1 ? x2 : rv; x0 = n0; x2 = n2; }
              { const float s = b1 ? x1 : x3, rv = QX2(s); const float n1 = b1 ? rv : x1, n3 = b1 ? x3 : rv; x1 = n1; x3 = n3; }
              u32x2 w; w.x = cvt_pk_bf16(x0, x1); w.y = cvt_pk_bf16(x2, x3);
              if (!dry) *(u32x2*)(rowp + d0 * 32) = w; } }
#undef QX1
#undef QX2
    }
    cur = nxt;
    }
    asm volatile("s_waitcnt vmcnt(0) lgkmcnt(0)" ::: "memory"); __builtin_amdgcn_s_barrier(); asm volatile("" ::: "memory");
#undef LOADQ
#undef DMA16
#undef ISSUE
#undef RESC
}
}
constexpr int NWAVES = 8;
constexpr int RING_OFF = 0, RING_BYTES = 131072;
constexpr int XTRA_OFF = RING_BYTES, XTRA_BYTES = 32256;
constexpr int MISC_OFF = XTRA_OFF + XTRA_BYTES;
constexpr int LDS_BYTES = MISC_OFF + 512;
static_assert(LDS_BYTES == 163840, "LDS map");

constexpr size_t WB_GU0 = 0, WB_D0 = 11 * MiB, WB_GU1 = WB_D0 + (size_t)DM * FF * 2, WB_D1 = WB_GU1 + 11 * MiB, WB_WO = 33 * MiB, WB_IN = 36 * MiB, WB_UQ = 43 * MiB, WB_UKV = 45 * MiB;
static_assert(WB_D1 + (size_t)DM * FF * 2 <= WB_WO && WB_UKV + 1 * MiB <= 52 * MiB && WS_WB + 52 * MiB <= WS_XN, "weight map");
constexpr size_t WS_MEMW = WS_BIG;

constexpr int CW_BAR = 4096;
constexpr size_t WS_RS = 78 * MiB;
constexpr size_t CTL_ZERO_BYTES = 1 * MiB;
static_assert(WS_WB + 46 * MiB <= WS_RS && WS_RS + 12 * (size_t)M * 16 <= WS_XN, "row sums sit between the weight copies and XN");

struct MArgs { const float* in[29]; float* out; unsigned char* ws; int lo, hi, region, pad; };
static_assert(sizeof(MArgs) == 264, "no padding in the argument struct");

struct Frame {
    LAS unsigned char* lds;
    int vcu, G;
    float* X; unsigned char* ws; bf16* OC;
};
#define PH_IDS() int tid_ = threadIdx.x; asm volatile("" : "+v"(tid_)); const int tid = tid_, lane = tid & 63, wave = __builtin_amdgcn_readfirstlane(tid >> 6); (void)tid; (void)lane; (void)wave

__device__ __forceinline__ void tr_item(const float* W, int ldw, int scol, int k0, bf16* WT, int K, int drow, LAS float* scr, int lane, int nv, const float* gain) {
    const int c = lane & 7;
    if (nv == 0) {
#pragma unroll
        for (int j = 0; j < 4; ++j) { const int n = (lane >> 3) + 8 * j; *(GAS u32x4*)(WT + (size_t)(drow + n) * K + k0 + 8 * c) = (u32x4){0u, 0u, 0u, 0u}; }
        return;
    }
    const int n4 = (lane & 7) * 4, kq = lane >> 3;
    const GAS float* Wg = (const GAS float*)W + (size_t)(k0 + kq) * ldw + scol + n4;
    const bool val = n4 < nv;
    f32x4 wv[8];
#pragma unroll
    for (int i = 0; i < 8; ++i) wv[i] = val ? *(const GAS f32x4*)(Wg + (size_t)(8 * i) * ldw) : (f32x4){0.f, 0.f, 0.f, 0.f};
#pragma unroll
    for (int i = 0; i < 8; ++i) { LAS float* d = scr + (kq + 8 * i) * 33 + n4; d[0] = wv[i].x; d[1] = wv[i].y; d[2] = wv[i].z; d[3] = wv[i].w; }
    f32x4 g0 = (f32x4){1.f, 1.f, 1.f, 1.f}, g1 = g0;
    if (gain) { g0 = *(const GAS f32x4*)(gain + k0 + 8 * c); g1 = *(const GAS f32x4*)(gain + k0 + 8 * c + 4); }
    LDS_WAIT(); asm volatile("" ::: "memory");
#pragma unroll
    for (int j = 0; j < 4; ++j) { const int n = (lane >> 3) + 8 * j; const LAS float* s = scr + (8 * c) * 33 + n;
        u32x4 o; o.x = cvt_pk_bf16(s[0 * 33] * g0[0], s[1 * 33] * g0[1]); o.y = cvt_pk_bf16(s[2 * 33] * g0[2], s[3 * 33] * g0[3]); o.z = cvt_pk_bf16(s[4 * 33] * g1[0], s[5 * 33] * g1[1]); o.w = cvt_pk_bf16(s[6 * 33] * g1[2], s[7 * 33] * g1[3]);
        *(GAS u32x4*)(WT + (size_t)(drow + n) * K + k0 + 8 * c) = o; }
    LDS_WAIT(); asm volatile("" ::: "memory");
}

__device__ __forceinline__ void norm_row(const float* xrow, const f32x4 (&gg)[4], bf16* orow, int lane, f32x4 (&v)[4]) {
    const GAS f32x4* xr = (const GAS f32x4*)xrow + lane; float s = 0.f;
#pragma unroll
    for (int j = 0; j < 4; ++j) { v[j] = xr[64 * j]; s += (v[j].x * v[j].x + v[j].y * v[j].y) + (v[j].z * v[j].z + v[j].w * v[j].w); }
    const float rstd = 1.0f / sqrtf(wave_sum(s) * (1.f / DM) + EPS);
    GAS u32x2* o8 = (GAS u32x2*)orow + lane;
#pragma unroll
    for (int j = 0; j < 4; ++j) { v[j] = v[j] * rstd * gg[j]; u32x2 w; w.x = cvt_pk_bf16(v[j].x, v[j].y); w.y = cvt_pk_bf16(v[j].z, v[j].w); o8[64 * j] = w; }
}

__device__ __forceinline__ void raw_row(const float* xrow, bf16* orow, float* rs_out, int lane) {
    const GAS f32x4* xr = (const GAS f32x4*)xrow + lane; f32x4 v[4]; float s = 0.f;
#pragma unroll
    for (int j = 0; j < 4; ++j) { v[j] = xr[64 * j]; s += (v[j].x * v[j].x + v[j].y * v[j].y) + (v[j].z * v[j].z + v[j].w * v[j].w); }
    s = wave_sum(s);
    GAS u32x2* o8 = (GAS u32x2*)orow + lane;
#pragma unroll
    for (int j = 0; j < 4; ++j) { u32x2 w; w.x = cvt_pk_bf16(v[j].x, v[j].y); w.y = cvt_pk_bf16(v[j].z, v[j].w); o8[64 * j] = w; }
    if (lane == 0) *(GAS f32x4*)rs_out = (f32x4){s, 0.f, 0.f, 0.f};
}
__device__ __forceinline__ void ph_prologue(Frame& F, const float* x, const float* mem, const float* mn, const float* memw) {
    PH_IDS();
    const int gt = F.vcu * 512 + tid, NT = F.G * 512, gw = F.vcu * NWAVES + wave, NGW = F.G * NWAVES;
    { bf16* XB = (bf16*)(F.ws + WS_XN); float* RS0 = (float*)(F.ws + WS_RS);
      for (int m = gw; m < M; m += NGW) raw_row(x + (size_t)m * DM, XB + (size_t)m * DM, RS0 + (size_t)m * 4, lane); }
    { float* cs = (float*)(F.ws + WS_ROPE);
      const int f = gt & 31; const float ex = (float)(2 * f) / 64.0f; const float inv = (float)(1.0 / pow(10000.0, (double)ex));
      for (int i = gt; i < SEQ * 32; i += NT) { const int pos = i >> 5; const float ang = (float)pos * inv; float sn, cn; sincosf(ang, &sn, &cn);
          cs[i] = cn; cs[SEQ * 32 + i] = sn; } }
    { bf16* MEMH = (bf16*)(F.ws + WS_MEMH);
      for (int r = gw; r < 4 * 1024; r += NGW) { const int l = r >> 10, row = r & 1023; f32x4 gg[4], v[4];
#pragma unroll
          for (int j = 0; j < 4; ++j) gg[j] = ((const f32x4*)(mn + l * DM))[lane + 64 * j];
          norm_row(mem + (size_t)row * DM, gg, MEMH + (size_t)r * DM, lane, v); } }
    { LAS float* scr = (LAS float*)(F.lds + RING_OFF + wave * 16384); bf16* MW = (bf16*)(F.ws + WS_MEMW);
      for (int it = gw; it < 4 * 512; it += NGW) { const int l = it >> 9, r = it & 511, kb = r >> 5, nb = r & 31;
          tr_item(memw + (size_t)l * DM * DM, DM, 32 * nb, 64 * kb, MW + (size_t)l * DM * DM, DM, 32 * nb, scr, lane, 32, nullptr); } }
}
__device__ __forceinline__ void ph_memknorm(Frame& F, const float* memk_norm) {
    PH_IDS();
    const int gw = F.vcu * NWAVES + wave, NGW = F.G * NWAVES; bf16* KVm = (bf16*)(F.ws + WS_MEMKV);
    for (int idx = gw; idx < 4096 * 4; idx += NGW) { const int row = idx >> 2, h = idx & 3, l = row >> 10;
        bf16* p = KVm + (size_t)row * 1024 + h * 128 + lane * 2; const float* g = memk_norm + l * 128;
        const float a = bf2f(p[0]), b = bf2f(p[1]);
        const float rstd = 1.0f / sqrtf(wave_sum(a * a + b * b) * (1.f / 128.f) + EPS);
        *(GAS unsigned*)p = cvt_pk_bf16(a * rstd * g[lane * 2], b * rstd * g[lane * 2 + 1]); }
}
struct ConvPtrs { const float *g0, *u0, *d0, *g1, *u1, *d1, *wo, *gin, *min, *uq, *ukv, *n1, *n2, *nm; };
template <int MAP>
__device__ __forceinline__ void conv_job(Frame& F, const float* W, int ldw, int nkb, int nblk, bf16* dst, int K, int& rot, LAS float* scr, int wave, int lane, const float* gain) {
    const int NGW = F.G * NWAVES; int gw = F.vcu * NWAVES + wave - rot; if (gw < 0) gw += NGW;
    const int total = nkb * nblk;
    for (int r = gw; r < total; r += NGW) {
        const int kb = r / nblk, nb = r - kb * nblk; int scol = 32 * nb, drow = 32 * nb, nv = 32;
        if (MAP == 1) drow = 32 * ((nb >> 2) * 8 + (nb & 3));
        if (MAP == 2) drow = 32 * ((nb >> 2) * 8 + 4 + (nb & 3));
        if (MAP == 3) { scol = drow < 1024 ? drow : drow < 2048 ? drow + 1040 : drow < 3072 ? drow - 1024 : drow < 3584 ? drow + 16 : 2048; nv = drow < 3584 ? 32 : drow == 3584 ? 16 : 0; }
        if (MAP == 4) nv = drow >= MLA_IN ? 0 : 32;
        tr_item(W, ldw, scol, 64 * kb, dst, K, drow, scr, lane, nv, gain);
    }
    rot = (rot + total) % NGW;
}
__device__ __forceinline__ void conv_layer(Frame& F, int i, const ConvPtrs& cp) {
    PH_IDS();
    const int j = i >> 1; const bool gla = !(i & 1);
    LAS float* scr = (LAS float*)(F.lds + RING_OFF + wave * 16384);
    unsigned char* wb = F.ws + WS_WB; int rot = 0;
    conv_job<1>(F, cp.g0 + (size_t)i * DM * FF, FF, 16, 88, (bf16*)(wb + WB_GU0), DM, rot, scr, wave, lane, cp.n1 + i * DM);
    conv_job<2>(F, cp.u0 + (size_t)i * DM * FF, FF, 16, 88, (bf16*)(wb + WB_GU0), DM, rot, scr, wave, lane, cp.n1 + i * DM);
    conv_job<1>(F, cp.g1 + (size_t)i * DM * FF, FF, 16, 88, (bf16*)(wb + WB_GU1), DM, rot, scr, wave, lane, cp.n2 + i * DM);
    conv_job<2>(F, cp.u1 + (size_t)i * DM * FF, FF, 16, 88, (bf16*)(wb + WB_GU1), DM, rot, scr, wave, lane, cp.n2 + i * DM);
    conv_job<0>(F, cp.d0 + (size_t)i * FF * DM, DM, 44, 32, (bf16*)(wb + WB_D0), FF, rot, scr, wave, lane, nullptr);
    conv_job<0>(F, cp.d1 + (size_t)i * FF * DM, DM, 44, 32, (bf16*)(wb + WB_D1), FF, rot, scr, wave, lane, nullptr);
    conv_job<0>(F, cp.wo + (size_t)i * 1536 * DM, DM, 24, 32, (bf16*)(wb + WB_WO), 1536, rot, scr, wave, lane, nullptr);
    if (gla) conv_job<3>(F, cp.gin + (size_t)j * DM * GLA_IN, GLA_IN, 16, 120, (bf16*)(wb + WB_IN), DM, rot, scr, wave, lane, cp.nm + i * DM);
    else {
        conv_job<4>(F, cp.min + (size_t)j * DM * MLA_IN, MLA_IN, 16, 40, (bf16*)(wb + WB_IN), DM, rot, scr, wave, lane, cp.nm + i * DM);
        conv_job<0>(F, cp.uq + (size_t)j * 384 * QW, QW, 6, 48, (bf16*)(wb + WB_UQ), 384, rot, scr, wave, lane, nullptr);
        conv_job<0>(F, cp.ukv + (size_t)j * 256 * KVW, KVW, 4, 64, (bf16*)(wb + WB_UKV), 256, rot, scr, wave, lane, nullptr);
    }
}
__device__ __forceinline__ void ph_mla_rowprep(Frame& F, const float* gq, const float* gkv, const float* gkr, const bool dry = false) {
    PH_IDS();
    const int gw = F.vcu * NWAVES + wave, NGW = F.G * NWAVES;
    bf16* P = (bf16*)(F.ws + WS_PM); bf16* KR = (bf16*)(F.ws + WS_KR); const float* rope = (const float*)(F.ws + WS_ROPE);
    f32x4 ga[2], gb[2];
    { const float* g = lane < 48 ? gq + 8 * lane : gkv + 8 * (lane - 48); ga[0] = *(const f32x4*)g; ga[1] = *(const f32x4*)(g + 4); }
    { const float* g = lane < 16 ? gkv + 8 * (16 + lane) : gkr + 8 * ((lane - 16) & 7); gb[0] = *(const f32x4*)g; gb[1] = *(const f32x4*)(g + 4); }
    for (int m = gw; m < M; m += NGW) {
        bf16* p = P + (size_t)m * PM;
        const bf16x8 c0 = *(const bf16x8*)(p + 8 * lane);
        bf16x8 c1 = (bf16x8){0, 0, 0, 0, 0, 0, 0, 0}; if (lane < 24) c1 = *(const bf16x8*)(p + 512 + 8 * lane);
        float a[8], b[8]; float s0 = 0.f, s1 = 0.f;
#pragma unroll
        for (int e = 0; e < 8; ++e) { a[e] = bf2f((bf16)c0[e]); b[e] = bf2f((bf16)c1[e]); s0 += a[e] * a[e]; s1 += b[e] * b[e]; }
        const float sq = wave_sum(lane < 48 ? s0 : 0.f), skv = wave_sum((lane >= 48 ? s0 : 0.f) + (lane < 16 ? s1 : 0.f)), skr = wave_sum((lane >= 16 && lane < 24) ? s1 : 0.f);
        const float rq = 1.0f / sqrtf(sq * (1.f / 384.f) + EPS), rkv = 1.0f / sqrtf(skv * (1.f / 256.f) + EPS), rkr = 1.0f / sqrtf(skr * (1.f / 64.f) + EPS);
        const float r0 = lane < 48 ? rq : rkv, r1 = lane < 16 ? rkv : rkr;
        f32x4 x0, x1, y0, y1;
#pragma unroll
        for (int e = 0; e < 4; ++e) { x0[e] = a[e] * r0 * ga[0][e]; x1[e] = a[4 + e] * r0 * ga[1][e]; y0[e] = b[e] * r1 * gb[0][e]; y1[e] = b[4 + e] * r1 * gb[1][e]; }
        if (!dry) *(bf16x8*)(p + 8 * lane) = att::pack8(x0, x1);
        if (lane < 16 && !dry) *(bf16x8*)(p + 512 + 8 * lane) = att::pack8(y0, y1);
        const int ck = (lane - 16) & 7, pos = m % SEQ; const float* cp = rope + pos * 32 + 8 * (ck & 3); const float* sp = cp + SEQ * 32;
        const f32x4 cs0 = *(const f32x4*)cp, cs1 = *(const f32x4*)(cp + 4), sn0 = *(const f32x4*)sp, sn1 = *(const f32x4*)(sp + 4);
        f32x4 o0, o1;
#pragma unroll
        for (int e = 0; e < 4; ++e) { const float t0 = __shfl_xor(y0[e], 4), t1 = __shfl_xor(y1[e], 4);
            o0[e] = ck < 4 ? (y0[e] * cs0[e] - t0 * sn0[e]) : (t0 * sn0[e] + y0[e] * cs0[e]);
            o1[e] = ck < 4 ? (y1[e] * cs1[e] - t1 * sn1[e]) : (t1 * sn1[e] + y1[e] * cs1[e]); }
        if (lane >= 16 && lane < 24 && !dry) *(bf16x8*)(KR + (size_t)m * 64 + 8 * ck) = att::pack8(o0, o1);
    }
}
__device__ __forceinline__ void ph_mla_knorm(Frame& F, const float* gkn, const bool dry = false) {
    PH_IDS();
    const int gw = F.vcu * NWAVES + wave, NGW = F.G * NWAVES; bf16* KV = (bf16*)(F.ws + WS_KV);
    f32x4 g[4];
#pragma unroll
    for (int q = 0; q < 4; ++q) g[q] = *(const f32x4*)(gkn + (lane & 7) * 16 + 4 * q);
    for (int m = gw; m < M; m += NGW) {
        bf16* p = KV + (size_t)m * KVW + (lane >> 3) * 256 + (lane & 7) * 16;
        const bf16x8 c0 = *(const bf16x8*)p, c1 = *(const bf16x8*)(p + 8);
        float a[16]; float s = 0.f;
#pragma unroll
        for (int e = 0; e < 8; ++e) { a[e] = bf2f((bf16)c0[e]); a[8 + e] = bf2f((bf16)c1[e]); s += a[e] * a[e] + a[8 + e] * a[8 + e]; }
        s += __shfl_xor(s, 1); s += __shfl_xor(s, 2); s += __shfl_xor(s, 4);
        const float rstd = 1.0f / sqrtf(s * (1.f / 128.f) + EPS);
        f32x4 x[4];
#pragma unroll
        for (int q = 0; q < 4; ++q)
#pragma unroll
            for (int e = 0; e < 4; ++e) x[q][e] = a[4 * q + e] * rstd * g[q][e];
        if (!dry) { *(bf16x8*)p = att::pack8(x[0], x[1]); *(bf16x8*)(p + 8) = att::pack8(x[2], x[3]); }
    }
}
__device__ __forceinline__ float wave_absmax(const float* g, int n, int lane) {
    float m = fabsf(g[lane]); if (n > 64) m = fmaxf(m, fabsf(g[64 + lane]));
#pragma unroll
    for (int o = 1; o < 64; o <<= 1) m = fmaxf(m, __shfl_xor(m, o));
    return m;
}
__device__ __forceinline__ void ph_memattn(Frame& F, int layer, bool gla, const float* qgain, const float* kgain, const bool dry = false) {
    float bnd; { PH_IDS(); bnd = 0.08838834764831845f * 128.f * wave_absmax(qgain, 128, lane) * wave_absmax(kgain, 128, lane) * 1.03f; if (!(bnd < 40.f)) bnd = 0.f; }
    const bf16* memkv = (const bf16*)(F.ws + WS_MEMKV) + (size_t)layer * 1024 * 1024;
    const bf16* Qbase; bf16* Obase; int ldq, ldo;
    if (gla) { bf16* P = (bf16*)(F.ws + WS_PG); Qbase = P + PG_QM; Obase = P + PG_QM; ldq = PG; ldo = PG; }
    else { Qbase = (const bf16*)(F.ws + WS_PM) + PM_QM; Obase = F.OC + 1024; ldq = PM; ldo = OCW; }
    const int vcu = F.vcu, G = F.G, nblk = (512 - vcu + G - 1) / G;
    auto get = [=](int n, att::ABlk& d) { const int x = vcu + n * G, b = x >> 7, h = (x >> 5) & 3, qb = x & 31; const size_t row0 = (size_t)b * SEQ + 256 * qb;
        d.Q = Qbase + row0 * ldq + h * 128; d.O = Obase + row0 * ldo + h * 128; d.Kn = memkv + (size_t)b * NMEM * 1024 + h * 128; d.Kr = nullptr; d.V = d.Kn + 512; d.NT = 4; d.P0 = 0; };
    att::attn_blocks<0, false, 1>((LAS char*)F.lds, get, nblk, ldq, 1024, 1024, ldo, 0.08838834764831845f, bnd, qgain, nullptr, nullptr, dry);
}

__device__ __forceinline__ void ph_mla_attn(Frame& F, const float* gqn, const float* gqr, const float* gkn, const float* gkr, const bool dry = false) {
    float bnd; { PH_IDS(); bnd = 0.07216878364870322f * (128.f * wave_absmax(gqn, 128, lane) * wave_absmax(gkn, 128, lane) + 64.f * wave_absmax(gqr, 64, lane) * wave_absmax(gkr, 64, lane)) * 1.03f; if (!(bnd < 40.f)) bnd = 0.f; }
    const bf16* Qb = (const bf16*)(F.ws + WS_Q); const bf16* KVb = (const bf16*)(F.ws + WS_KV); const bf16* KRb = (const bf16*)(F.ws + WS_KR); bf16* OC = F.OC;
    const float* rope = (const float*)(F.ws + WS_ROPE);
    const int vcu = F.vcu, G = F.G, nblk = 2 * ((512 - vcu + G - 1) / G);
    auto get = [=](int n, att::ABlk& d) { const int x = vcu + (n >> 1) * G, pass = n & 1, bh = x >> 4, y = x & 15, b = bh >> 3, h = bh & 7, qb = pass ? y : 31 - y;
        const size_t row0 = (size_t)b * SEQ + 256 * qb;
        d.Q = Qb + row0 * QW + h * 192; d.Kn = KVb + (size_t)b * SEQ * KVW + h * 256; d.Kr = KRb + (size_t)b * SEQ * 64; d.V = d.Kn + 128; d.O = OC + row0 * OCW + h * 128; d.NT = 4 * (qb + 1); d.P0 = 256 * qb; };
    att::attn_blocks<4, true, 2>((LAS char*)F.lds, get, nblk, QW, KVW, KVW, OCW, 0.07216878364870322f, bnd, gqn, gqr, rope, dry);
}

constexpr int GCH = 128, GNU = 1024;
__device__ __forceinline__ void ph_gla_prep(Frame& F, const float* wa  , const float* ba  , const bool dry = false) {
    PH_IDS();
    const int u4 = wave >> 1, c = tid & 127;
    bf16* P = (bf16*)(F.ws + WS_PG); const float* ALOW = (const float*)(F.ws + WS_ALOW); float* GV = (float*)(F.ws + WS_GV);
    LAS float* EQ = (LAS float*)F.lds;
    LAS float* AL = (LAS float*)(F.lds + 131072);
    for (int ub = F.vcu * 4; ub < GNU; ub += F.G * 4) {
        const int unit = ub + u4, h = unit & 3; const size_t row0 = (size_t)(unit >> 2) * GCH;
        ((LAS f32x4*)AL)[tid] = ((const f32x4*)(ALOW + (size_t)(ub >> 2) * GCH * 16))[tid];
        float w[16];
#pragma unroll
        for (int k = 0; k < 16; ++k) w[k] = wa[k * 512 + h * 128 + c];
        const float bias = ba[h * 128 + c];
        float run = 0.f, bref = 0.f;
        __syncthreads();
#pragma unroll 1
        for (int hf = 0; hf < 2; ++hf) {
            float bc[64];
            const LAS float* al = AL + (64 * hf) * 16;
#pragma unroll
            for (int r = 0; r < 64; ++r) { float z = bias;
#pragma unroll
                for (int k = 0; k < 16; ++k) z += al[r * 16 + k] * w[k];
                const float ls = fminf(z, 0.f) - 0.6931471805599453f * __builtin_amdgcn_logf(1.0f + __builtin_amdgcn_exp2f(-1.4426950408889634f * fabsf(z)));
                run += ls * (1.f / 16.f); bc[r] = run; }
            if (hf == 0) bref = bc[63];
            LAS float* eqp = EQ + (size_t)(u4 * 64) * 128 + c;
#pragma unroll
            for (int r = 0; r < 64; ++r) eqp[r * 128] = __builtin_amdgcn_exp2f(1.4426950408889634f * (bc[r] - bref));
            __syncthreads();
            int tl = tid; asm volatile("" : "+v"(tl));
#pragma unroll
            for (int q8 = 0; q8 < 8; ++q8) { const int idx = tl + 512 * q8, us = idx >> 10, row = (idx >> 4) & 63, ch = idx & 15;
                const int un2 = ub + us, h2 = un2 & 3; const size_t rw = (size_t)(un2 >> 2) * GCH + 64 * hf + row;
                bf16* qp = P + rw * PG + PG_Q + h2 * 128 + ch * 8; bf16* kp = P + rw * PG + PG_K + h2 * 128 + ch * 8;
                const u32x4 qv = *(const u32x4*)qp, kv = *(const u32x4*)kp;
                const f32x4 e0 = *(const LAS f32x4*)(EQ + (size_t)(us * 64 + row) * 128 + ch * 8), e1 = *(const LAS f32x4*)(EQ + (size_t)(us * 64 + row) * 128 + ch * 8 + 4);
                u32x4 qo, ko;
#define GP2(xw, ea, eb, OUTQ) cvt_pk_bf16(__uint_as_float((xw) << 16) * (ea) * (OUTQ ? 0.08838834764831845f : 1.f), __uint_as_float((xw) & 0xffff0000u) * (eb) * (OUTQ ? 0.08838834764831845f : 1.f))
                qo.x = GP2(qv.x, e0[0], e0[1], true); qo.y = GP2(qv.y, e0[2], e0[3], true); qo.z = GP2(qv.z, e1[0], e1[1], true); qo.w = GP2(qv.w, e1[2], e1[3], true);
                const f32x4 i0 = {__builtin_amdgcn_rcpf(e0[0]), __builtin_amdgcn_rcpf(e0[1]), __builtin_amdgcn_rcpf(e0[2]), __builtin_amdgcn_rcpf(e0[3])}, i1 = {__builtin_amdgcn_rcpf(e1[0]), __builtin_amdgcn_rcpf(e1[1]), __builtin_amdgcn_rcpf(e1[2]), __builtin_amdgcn_rcpf(e1[3])};
                ko.x = GP2(kv.x, i0[0], i0[1], false); ko.y = GP2(kv.y, i0[2], i0[3], false); ko.z = GP2(kv.z, i1[0], i1[1], false); ko.w = GP2(kv.w, i1[2], i1[3], false);
#undef GP2
                if (!dry) { *(u32x4*)qp = qo; *(u32x4*)kp = ko; } }
            __syncthreads();
        }
        const float blast = run;
        float* gv = GV + (size_t)unit * 384 + c;
        if (!dry) { gv[0] = __builtin_amdgcn_exp2f(1.4426950408889634f * blast); gv[128] = __builtin_amdgcn_exp2f(1.4426950408889634f * (blast - bref)); gv[256] = __builtin_amdgcn_exp2f(1.4426950408889634f * bref); }
    }
}
#define GL_TRRD(dst, base, off) asm volatile("ds_read_b64_tr_b16 %0, %1 offset:%2" : "=&v"(dst) : "v"(base), "i"(off) : "memory")
#define GL_FRAG(out, base, d0, ks) do { att::s16x4 l_, h_; GL_TRRD(l_, base, (d0) * 512 + (ks) * 4096); GL_TRRD(h_, base, (d0) * 512 + (ks) * 4096 + 2048); \
        asm volatile("s_waitcnt lgkmcnt(0)" ::: "memory"); __builtin_amdgcn_sched_barrier(0); out = (bf16x8){l_[0], l_[1], l_[2], l_[3], h_[0], h_[1], h_[2], h_[3]}; } while (0)
#define GL_STAGE_V() do { const bf16* vp = P + (row0 + sr) * PG + PG_V + h * 256 + sc; \
        _Pragma("unroll") for (int q4 = 0; q4 < 4; ++q4) { const bf16x8 x0 = *(const bf16x8*)(vp + (size_t)(32 * q4) * PG), x1 = *(const bf16x8*)(vp + (size_t)(32 * q4) * PG + 128); \
            const int o_ = (q4 >> 1) * 32768 + ((q4 & 1) ? vst1 : vst0); *(LAS bf16x8*)(lds + o_) = x0; *(LAS bf16x8*)(lds + o_ + 16384) = x1; } } while (0)
__device__ __forceinline__ void ph_gla_u(Frame& F) {
    PH_IDS();
    const int r32 = lane & 31, hi = lane >> 5, sr = tid >> 4, sc = (tid & 15) * 8;
    const bf16* P = (const bf16*)(F.ws + WS_PG); bf16* US = (bf16*)(F.ws + WS_US); const float* GV = (const float*)(F.ws + WS_GV);
    LAS char* lds = (LAS char*)F.lds;
    const int vst0 = att::v_st(sr, sc), vst1 = att::v_st(32 + sr, sc);
    const int vbA = (int)(uintptr_t)lds + att::v_rd_base(lane) + (wave >> 2) * 16384 + (wave & 3) * 512, vbB = (int)(uintptr_t)lds + att::v_rd_base(lane) + 65536;
    for (int unit = F.vcu; unit < GNU; unit += F.G) {
        const int h = unit & 3; const size_t row0 = (size_t)(unit >> 2) * GCH;
        GL_STAGE_V();
        { const bf16* kp = P + (row0 + sr) * PG + PG_K + h * 128 + sc;
#pragma unroll
          for (int q4 = 0; q4 < 4; ++q4) { const bf16x8 x0 = *(const bf16x8*)(kp + (size_t)(32 * q4) * PG); *(LAS bf16x8*)(lds + 65536 + (q4 >> 1) * 16384 + ((q4 & 1) ? vst1 : vst0)) = x0; } }
        __syncthreads();
        att::f32x16 acc[4] = {};
#pragma unroll
        for (int jh = 0; jh < 2; ++jh)
#pragma unroll
            for (int ks = 0; ks < 4; ++ks) { bf16x8 a; GL_FRAG(a, vbA + jh * 32768, 0, ks);
#pragma unroll
                for (int nb = 0; nb < 4; ++nb) { bf16x8 b; GL_FRAG(b, vbB + jh * 16384, nb, ks); acc[nb] = __builtin_amdgcn_mfma_f32_32x32x16_bf16(a, b, acc[nb], 0, 0, 0); } }
        bf16* up = US + (size_t)unit * 32768 + (size_t)(wave * 32) * 128 + r32;
#pragma unroll
        for (int nb = 0; nb < 4; ++nb) { const float e2 = GV[(size_t)unit * 384 + 128 + nb * 32 + r32];
#pragma unroll
            for (int r = 0; r < 16; ++r) up[(size_t)att::crow(r, hi) * 128 + nb * 32] = f2bf(acc[nb][r] * e2); }
        __syncthreads();
    }
}
__device__ __forceinline__ void ph_gla_scan(Frame& F, const bool dry = false) {
    PH_IDS();
    bf16* US = (bf16*)(F.ws + WS_US); const float* GV = (const float*)(F.ws + WS_GV);
    for (int e = F.vcu * 512 + tid; e < 131072; e += F.G * 512) {
        const int dkq = e & 31, dv = (e >> 5) & 255, bh = e >> 13, b = bh >> 2, h = bh & 3;
        f32x4 S = (f32x4){0.f, 0.f, 0.f, 0.f};
        const size_t ustride = (size_t)4 * 32768;
        bf16* up = US + ((size_t)(b * 64) * 4 + h) * 32768 + (size_t)dv * 128 + dkq * 4;
        const float* gp = GV + ((size_t)(b * 64) * 4 + h) * 384 + dkq * 4;
        for (int n = 0; n < 64; n += 4) {
            u32x2 uu[4]; f32x4 dc[4], e1[4];
#pragma unroll
            for (int q = 0; q < 4; ++q) { uu[q] = *(const GAS u32x2*)(up + (size_t)(n + q) * ustride); dc[q] = *(const GAS f32x4*)(gp + (size_t)(n + q) * 4 * 384); e1[q] = *(const GAS f32x4*)(gp + (size_t)(n + q) * 4 * 384 + 256); }
#pragma unroll
            for (int q = 0; q < 4; ++q) {
                const f32x4 s1 = S * e1[q]; u32x2 w; w.x = cvt_pk_bf16(s1.x, s1.y); w.y = cvt_pk_bf16(s1.z, s1.w);
                if (!dry) *(GAS u32x2*)(up + (size_t)(n + q) * ustride) = w;
                f32x4 u; u.x = __uint_as_float(uu[q].x << 16); u.y = __uint_as_float(uu[q].x & 0xffff0000u); u.z = __uint_as_float(uu[q].y << 16); u.w = __uint_as_float(uu[q].y & 0xffff0000u);
                S = S * dc[q] + u; }
        }
    }
}
template <int B_> __device__ __forceinline__ bf16x8 gl_pk4(const att::f32x16& P) {
    const unsigned a0 = cvt_pk_bf16(P[B_ + 0], P[B_ + 1]), a1 = cvt_pk_bf16(P[B_ + 2], P[B_ + 3]), b0 = cvt_pk_bf16(P[B_ + 4], P[B_ + 5]), b1 = cvt_pk_bf16(P[B_ + 6], P[B_ + 7]);
    auto r0 = __builtin_amdgcn_permlane32_swap(a0, b0, false, false); auto r1 = __builtin_amdgcn_permlane32_swap(a1, b1, false, false);
    u32x4 w = {r0[0], r1[0], r0[1], r1[1]}; return __builtin_bit_cast(bf16x8, w);
}
__device__ __forceinline__ void ph_gla_out(Frame& F, const float* gout  , const bool dry = false) {
    PH_IDS();
    const int r32 = lane & 31, hi = lane >> 5, sr = tid >> 4, sc = (tid & 15) * 8, it = wave & 3, grp = wave >> 2;
    bf16* P = (bf16*)(F.ws + WS_PG); const bf16* US = (const bf16*)(F.ws + WS_US);
    constexpr int L_K = 65536, L_PART = 135168, L_RSTD = 136192, TP = 1040;
    LAS char* lds = (LAS char*)F.lds; LAS float* part = (LAS float*)(lds + L_PART); LAS float* rstd_l = (LAS float*)(lds + L_RSTD);
    const int vst0 = att::v_st(sr, sc), vst1 = att::v_st(32 + sr, sc);
    const int vb = (int)(uintptr_t)lds + att::v_rd_base(lane) + grp * 16384;
    int kbase[8];
#pragma unroll
    for (int d0 = 0; d0 < 8; ++d0) kbase[d0] = (int)(uintptr_t)lds + L_K + KSWZ(r32, 2 * d0 + hi);
    float g4[4];
#pragma unroll
    for (int blk = 0; blk < 4; ++blk) g4[blk] = gout[grp * 128 + blk * 32 + r32];
    for (int unit = F.vcu; unit < GNU; unit += F.G) {
        const int h = unit & 3; const size_t row0 = (size_t)(unit >> 2) * GCH;
        GL_STAGE_V();
        { const bf16* kp = P + (row0 + sr) * PG + PG_K + h * 128 + sc;
#pragma unroll
          for (int q4 = 0; q4 < 4; ++q4) { const bf16x8 x0 = *(const bf16x8*)(kp + (size_t)(32 * q4) * PG); const int row = sr + 32 * q4; *(LAS bf16x8*)(lds + L_K + KSWZ(row, tid & 15)) = x0; } }
        bf16x8 qr[8];
        { const bf16* qp = P + (row0 + 32 * it + r32) * PG + PG_Q + h * 128 + hi * 8;
#pragma unroll
          for (int d0 = 0; d0 < 8; ++d0) qr[d0] = *(const bf16x8*)(qp + d0 * 16); }
        const bf16* sp = US + (size_t)unit * 32768 + (size_t)(grp * 128 + r32) * 128 + hi * 8;
        bf16x8 ub[8];
#pragma unroll
        for (int ks = 0; ks < 2; ++ks)
#pragma unroll
            for (int blk = 0; blk < 4; ++blk) ub[ks * 4 + blk] = *(const bf16x8*)(sp + (size_t)(blk * 32) * 128 + ks * 16);
        __syncthreads();
        att::f32x16 o[4] = {};
#define GL_KRD(dst, addr, off) asm volatile("ds_read_b128 %0, %1 offset:%2" : "=&v"(dst) : "v"(addr), "i"(off) : "memory")
#define GL_JT(jt) do { att::f32x16 p = {}; bf16x8 kf[8]; \
            _Pragma("unroll") for (int d0 = 0; d0 < 8; ++d0) GL_KRD(kf[d0], kbase[d0], (jt) * 8192); \
            asm volatile("s_waitcnt lgkmcnt(0)" : "+v"(kf[0]), "+v"(kf[1]), "+v"(kf[2]), "+v"(kf[3]), "+v"(kf[4]), "+v"(kf[5]), "+v"(kf[6]), "+v"(kf[7]) :: "memory"); __builtin_amdgcn_sched_barrier(0); \
            _Pragma("unroll") for (int d0 = 0; d0 < 8; ++d0) p = __builtin_amdgcn_mfma_f32_32x32x16_bf16(kf[d0], qr[d0], p, 0, 0, 0); \
            __builtin_amdgcn_sched_barrier(0); \
            att::s16x4 vl[8], vh[8]; \
            _Pragma("unroll") for (int f = 0; f < 8; ++f) { GL_TRRD(vl[f], vb + ((jt) >> 1) * 32768, (f >> 1) * 512 + (2 * ((jt) & 1) + (f & 1)) * 4096); GL_TRRD(vh[f], vb + ((jt) >> 1) * 32768, (f >> 1) * 512 + (2 * ((jt) & 1) + (f & 1)) * 4096 + 2048); } \
            if ((jt) == it) { _Pragma("unroll") for (int r = 0; r < 16; ++r) if (att::crow(r, hi) > r32) p[r] = 0.f; } \
            const bf16x8 paA = gl_pk4<0>(p), paB = gl_pk4<8>(p); \
            asm volatile("s_waitcnt lgkmcnt(0)" : "+v"(vl[0]), "+v"(vh[0]), "+v"(vl[1]), "+v"(vh[1]), "+v"(vl[2]), "+v"(vh[2]), "+v"(vl[3]), "+v"(vh[3]), "+v"(vl[4]), "+v"(vh[4]), "+v"(vl[5]), "+v"(vh[5]), "+v"(vl[6]), "+v"(vh[6]), "+v"(vl[7]), "+v"(vh[7]) :: "memory"); __builtin_amdgcn_sched_barrier(0); \
            _Pragma("unroll") for (int blk = 0; blk < 4; ++blk) { \
                o[blk] = __builtin_amdgcn_mfma_f32_32x32x16_bf16(paA, (bf16x8){vl[2 * blk][0], vl[2 * blk][1], vl[2 * blk][2], vl[2 * blk][3], vh[2 * blk][0], vh[2 * blk][1], vh[2 * blk][2], vh[2 * blk][3]}, o[blk], 0, 0, 0); \
                o[blk] = __builtin_amdgcn_mfma_f32_32x32x16_bf16(paB, (bf16x8){vl[2 * blk + 1][0], vl[2 * blk + 1][1], vl[2 * blk + 1][2], vl[2 * blk + 1][3], vh[2 * blk + 1][0], vh[2 * blk + 1][1], vh[2 * blk + 1][2], vh[2 * blk + 1][3]}, o[blk], 0, 0, 0); } } while (0)
        GL_JT(0);
        if (it >= 1) GL_JT(1);
        if (it >= 2) GL_JT(2);
        if (it >= 3) GL_JT(3);
#undef GL_JT
#undef GL_KRD
#pragma unroll
        for (int kp = 0; kp < 4; ++kp) {
            bf16x8 un[8];
            if (kp < 3) {
#pragma unroll
                for (int ks = 0; ks < 2; ++ks)
#pragma unroll
                    for (int blk = 0; blk < 4; ++blk) un[ks * 4 + blk] = *(const bf16x8*)(sp + (size_t)(blk * 32) * 128 + (2 * kp + 2 + ks) * 16);
            }
#pragma unroll
            for (int ks = 0; ks < 2; ++ks)
#pragma unroll
                for (int blk = 0; blk < 4; ++blk) o[blk] = __builtin_amdgcn_mfma_f32_32x32x16_bf16(qr[2 * kp + ks], ub[ks * 4 + blk], o[blk], 0, 0, 0);
            if (kp < 3) {
#pragma unroll
                for (int e = 0; e < 8; ++e) ub[e] = un[e];
            }
        }
        int tl = tid; asm volatile("" : "+v"(tl));
        const int lnb = tl & 63, r32b = tl & 31, hib = (tl >> 5) & 1;
        u32x4 rg[8];
#pragma unroll
        for (int q8 = 0; q8 < 8; ++q8) { const int idx = tl + 512 * q8; rg[q8] = *(const u32x4*)(P + (row0 + (idx >> 5)) * PG + PG_R + h * 256 + (idx & 31) * 8); }
        float v16[16];
#pragma unroll
        for (int r = 0; r < 16; ++r) v16[r] = (o[0][r] * o[0][r] + o[1][r] * o[1][r]) + (o[2][r] * o[2][r] + o[3][r] * o[3][r]);
        float w8[8], w4[4], w2[2], w1;
        { const bool up = (lnb & 16) != 0;
#pragma unroll
          for (int q = 0; q < 8; ++q) { const float keep = up ? v16[8 + q] : v16[q], send = up ? v16[q] : v16[8 + q]; w8[q] = keep + __shfl_xor(send, 16); } }
        { const bool up = (lnb & 8) != 0;
#pragma unroll
          for (int q = 0; q < 4; ++q) { const float keep = up ? w8[4 + q] : w8[q], send = up ? w8[q] : w8[4 + q]; w4[q] = keep + __shfl_xor(send, 8); } }
        { const bool up = (lnb & 4) != 0;
#pragma unroll
          for (int q = 0; q < 2; ++q) { const float keep = up ? w4[2 + q] : w4[q], send = up ? w4[q] : w4[2 + q]; w2[q] = keep + __shfl_xor(send, 4); } }
        { const bool up = (lnb & 2) != 0; const float keep = up ? w2[1] : w2[0], send = up ? w2[0] : w2[1]; w1 = keep + __shfl_xor(send, 2); }
        w1 += __shfl_xor(w1, 1);
        if ((lnb & 1) == 0) part[(it * 32 + att::crow(r32b >> 1, hib)) * 2 + grp] = w1;
        __syncthreads();
        if (tl < 128) rstd_l[tl] = 1.0f / sqrtf((part[tl * 2] + part[tl * 2 + 1]) * (1.f / 256.f) + EPS);
        __syncthreads();
#pragma unroll
        for (int r = 0; r < 16; ++r) { const int i = 32 * it + att::crow(r, hib); const float rs = rstd_l[i];
            LAS float* tp = (LAS float*)(lds + i * TP) + grp * 128 + r32b;
#pragma unroll
            for (int blk = 0; blk < 4; ++blk) tp[blk * 32] = o[blk][r] * rs * g4[blk]; }
        __syncthreads();
#pragma unroll
        for (int q8 = 0; q8 < 8; ++q8) { const int idx = tl + 512 * q8, row = idx >> 5, ch = idx & 31;
            const f32x4 t0 = *(const LAS f32x4*)(lds + row * TP + ch * 32), t1 = *(const LAS f32x4*)(lds + row * TP + ch * 32 + 16); const u32x4 gv = rg[q8]; u32x4 w;
#define GL_O2(ta, tb, gw) cvt_pk_bf16((ta) * fast_silu(__uint_as_float((gw) << 16)), (tb) * fast_silu(__uint_as_float((gw) & 0xffff0000u)))
            w.x = GL_O2(t0[0], t0[1], gv.x); w.y = GL_O2(t0[2], t0[3], gv.y); w.z = GL_O2(t1[0], t1[1], gv.z); w.w = GL_O2(t1[2], t1[3], gv.w);
#undef GL_O2
            if (!dry) *(u32x4*)(P + (row0 + row) * PG + PG_V + h * 256 + ch * 8) = w; }
        __syncthreads();
    }
}
#undef GL_STAGE_V

constexpr int PID_END = 16 * 9;
#ifndef PROBE_PID
#define PROBE_PID (-1)
#endif
#ifndef PROBE_N
#define PROBE_N 1
#endif
#ifndef PROBE_PID2
#define PROBE_PID2 (-1)
#endif
#ifndef PROBE_PID3
#define PROBE_PID3 (-1)
#endif
#define NREP(k) ((((k) == PROBE_PID) || ((k) == PROBE_PID2) || ((k) == PROBE_PID3)) ? PROBE_N : 1)
#ifndef GU_ALIGN
#define GU_ALIGN true
#endif
#ifndef REV_GU
#define REV_GU 0
#endif
#ifndef REV_DOWN
#define REV_DOWN 1
#endif
#ifndef REV_OUT
#define REV_OUT 1
#endif
#ifndef REV_IN
#define REV_IN 0
#endif
#define REP(k) for (int rep_ = 0; rep_ < NREP(k); ++rep_)
#define DRY(k) (rep_ + 1 < NREP(k))
__global__ void __launch_bounds__(NWAVES * 64, 2) mk_fwd(MArgs args) {
    extern __shared__ __attribute__((aligned(16))) unsigned char lds_raw[];
    Frame F;
    F.lds = (LAS unsigned char*)lds_raw;
    F.G = gridDim.x; { const int bx = blockIdx.x; F.vcu = (F.G % 8 == 0) ? (bx % 8) * (F.G / 8) + bx / 8 : bx; }
    F.X = args.out; F.ws = args.ws; F.OC = (bf16*)args.out;
    volatile LAS unsigned* MISC = (volatile LAS unsigned*)(F.lds + MISC_OFF);
    for (int u = threadIdx.x; u < 128; u += NWAVES * 64) MISC[u] = 0u;
    __syncthreads();
    XcdBarrier bar = xcd_barrier_post((unsigned*)(F.ws + WS_CTL) + CW_BAR + args.region * XCD_BAR_WORDS, MISC + 8);
    const int lo = args.lo, hi = args.hi;
#define IN(k) (lo <= (k) && (k) < hi)
#ifdef TGRP
    unsigned long long tph_prev = __builtin_amdgcn_s_memrealtime(), tph_acc = 0; int tph_gla = 0;
#define TSLOT(k) ((k) < 16 ? 16 + (k) : ((k) & 15))
#define TSEL(k) (TGRP == 1 ? (tph_gla && TSLOT(k) >= 2 && TSLOT(k) <= 5) : TGRP == 2 ? (!tph_gla && (TSLOT(k) == 2 || TSLOT(k) == 4)) : TGRP == 3 ? (TSLOT(k) >= 16 || TSLOT(k) == 7) : TGRP == 4 ? (!tph_gla && TSLOT(k) == 5) : \
                 TGRP == 5 ? (TSLOT(k) == 1 || TSLOT(k) == 6 || (!tph_gla && TSLOT(k) == 3)) : TGRP == 6 ? (TSLOT(k) == 9 || TSLOT(k) == 10) : TGRP >= 32 ? (TSLOT(k) == TGRP - 32 && (TGLA < 0 || tph_gla == TGLA)) : false)
#ifndef TGLA
#define TGLA (-1)
#endif
#define SEAM(k) do { if ((k) + 1 < hi) xcd_barrier(bar); { const unsigned long long tn_ = __builtin_amdgcn_s_memrealtime(); if (TSEL(k)) tph_acc += tn_ - tph_prev; tph_prev = tn_; } } while (0)
#else
#define SEAM(k) do { if ((k) + 1 < hi) xcd_barrier(bar); } while (0)
#endif
    unsigned char* ws = F.ws; unsigned char* wb = ws + WS_WB;

    LAS unsigned char* rstab = F.lds + XTRA_OFF;
    float* RS = (float*)(ws + WS_RS); LAS float* rspart = (LAS float*)(F.lds + XTRA_OFF + 8192);
#define OPQ(k) ({ const float* p_ = args.in[k]; asm volatile("" : "+s"(p_)); p_; })
#define CONV(layer) do { const ConvPtrs cp{OPQ(3), OPQ(4), OPQ(5), OPQ(7), OPQ(8), OPQ(9), OPQ(11), OPQ(16), OPQ(20), OPQ(23), OPQ(24), OPQ(2), OPQ(6), OPQ(10)}; conv_layer(F, (layer), cp); } while (0)

    if (IN(0)) { REP(0) { ph_prologue(F, args.in[0], args.in[1], args.in[12], args.in[13]); CONV(0); } SEAM(0); }
    if (IN(1)) {
        pg8::Gemm g{(const bf16*)(ws + WS_MEMH), (const bf16*)(ws + WS_MEMW), 4096, 4096, DM, DM, DM}; pg8::DiagOrder S{F.G, (int)blockIdx.x, 4};
        pg8::EpiBf16<false> E{(bf16*)(ws + WS_MEMKV), 1024, 3};
        pg8::gemm_phase<pg8::EpiBf16<false>, pg8::DiagOrder, PG8_ALIGN, PG8_SP2>(F.lds + RING_OFF, g, S, E);
        SEAM(1);
    }
    if (IN(2)) { ph_memknorm(F, args.in[15]); SEAM(2); }

    for (int it = 0; it < 8; ++it) {
        const int pb = 16 * (it + 1), i = it >> 1, half = it & 1, j = i >> 1;
        if (pb + 16 <= lo || pb >= hi) continue;
        if (half) {
            const bool gla = !(i & 1);
#ifdef TGRP
            tph_gla = gla ? 1 : 0;
#endif
            if (IN(pb + 1)) REP(pb + 1) {
                if (gla) {
                    pg8::Gemm g{(const bf16*)(ws + WS_XN), (const bf16*)(wb + WB_IN), M, 3840, DM, DM, DM}; pg8::StaticOrder S; S.init(M, 3840, F.G, (int)blockIdx.x, REV_IN);
                    pg8::EpiGlaIn E{(bf16*)(ws + WS_PG), (float*)(ws + WS_ALOW)};
                    pg8::gemm_phase<pg8::EpiGlaIn, pg8::StaticOrder, PG8_ALIGN, PG8_SP2>(F.lds + RING_OFF, g, S, E, RS + (size_t)(3 * i + 1) * 4 * M, rstab);
                } else {
                    pg8::Gemm g{(const bf16*)(ws + WS_XN), (const bf16*)(wb + WB_IN), M, PM, DM, DM, DM}; pg8::StaticOrder S; S.init(M, PM, F.G, (int)blockIdx.x, REV_IN);
                    pg8::EpiBf16<true> E{(bf16*)(ws + WS_PM), PM, 0x7fffffff};
                    pg8::gemm_phase<pg8::EpiBf16<true>, pg8::StaticOrder, PG8_ALIGN, PG8_SP2>(F.lds + RING_OFF, g, S, E, RS + (size_t)(3 * i + 1) * 4 * M, rstab);
                }
                if (rep_ + 1 == NREP(pb + 1)) SEAM(pb + 1);
            }
            if (gla) {
                if (IN(pb + 2)) { REP(pb + 2) { ph_gla_prep(F, args.in[17] + (size_t)j * 16 * 512, args.in[18] + j * 512, DRY(pb + 2)); ph_memattn(F, i, true, args.in[14] + i * 128, args.in[15] + i * 128, DRY(pb + 2)); } SEAM(pb + 2); }
                if (IN(pb + 3)) { REP(pb + 3) ph_gla_u(F); SEAM(pb + 3); }
                if (IN(pb + 4)) { REP(pb + 4) ph_gla_scan(F, DRY(pb + 4)); SEAM(pb + 4); }
                if (IN(pb + 5)) { REP(pb + 5) ph_gla_out(F, args.in[19] + j * 256, DRY(pb + 5)); SEAM(pb + 5); }
            }
            if (IN(pb + 2) && !gla) { REP(pb + 2) { ph_mla_rowprep(F, args.in[21] + j * 384, args.in[22] + j * 256, args.in[28] + j * 64, DRY(pb + 2)); ph_memattn(F, i, false, args.in[14] + i * 128, args.in[15] + i * 128, DRY(pb + 2)); } SEAM(pb + 2); }
            if (IN(pb + 3) && !gla) REP(pb + 3) {
                int kq_ = 384, kkv_ = 256; asm volatile("" : "+s"(kq_), "+s"(kkv_));
                { pg8::Gemm g{(const bf16*)(ws + WS_PM) + PM_CQ, (const bf16*)(wb + WB_UQ), M, QW, kq_, PM, 384}; pg8::StaticOrder S; S.init(M, QW, F.G, (int)blockIdx.x);
                  pg8::EpiBf16<false> E{(bf16*)(ws + WS_Q), QW, 0x7fffffff};
                  pg8::gemm_phase<pg8::EpiBf16<false>, pg8::StaticOrder, PG8_ALIGN, PG8_SP2>(F.lds + RING_OFF, g, S, E); }
                { pg8::Gemm g{(const bf16*)(ws + WS_PM) + PM_CKV, (const bf16*)(wb + WB_UKV), M, KVW, kkv_, PM, 256}; pg8::StaticOrder S; S.init(M, KVW, F.G, (int)blockIdx.x);
#ifdef KV_FUSED
                  pg8::EpiKV E{(bf16*)(ws + WS_KV), KVW, args.in[27] + j * 128, rspart};
                  pg8::gemm_phase<pg8::EpiKV, pg8::StaticOrder, true, PG8_SP2>(F.lds + RING_OFF, g, S, E); }
#else
                  pg8::EpiBf16<false> E{(bf16*)(ws + WS_KV), KVW, 0x7fffffff};
                  pg8::gemm_phase<pg8::EpiBf16<false>, pg8::StaticOrder, PG8_ALIGN, PG8_SP2>(F.lds + RING_OFF, g, S, E); }
#endif
                if (rep_ + 1 == NREP(pb + 3)) SEAM(pb + 3);
            }
#ifndef KV_FUSED
            if (IN(pb + 4) && !gla) { REP(pb + 4) ph_mla_knorm(F, args.in[27] + j * 128, DRY(pb + 4)); SEAM(pb + 4); }
#endif
            if (IN(pb + 5) && !gla) { REP(pb + 5) ph_mla_attn(F, args.in[25] + j * 128, args.in[26] + j * 64, args.in[27] + j * 128, args.in[28] + j * 64, DRY(pb + 5)); SEAM(pb + 5); }
            if (IN(pb + 6)) {
                pg8::Gemm g{gla ? (const bf16*)(ws + WS_PG) + PG_V : (const bf16*)F.OC, (const bf16*)(wb + WB_WO), M, DM, 1536, gla ? PG : OCW, 1536};
                pg8::StaticOrder S; S.init(M, DM, F.G, (int)blockIdx.x, REV_OUT);
                REP(pb + 6) { pg8::EpiResid E{(bf16*)(ws + WS_XN), nullptr, RS + (size_t)(3 * i + 2) * 4 * M, rspart, DM, rep_ ? 0.0f : 1.0f};
                pg8::gemm_phase<pg8::EpiResid, pg8::StaticOrder, PG8_ALIGN, PG8_SP2>(F.lds + RING_OFF, g, S, E); }
                SEAM(pb + 6);
            }
        }
        if (IN(pb + 7) && !half && it > 0) { REP(pb + 7) CONV(i); SEAM(pb + 7); }
        if (IN(pb + 9)) {
            pg8::Gemm g{(const bf16*)(ws + WS_XN), (const bf16*)(wb + (half ? WB_GU1 : WB_GU0)), M, 2 * FF, DM, DM, DM}; pg8::StaticOrder S; S.init(M, 2 * FF, F.G, (int)blockIdx.x, REV_GU);
            pg8::EpiSwiGLU E{(bf16*)(ws + WS_H), FF};
#ifndef DN_SKIP
#define DN_SKIP 0
#endif
#ifdef GU_PK
#ifndef GU_SKIP
#define GU_SKIP 0
#endif
            REP(pb + 9) { pg8::Gemm g2 = g; if (DRY(pb + 9)) g2.K = GU_PK; pg8::gemm_phase<pg8::EpiSwiGLU, pg8::StaticOrder, GU_ALIGN, PG8_SP2>(F.lds + RING_OFF, g2, S, E, RS + (size_t)(3 * i + (half ? 2 : 0)) * 4 * M, rstab, GU_SKIP && DRY(pb + 9)); }
#else
            REP(pb + 9) pg8::gemm_phase<pg8::EpiSwiGLU, pg8::StaticOrder, GU_ALIGN, PG8_SP2>(F.lds + RING_OFF, g, S, E, RS + (size_t)(3 * i + (half ? 2 : 0)) * 4 * M, rstab);
#endif
            SEAM(pb + 9);
        }
        if (IN(pb + 10)) {
            pg8::Gemm g{(const bf16*)(ws + WS_H), (const bf16*)(wb + (half ? WB_D1 : WB_D0)), M, DM, FF, FF, FF}; pg8::StaticOrder S; S.init(M, DM, F.G, (int)blockIdx.x, REV_DOWN);
            const bool lastp = (it == 7);
            REP(pb + 10) { pg8::EpiResid E{(bf16*)(ws + WS_XN), lastp ? F.X : nullptr, RS + (size_t)(half ? 3 * (i + 1) : 3 * i + 1) * 4 * M, rspart, DM, rep_ ? 0.0f : 0.5f};
            pg8::gemm_phase<pg8::EpiResid, pg8::StaticOrder, PG8_ALIGN, PG8_SP2>(F.lds + RING_OFF, g, S, E, nullptr, nullptr, DN_SKIP && rep_ > 0); }
            SEAM(pb + 10);
        }
    }
#ifdef TGRP
    if (blockIdx.x == 0 && threadIdx.x == 0) { const unsigned long long s0 = __builtin_amdgcn_s_memrealtime(); while (__builtin_amdgcn_s_memrealtime() - s0 < 4ull * tph_acc) __builtin_amdgcn_s_sleep(8); }
#endif
#undef OPQ
#undef CONV
#undef IN
#undef SEAM
}
#ifndef FAST_GLA
#define FAST_GLA 0
#endif
#ifndef FAST_MLA_PREP
#define FAST_MLA_PREP 0
#endif
#ifndef FAST_MLA_ATT
#define FAST_MLA_ATT 0
#endif
extern "C" void kernel_launch(void* const* d_in, const int* in_sizes, int n_in, void* d_out, int out_size, void* d_ws, size_t ws_size, hipStream_t stream) {
    static int grid = 0;
    if (grid == 0) {
        if (n_in != 29 || out_size != M * DM || ws_size < WS_END) { fprintf(stderr, "kernel_launch: unexpected shapes (n_in %d out %d ws %zu)\n", n_in, out_size, ws_size); grid = -1; return; }
        int dev = 0, cus = 0, per_cu = 0;
        if (hipGetDevice(&dev) != hipSuccess || hipDeviceGetAttribute(&cus, hipDeviceAttributeMultiprocessorCount, dev) != hipSuccess) { grid = -1; return; }
        if (hipFuncSetAttribute((const void*)mk_fwd, hipFuncAttributeMaxDynamicSharedMemorySize, LDS_BYTES) != hipSuccess) { fprintf(stderr, "kernel_launch: hipFuncSetAttribute failed\n"); grid = -1; return; }
        if (hipOccupancyMaxActiveBlocksPerMultiprocessor(&per_cu, (const void*)mk_fwd, NWAVES * 64, LDS_BYTES) != hipSuccess || per_cu < 1)
            fprintf(stderr, "kernel_launch: note: occupancy query reports %d workgroups per CU\n", per_cu);
        (void)hipGetLastError();
        grid = cus;
    }
    if (grid < 0) return;
    const float* mem = (const float*)d_in[1]; (void)mem;
    const float* memq_norm = (const float*)d_in[14];
    const float* gla_w_alpha = (const float*)d_in[17]; const float* gla_b_alpha = (const float*)d_in[18]; const float* gla_out_norm = (const float*)d_in[19];
    const float* mla_q_norm = (const float*)d_in[21]; const float* mla_kv_norm = (const float*)d_in[22];
    const float* mla_qn = (const float*)d_in[25]; const float* mla_qr = (const float*)d_in[26]; const float* mla_kn = (const float*)d_in[27]; const float* mla_kr = (const float*)d_in[28];
    unsigned char* ws = (unsigned char*)d_ws;
    float* ROPE = (float*)(ws + WS_ROPE); bf16* MEMKV = (bf16*)(ws + WS_MEMKV); float* ALOW = (float*)(ws + WS_ALOW);
    bf16* KR = (bf16*)(ws + WS_KR); bf16* PGb = (bf16*)(ws + WS_PG); float* ALPHA = (float*)(ws + WS_US);
    bf16* OC = (bf16*)d_out; bf16* PMb = (bf16*)(ws + WS_PM); bf16* Qb = (bf16*)(ws + WS_Q); bf16* KVb = (bf16*)(ws + WS_KV);

    (void)hipMemsetAsync(ws + WS_CTL, 0, CTL_ZERO_BYTES, stream);
    MArgs a{};
    for (int k = 0; k < 29; ++k) a.in[k] = (const float*)d_in[k];
    a.out = (float*)d_out; a.ws = ws;
    int region = 0;
    auto mk = [&](int lo, int hi) { if (lo >= hi) return; a.lo = lo; a.hi = hi; a.region = region++; a.pad = 0; hipLaunchKernelGGL(mk_fwd, dim3(grid), dim3(NWAVES * 64), LDS_BYTES, stream, a); };
    int cur_lo = 0;
    for (int it = 1; it < 8; it += 2) {
        const int pb = 16 * (it + 1), i = it >> 1, j = i >> 1; const bool gla = !(i & 1);
        const bf16* memkv = MEMKV + (size_t)i * 1024 * 1024;
        if (gla) {
            if (!FAST_GLA) {
                mk(cur_lo, pb + 2);
                nv_gla_alpha<<<M * 512 / 256, 256, 0, stream>>>(ALOW, gla_w_alpha + (size_t)j * 16 * 512, gla_b_alpha + j * 512, ALPHA);
                nv_attn<128, false><<<dim3(SEQ / 64, 4, BATCH), 64, 0, stream>>>(PGb + PG_QM, PG, 128, memkv, 1024, 128, nullptr, 0, memkv + 512, 1024, 128, PGb + PG_QM, PG, 128, 4, SEQ, NMEM, 0.08838834764831845f, memq_norm + i * 128);
                nv_gla_rec<<<16, 256, 0, stream>>>(PGb, ALPHA, gla_out_norm + j * 256);
                cur_lo = pb + 6;
            }
        } else {
            if (!FAST_MLA_PREP) {
                mk(cur_lo, pb + 2);
                nv_attn<128, false><<<dim3(SEQ / 64, 4, BATCH), 64, 0, stream>>>(PMb + PM_QM, PM, 128, memkv, 1024, 128, nullptr, 0, memkv + 512, 1024, 128, OC + 1024, OCW, 128, 4, SEQ, NMEM, 0.08838834764831845f, memq_norm + i * 128);
                nv_mla_rowprep<<<M / 4, 256, 0, stream>>>(PMb, mla_q_norm + j * 384, mla_kv_norm + j * 256, mla_kr + j * 64, ROPE, KR);
                cur_lo = pb + 3;
            }
            if (!FAST_MLA_ATT) {
                mk(cur_lo, pb + 4);
                nv_mla_headprep<<<M * 8 / 4, 256, 0, stream>>>(Qb, KVb, mla_qn + j * 128, mla_qr + j * 64, mla_kn + j * 128, ROPE);
                nv_attn<192, true><<<dim3(SEQ / 64, 8, BATCH), 64, 0, stream>>>(Qb, QW, 192, KVb, KVW, 256, KR, 64, KVb + 128, KVW, 256, OC, OCW, 128, 8, SEQ, SEQ, 0.07216878364870322f, nullptr);
                cur_lo = pb + 6;
            }
        }
    }
    mk(cur_lo, PID_END);
}
```

```cpp
#define FAST_GLA 1
#define FAST_MLA_PREP 1
#define FAST_MLA_ATT 1
#define KV_FUSED 1
#define ATT_STAGGER 0
#include <hip/hip_runtime.h>
#include <cstdio>
#include <cstdint>

typedef unsigned short bf16;
typedef short bf16x8 __attribute__((ext_vector_type(8)));
typedef float f32x4 __attribute__((ext_vector_type(4)));

constexpr int BATCH = 4, SEQ = 8192, DM = 1024, DEPTH = 4, NMEM = 256, FF = 2816;
constexpr int M = BATCH * SEQ;
constexpr float EPS = 1e-6f;
constexpr int GLA_IN = 3600, MLA_IN = 1216;
constexpr int PG = 3584;
constexpr int PG_Q = 0, PG_K = 512, PG_R = 1024, PG_V = 2048, PG_QM = 3072;
constexpr int PM = 1280;
constexpr int PM_CQ = 0, PM_CKV = 384, PM_KR = 640, PM_QM = 704;
constexpr int QW = 1536, KVW = 2048, OCW = 1536;

constexpr size_t MiB = 1u << 20;
constexpr size_t WS_CTL = 0;
constexpr size_t WS_ROPE = 28 * MiB;
constexpr size_t WS_MEMKV = 3 * MiB;
constexpr size_t WS_MEMH = 11 * MiB;
constexpr size_t WS_ALOW = 19 * MiB;
constexpr size_t WS_GV = 21 * MiB;
constexpr size_t WS_KR = 24 * MiB;
constexpr size_t WS_WB = 32 * MiB;
constexpr size_t WS_XN = 84 * MiB;
constexpr size_t WS_BIG = 148 * MiB;
constexpr size_t WS_H = WS_BIG;
constexpr size_t WS_PG = WS_BIG;
constexpr size_t WS_US = 372 * MiB;
constexpr size_t WS_PM = 180 * MiB;
constexpr size_t WS_Q = 260 * MiB;
constexpr size_t WS_KV = 356 * MiB;
constexpr size_t WS_END = 500 * MiB;

__device__ __forceinline__ float bf2f(bf16 b) { return __uint_as_float(((unsigned)b) << 16); }
__device__ __forceinline__ bf16 f2bf(float f) { unsigned u = __float_as_uint(f); return (bf16)((u + 0x7fffu + ((u >> 16) & 1u)) >> 16); }
__device__ __forceinline__ float wave_sum(float v) {
#pragma unroll
    for (int o = 1; o < 64; o <<= 1) v += __shfl_xor(v, o);
    return v;
}
__device__ __forceinline__ float silu_f(float x) { return x / (1.f + __expf(-x)); }

struct ColMap { int t0, a0, t1, a1, t2, a2, a3, nvalid; };
__device__ __forceinline__ int cm_src(const ColMap& c, int n) { return n + (n < c.t0 ? c.a0 : n < c.t1 ? c.a1 : n < c.t2 ? c.a2 : c.a3); }
static ColMap cm_identity(int nvalid) { ColMap c; c.t0 = 1 << 30; c.a0 = 0; c.t1 = 1 << 30; c.a1 = 0; c.t2 = 1 << 30; c.a2 = 0; c.a3 = 0; c.nvalid = nvalid; return c; }

template <int EPI>
__global__ __launch_bounds__(256) void nv_gemm(const bf16* __restrict__ A, int lda, const float* __restrict__ W, const float* __restrict__ W2, int ldw, ColMap cm,
                                               int K, void* Cv, int ldc, float scale, int nstore) {
    __shared__ __attribute__((aligned(16))) bf16 sA[64][40];
    __shared__ __attribute__((aligned(16))) bf16 sB[64][40];
    __shared__ __attribute__((aligned(16))) bf16 sB2[64][40];
    const int tid = threadIdx.x, lane = tid & 63, wid = tid >> 6;
    const int m0 = blockIdx.y * 64, n0 = blockIdx.x * 64;
    const int wm = (wid >> 1) * 32, wn = (wid & 1) * 32;
    f32x4 acc[2][2], acc2[2][2];
#pragma unroll
    for (int i = 0; i < 2; ++i)
#pragma unroll
        for (int j = 0; j < 2; ++j) { acc[i][j] = (f32x4){0.f, 0.f, 0.f, 0.f}; acc2[i][j] = (f32x4){0.f, 0.f, 0.f, 0.f}; }
    const int ar = tid >> 2, ac = (tid & 3) * 8;
    const int bk = tid >> 3, bn = (tid & 7) * 8;
    const int ncol = n0 + bn; const bool nval = ncol < cm.nvalid; const int src = cm_src(cm, ncol);
    for (int k0 = 0; k0 < K; k0 += 32) {
        const bf16x8 av = *(const bf16x8*)(A + (size_t)(m0 + ar) * lda + k0 + ac);
        f32x4 w0 = (f32x4){0.f, 0.f, 0.f, 0.f}, w1 = w0, u0 = w0, u1 = w0;
        if (nval) { const float* wp = W + (size_t)(k0 + bk) * ldw + src; w0 = *(const f32x4*)wp; w1 = *(const f32x4*)(wp + 4);
            if (EPI == 1) { const float* up = W2 + (size_t)(k0 + bk) * ldw + src; u0 = *(const f32x4*)up; u1 = *(const f32x4*)(up + 4); } }
        *(bf16x8*)&sA[ar][ac] = av;
#pragma unroll
        for (int j = 0; j < 4; ++j) { sB[bn + j][bk] = f2bf(w0[j]); sB[bn + 4 + j][bk] = f2bf(w1[j]); }
        if (EPI == 1) {
#pragma unroll
            for (int j = 0; j < 4; ++j) { sB2[bn + j][bk] = f2bf(u0[j]); sB2[bn + 4 + j][bk] = f2bf(u1[j]); } }
        __syncthreads();
        bf16x8 a[2], b[2], b2[2];
#pragma unroll
        for (int i = 0; i < 2; ++i) { a[i] = *(const bf16x8*)&sA[wm + i * 16 + (lane & 15)][(lane >> 4) * 8]; b[i] = *(const bf16x8*)&sB[wn + i * 16 + (lane & 15)][(lane >> 4) * 8];
            if (EPI == 1) b2[i] = *(const bf16x8*)&sB2[wn + i * 16 + (lane & 15)][(lane >> 4) * 8]; }
#pragma unroll
        for (int i = 0; i < 2; ++i)
#pragma unroll
            for (int j = 0; j < 2; ++j) { acc[i][j] = __builtin_amdgcn_mfma_f32_16x16x32_bf16(a[i], b[j], acc[i][j], 0, 0, 0);
                if (EPI == 1) acc2[i][j] = __builtin_amdgcn_mfma_f32_16x16x32_bf16(a[i], b2[j], acc2[i][j], 0, 0, 0); }
        __syncthreads();
    }
#pragma unroll
    for (int i = 0; i < 2; ++i)
#pragma unroll
        for (int j = 0; j < 2; ++j)
#pragma unroll
            for (int r = 0; r < 4; ++r) {
                const int row = m0 + wm + i * 16 + (lane >> 4) * 4 + r, col = n0 + wn + j * 16 + (lane & 15);
                const float v = acc[i][j][r];
                if (EPI == 0) ((bf16*)Cv)[(size_t)row * ldc + col] = f2bf(v);
                if (EPI == 1) ((bf16*)Cv)[(size_t)row * ldc + col] = f2bf(silu_f(v) * acc2[i][j][r]);
                if (EPI == 2) { float* p = (float*)Cv + (size_t)row * ldc + col; *p = *p + scale * v; }
                if (EPI == 3) { if (col < nstore) ((float*)Cv)[(size_t)row * ldc + col] = v; }
            }
}

__global__ __launch_bounds__(256) void nv_rmsnorm(const float* __restrict__ X, const float* __restrict__ g, bf16* __restrict__ out, int rows) {
    const int lane = threadIdx.x & 63, row = blockIdx.x * 4 + (threadIdx.x >> 6);
    if (row >= rows) return;
    const f32x4* xr = (const f32x4*)(X + (size_t)row * DM) + lane; f32x4 v[4]; float s = 0.f;
#pragma unroll
    for (int j = 0; j < 4; ++j) { v[j] = xr[64 * j]; s += v[j].x * v[j].x + v[j].y * v[j].y + v[j].z * v[j].z + v[j].w * v[j].w; }
    const float rstd = 1.0f / sqrtf(wave_sum(s) * (1.f / DM) + EPS);
#pragma unroll
    for (int j = 0; j < 4; ++j) { const f32x4 gg = ((const f32x4*)g)[lane + 64 * j]; bf16* o = out + (size_t)row * DM + (lane + 64 * j) * 4;
        o[0] = f2bf(v[j].x * rstd * gg.x); o[1] = f2bf(v[j].y * rstd * gg.y); o[2] = f2bf(v[j].z * rstd * gg.z); o[3] = f2bf(v[j].w * rstd * gg.w); }
}

__global__ void nv_rope_table(float* cs) {
    const int i = blockIdx.x * blockDim.x + threadIdx.x; if (i >= SEQ * 32) return;
    const int pos = i >> 5, f = i & 31;
    const float ex = (float)(2 * f) / 64.0f;
    const float inv = (float)(1.0 / pow(10000.0, (double)ex));
    const float ang = (float)pos * inv;
    cs[i] = (float)cos((double)ang); cs[SEQ * 32 + i] = (float)sin((double)ang);
}

__global__ __launch_bounds__(256) void nv_headnorm128(bf16* __restrict__ buf, int ld, int col0, int hstride, int nheads, const float* __restrict__ g, int rows) {
    const int lane = threadIdx.x & 63, idx = blockIdx.x * 4 + (threadIdx.x >> 6);
    if (idx >= rows * nheads) return;
    const int row = idx / nheads, h = idx % nheads;
    bf16* p = buf + (size_t)row * ld + col0 + h * hstride + lane * 2;
    const float a = bf2f(p[0]), b = bf2f(p[1]);
    const float rstd = 1.0f / sqrtf(wave_sum(a * a + b * b) * (1.f / 128.f) + EPS);
    p[0] = f2bf(a * rstd * g[lane * 2]); p[1] = f2bf(b * rstd * g[lane * 2 + 1]);
}

__global__ __launch_bounds__(256) void nv_mla_rowprep(bf16* __restrict__ P, const float* __restrict__ gq, const float* __restrict__ gkv, const float* __restrict__ gkr,
                                                      const float* __restrict__ rope, bf16* __restrict__ KR) {
    const int lane = threadIdx.x & 63, row = blockIdx.x * 4 + (threadIdx.x >> 6);
    bf16* p = P + (size_t)row * PM;
    float q[6]; float s = 0.f;
#pragma unroll
    for (int j = 0; j < 6; ++j) { q[j] = bf2f(p[PM_CQ + lane + 64 * j]); s += q[j] * q[j]; }
    float rstd = 1.0f / sqrtf(wave_sum(s) * (1.f / 384.f) + EPS);
#pragma unroll
    for (int j = 0; j < 6; ++j) p[PM_CQ + lane + 64 * j] = f2bf(q[j] * rstd * gq[lane + 64 * j]);
    float c[4]; s = 0.f;
#pragma unroll
    for (int j = 0; j < 4; ++j) { c[j] = bf2f(p[PM_CKV + lane + 64 * j]); s += c[j] * c[j]; }
    rstd = 1.0f / sqrtf(wave_sum(s) * (1.f / 256.f) + EPS);
#pragma unroll
    for (int j = 0; j < 4; ++j) p[PM_CKV + lane + 64 * j] = f2bf(c[j] * rstd * gkv[lane + 64 * j]);
    float k = bf2f(p[PM_KR + lane]);
    rstd = 1.0f / sqrtf(wave_sum(k * k) * (1.f / 64.f) + EPS);
    k = k * rstd * gkr[lane];
    const float other = __shfl_xor(k, 32);
    const int pos = row % SEQ, f = lane & 31;
    const float cs = rope[pos * 32 + f], sn = rope[SEQ * 32 + pos * 32 + f];
    const float o = lane < 32 ? (k * cs - other * sn) : (other * sn + k * cs);
    KR[(size_t)row * 64 + lane] = f2bf(o);
}

__global__ __launch_bounds__(256) void nv_mla_headprep(bf16* __restrict__ Q, bf16* __restrict__ KV, const float* __restrict__ gqn, const float* __restrict__ gqr, const float* __restrict__ gkn,
                                                       const float* __restrict__ rope) {
    const int lane = threadIdx.x & 63, idx = blockIdx.x * 4 + (threadIdx.x >> 6);
    const int row = idx >> 3, h = idx & 7;
    bf16* q = Q + (size_t)row * QW + h * 192;
    { const float a = bf2f(q[lane * 2]), b = bf2f(q[lane * 2 + 1]);
      const float rstd = 1.0f / sqrtf(wave_sum(a * a + b * b) * (1.f / 128.f) + EPS);
      q[lane * 2] = f2bf(a * rstd * gqn[lane * 2]); q[lane * 2 + 1] = f2bf(b * rstd * gqn[lane * 2 + 1]); }
    { float k = bf2f(q[128 + lane]);
      const float rstd = 1.0f / sqrtf(wave_sum(k * k) * (1.f / 64.f) + EPS);
      k = k * rstd * gqr[lane];
      const float other = __shfl_xor(k, 32);
      const int pos = row % SEQ, f = lane & 31;
      const float cs = rope[pos * 32 + f], sn = rope[SEQ * 32 + pos * 32 + f];
      q[128 + lane] = f2bf(lane < 32 ? (k * cs - other * sn) : (other * sn + k * cs)); }
    bf16* kk = KV + (size_t)row * KVW + h * 256;
    { const float a = bf2f(kk[lane * 2]), b = bf2f(kk[lane * 2 + 1]);
      const float rstd = 1.0f / sqrtf(wave_sum(a * a + b * b) * (1.f / 128.f) + EPS);
      kk[lane * 2] = f2bf(a * rstd * gkn[lane * 2]); kk[lane * 2 + 1] = f2bf(b * rstd * gkn[lane * 2 + 1]); }
}

template <int DQK, bool CAUSAL>
__global__ __launch_bounds__(64) void nv_attn(const bf16* __restrict__ Q, int ldq, int qhs, const bf16* __restrict__ Kn, int ldkn, int knhs, const bf16* __restrict__ Kr, int ldkr,
                                              const bf16* __restrict__ V, int ldv, int vhs, bf16* __restrict__ O, int ldo, int ohs, int nheads, int sq, int skv, float scale, const float* __restrict__ qgain) {
    __shared__ float sQ[64][DQK + 1];
    const int lane = threadIdx.x;
    const int qb = blockIdx.x, h = blockIdx.y, b = blockIdx.z;
    const int q0 = qb * 64;
    const size_t qrow = (size_t)b * sq + q0 + lane;
    { const bf16* qp = Q + qrow * ldq + h * qhs; float s = 0.f;
      for (int d = 0; d < DQK; ++d) { const float v = bf2f(qp[d]); sQ[lane][d] = v; s += v * v; }
      if (qgain) { const float rstd = 1.0f / sqrtf(s * (1.f / DQK) + EPS); for (int d = 0; d < DQK; ++d) sQ[lane][d] = sQ[lane][d] * rstd * qgain[d]; } }
    float acc[128];
#pragma unroll
    for (int d = 0; d < 128; ++d) acc[d] = 0.f;
    float mx = -1e30f, l = 0.f;
    const int jend = CAUSAL ? (q0 + 64) : skv;
    for (int j = 0; j < jend; ++j) {
        const size_t krow = (size_t)b * skv + j;
        const bf16* kn = Kn + krow * ldkn + h * knhs;
        float s = 0.f;
#pragma unroll 8
        for (int d = 0; d < 128; ++d) s += sQ[lane][d] * bf2f(kn[d]);
        if (DQK > 128) { const bf16* kr = Kr + krow * ldkr;
#pragma unroll 8
            for (int d = 0; d < DQK - 128; ++d) s += sQ[lane][128 + d] * bf2f(kr[d]); }
        s *= scale;
        const bool ok = !CAUSAL || (j <= q0 + lane);
        if (ok) {
            const float mn = fmaxf(mx, s), al = __expf(mx - mn), p = __expf(s - mn);
            l = l * al + p; mx = mn;
            const bf16* vp = V + krow * ldv + h * vhs;
#pragma unroll
            for (int d = 0; d < 128; ++d) acc[d] = acc[d] * al + p * bf2f(vp[d]);
        }
    }
    const float inv = 1.0f / l;
    bf16* op = O + qrow * ldo + h * ohs;
#pragma unroll
    for (int d = 0; d < 128; ++d) op[d] = f2bf(acc[d] * inv);
}

__global__ __launch_bounds__(256) void nv_gla_alpha(const float* __restrict__ alow, const float* __restrict__ wa, const float* __restrict__ ba, float* __restrict__ alpha) {
    const size_t i = (size_t)blockIdx.x * 256 + threadIdx.x; const int m = (int)(i >> 9), c = (int)(i & 511);
    float z = ba[c];
#pragma unroll
    for (int r = 0; r < 16; ++r) z += alow[(size_t)m * 16 + r] * wa[r * 512 + c];
    const float ls = fminf(z, 0.f) - log1pf(expf(-fabsf(z)));
    alpha[i] = expf(ls * (1.f / 16.f));
}
__global__ __launch_bounds__(256) void nv_gla_rec(bf16* __restrict__ P, const float* __restrict__ alpha, const float* __restrict__ gout) {
    __shared__ float red[2][4];
    const int dv = threadIdx.x, h = blockIdx.x & 3, b = blockIdx.x >> 2, lane = dv & 63, wv = dv >> 6;
    float S[128];
#pragma unroll
    for (int d = 0; d < 128; ++d) S[d] = 0.f;
    const float g = gout[dv];
    const float scale = 0.08838834764831845f;
    for (int t = 0; t < SEQ; ++t) {
        const size_t row = (size_t)b * SEQ + t;
        bf16* p = P + row * PG;
        const bf16* q = p + PG_Q + h * 128; const bf16* k = p + PG_K + h * 128; const float* al = alpha + row * 512 + h * 128;
        const float v = bf2f(p[PG_V + h * 256 + dv]);
        float o = 0.f;
#pragma unroll
        for (int d = 0; d < 128; ++d) { S[d] = al[d] * S[d] + bf2f(k[d]) * v; o += bf2f(q[d]) * S[d]; }
        o *= scale;
        float ss = wave_sum(o * o);
        if (lane == 0) red[t & 1][wv] = ss;
        __syncthreads();
        ss = red[t & 1][0] + red[t & 1][1] + red[t & 1][2] + red[t & 1][3];
        const float rstd = 1.0f / sqrtf(ss * (1.f / 256.f) + EPS);
        const float r = bf2f(p[PG_R + h * 256 + dv]);
        p[PG_V + h * 256 + dv] = f2bf(o * rstd * g * silu_f(r));
    }
}

#define LAS __attribute__((address_space(3)))
#define GAS __attribute__((address_space(1)))
typedef unsigned u32x4 __attribute__((ext_vector_type(4)));
typedef unsigned u32x2 __attribute__((ext_vector_type(2)));
typedef float f32x2 __attribute__((ext_vector_type(2)));
typedef GAS unsigned gu32;
#define RLX_AGENT __ATOMIC_RELAXED, __HIP_MEMORY_SCOPE_AGENT
#define LDS_WAIT() asm volatile("s_waitcnt lgkmcnt(0)" ::: "memory")
#define VM_WAIT() asm volatile("s_waitcnt vmcnt(0)" ::: "memory")
__device__ __forceinline__ unsigned cvt_pk_bf16(float lo, float hi) { unsigned r; asm volatile("v_cvt_pk_bf16_f32 %0, %1, %2" : "=v"(r) : "v"(lo), "v"(hi)); return r; }
__device__ __forceinline__ float fast_silu(float x) { return x * __builtin_amdgcn_rcpf(1.0f + __builtin_amdgcn_exp2f(-1.4426950408889634f * x)); }

namespace pg8 {
constexpr int BM = 256, BK = 64, HALF = 128, HTB = HALF * BK * 2  , STAGE_BYTES = 8 * HTB, NXCD = 8, WGM = 8;
__host__ __device__ __forceinline__ int lds_byte(int r, int c) { const int st = (r >> 4) * 2 + (c >> 5), rr = r & 15, cc = c & 31, ob = rr * 64 + cc * 2; return st * 1024 + (ob ^ (((ob >> 9) & 1) << 5)); }
__host__ __device__ __forceinline__ void stage_rc(int b, int& R, int& C) { const int st = b / 1024, sb = b % 1024, swz = sb ^ (((sb >> 9) & 1) << 5); R = (st >> 1) * 16 + swz / 64; C = (st & 1) * 32 + (swz % 64) / 2; }
__host__ __device__ __forceinline__ int perm32(int rho) { const int n = rho >> 4, i = rho & 15; return 8 * (i >> 2) + 4 * n + (i & 3); }

struct Unit { int pm, pn; };
struct Gemm { const bf16* A; const bf16* Bt; int M, N, K, lda, ldb; };

struct StaticOrder {
    int nM, nN, nwg, G, c, rev;
    __device__ void init(int M_, int N_, int G_, int c_, int rev_ = 0) { nM = M_ / BM; nN = N_ / BM; nwg = nM * nN; G = G_; c = c_; rev = rev_; }
    __device__ bool next(int i, Unit& u) const {
        const int R = (nwg - c + G - 1) / G;
        if (i >= R) return false;
        const long L = (long)(rev ? R - 1 - i : i) * G + c;
        int wgid = (int)L; { const int q = nwg / NXCD, r = nwg % NXCD, xcd = wgid % NXCD, off = wgid / NXCD; wgid = (xcd < r ? xcd * (q + 1) : r * (q + 1) + (xcd - r) * q) + off; }
        const int nig = WGM * nN, gid = wgid / nig, fm = gid * WGM, gsz = (nM - fm) < WGM ? (nM - fm) : WGM;
        u.pm = fm + ((wgid % nig) % gsz); u.pn = (wgid % nig) / gsz; return true;
    }
};
struct DiagOrder {
    int G, c, nb;
    __device__ bool next(int i, Unit& u) const { const int L = i * G + c; if (L >= nb * 16) return false; const int blk = L >> 4, r = L & 15; u.pm = blk * 4 + (r >> 2); u.pn = blk * 4 + (r & 3); return true; }
};

__device__ __forceinline__ float rstd_of(float ss) { return __builtin_amdgcn_rsqf(ss * (1.f / 1024.f) + EPS); }
#ifndef RS_DIRECT
#define RS_DIRECT 0
#endif
#if RS_DIRECT
#define TABV(idx) ({ const f32x4 t_ = *(const f32x4*)(rsg + (idx) * 4); (t_.x + t_.y) + (t_.z + t_.w); })
#else
#define TABV(idx) ({ const f32x4 t_ = *(const LAS f32x4*)(tab + (idx) * 4); (t_.x + t_.y) + (t_.z + t_.w); })
#endif
template <bool RS> struct EpiBf16 {
    static constexpr bool PERM = true, USE_RS = RS;
    bf16* O; int ldc; int pn_mask;
    __device__ __forceinline__ void operator()(const f32x4 (&acc)[2][2][4][2], const Unit& u, int wr, int wc, int fr, int fq, const LAS float* tab, const float* rsg) const {
        asm volatile("" : "+v"(fr), "+v"(fq));
        const int row0 = u.pm * BM + wr * 64 + fr, col0 = (u.pn & pn_mask) * BM + wc * 32 + 8 * fq;
#pragma unroll
        for (int ai = 0; ai < 2; ++ai)
#pragma unroll
            for (int m = 0; m < 4; ++m) { bf16* rowp = O + (size_t)(row0 + ai * HALF + m * 16) * ldc + col0;
                const float rs = RS ? rstd_of(TABV(ai * HALF + wr * 64 + m * 16 + fr)) : 1.f;
#pragma unroll
                for (int bj = 0; bj < 2; ++bj) { const f32x4 v0 = acc[ai][bj][m][0] * rs, v1 = acc[ai][bj][m][1] * rs;
                    u32x4 w; w.x = cvt_pk_bf16(v0[0], v0[1]); w.y = cvt_pk_bf16(v0[2], v0[3]); w.z = cvt_pk_bf16(v1[0], v1[1]); w.w = cvt_pk_bf16(v1[2], v1[3]);
                    *(u32x4*)(rowp + bj * HALF) = w; } }
    }
};
struct EpiGlaIn {
    static constexpr bool PERM = true, USE_RS = true;
    bf16* O; float* alow;
    __device__ __forceinline__ void operator()(const f32x4 (&acc)[2][2][4][2], const Unit& u, int wr, int wc, int fr, int fq, const LAS float* tab, const float* rsg) const {
        const int row0 = u.pm * BM + wr * 64 + fr;
        if (u.pn == 14) {
            if (wc == 0 && fq < 2) {
#pragma unroll
                for (int ai = 0; ai < 2; ++ai)
#pragma unroll
                    for (int m = 0; m < 4; ++m) { const float rs = rstd_of(TABV(ai * HALF + wr * 64 + m * 16 + fr)); float* ap = alow + (size_t)(row0 + ai * HALF + m * 16) * 16 + 8 * fq;
                        *(f32x4*)ap = acc[ai][0][m][0] * rs; *(f32x4*)(ap + 4) = acc[ai][0][m][1] * rs; } }
            return;
        }
        const int col0 = u.pn * BM + wc * 32 + 8 * fq;
#pragma unroll
        for (int ai = 0; ai < 2; ++ai)
#pragma unroll
            for (int m = 0; m < 4; ++m) { bf16* rowp = O + (size_t)(row0 + ai * HALF + m * 16) * PG + col0;
                const float rs = rstd_of(TABV(ai * HALF + wr * 64 + m * 16 + fr));
#pragma unroll
                for (int bj = 0; bj < 2; ++bj) { const f32x4 v0 = acc[ai][bj][m][0] * rs, v1 = acc[ai][bj][m][1] * rs;
                    u32x4 w; w.x = cvt_pk_bf16(v0[0], v0[1]); w.y = cvt_pk_bf16(v0[2], v0[3]); w.z = cvt_pk_bf16(v1[0], v1[1]); w.w = cvt_pk_bf16(v1[2], v1[3]);
                    *(u32x4*)(rowp + bj * HALF) = w; } }
    }
};
struct EpiSwiGLU {
    static constexpr bool PERM = true, USE_RS = true;
    bf16* O; int ldc;
    __device__ __forceinline__ void operator()(const f32x4 (&acc)[2][2][4][2], const Unit& u, int wr, int wc, int fr, int fq, const LAS float* tab, const float* rsg) const {
        const int row0 = u.pm * BM + wr * 64 + fr, col0 = u.pn * HALF + wc * 32 + 8 * fq;
        float ss[2][4];
#pragma unroll
        for (int ai = 0; ai < 2; ++ai)
#pragma unroll
            for (int m = 0; m < 4; ++m) ss[ai][m] = TABV(ai * HALF + wr * 64 + m * 16 + fr);
#pragma unroll
        for (int ai = 0; ai < 2; ++ai)
#pragma unroll
            for (int m = 0; m < 4; ++m) { bf16* rowp = O + (size_t)(row0 + ai * HALF + m * 16) * ldc + col0;
                const float v = ss[ai][m] * (1.f / 1024.f) + EPS, c = -1.4426950408889634f * __builtin_amdgcn_rsqf(v);
                float h[8], e[8];
#pragma unroll
                for (int k = 0; k < 8; ++k) e[k] = acc[ai][0][m][k >> 2][k & 3] * c;
#pragma unroll
                for (int k = 0; k < 8; ++k) h[k] = acc[ai][0][m][k >> 2][k & 3] * acc[ai][1][m][k >> 2][k & 3];
                __builtin_amdgcn_sched_barrier(0);
#pragma unroll
                for (int k = 0; k < 8; ++k) e[k] = __builtin_amdgcn_exp2f(e[k]);
                __builtin_amdgcn_sched_barrier(0);
#pragma unroll
                for (int k = 0; k < 8; ++k) e[k] = __builtin_fmaf(e[k], v, v);
                __builtin_amdgcn_sched_barrier(0);
#pragma unroll
                for (int k = 0; k < 8; ++k) e[k] = __builtin_amdgcn_rcpf(e[k]);
                __builtin_amdgcn_sched_barrier(0);
#pragma unroll
                for (int k = 0; k < 8; ++k) h[k] *= e[k];
                u32x4 w; w.x = cvt_pk_bf16(h[0], h[1]); w.y = cvt_pk_bf16(h[2], h[3]); w.z = cvt_pk_bf16(h[4], h[5]); w.w = cvt_pk_bf16(h[6], h[7]);
                *(u32x4*)rowp = w; }
    }
};
struct EpiKV {
    static constexpr bool PERM = true, USE_RS = false;
    bf16* O; int ldc; const float* gkn; LAS float* part;
    __device__ __forceinline__ void operator()(const f32x4 (&acc)[2][2][4][2], const Unit& u, int wr, int wc, int fr, int fq, const LAS float*, const float*) const {
        asm volatile("" : "+v"(fr), "+v"(fq));
        const int row0 = u.pm * BM + wr * 64 + fr, col0 = u.pn * BM + wc * 32 + 8 * fq;
#pragma unroll
        for (int ai = 0; ai < 2; ++ai)
#pragma unroll
            for (int m = 0; m < 4; ++m) { const f32x4 a = acc[ai][0][m][0], b = acc[ai][0][m][1];
                float ss = ((a[0] * a[0] + a[1] * a[1]) + (a[2] * a[2] + a[3] * a[3])) + ((b[0] * b[0] + b[1] * b[1]) + (b[2] * b[2] + b[3] * b[3]));
                ss += __shfl_xor(ss, 16); ss += __shfl_xor(ss, 32);
                if (fq == 0) part[(ai * HALF + wr * 64 + m * 16 + fr) * 4 + wc] = ss; }
        asm volatile("s_waitcnt lgkmcnt(0)" ::: "memory"); __builtin_amdgcn_s_barrier(); asm volatile("" ::: "memory");
        const f32x4 g0 = *(const f32x4*)(gkn + wc * 32 + 8 * fq), g1 = *(const f32x4*)(gkn + wc * 32 + 8 * fq + 4);
#pragma unroll
        for (int ai = 0; ai < 2; ++ai)
#pragma unroll
            for (int m = 0; m < 4; ++m) { bf16* rowp = O + (size_t)(row0 + ai * HALF + m * 16) * ldc + col0;
                const f32x4 pp = *(const LAS f32x4*)(part + (ai * HALF + wr * 64 + m * 16 + fr) * 4);
                const float rs = __builtin_amdgcn_rsqf(((pp.x + pp.y) + (pp.z + pp.w)) * (1.f / 128.f) + EPS);
                { const f32x4 v0 = acc[ai][0][m][0] * rs * g0, v1 = acc[ai][0][m][1] * rs * g1;
                  u32x4 w; w.x = cvt_pk_bf16(v0[0], v0[1]); w.y = cvt_pk_bf16(v0[2], v0[3]); w.z = cvt_pk_bf16(v1[0], v1[1]); w.w = cvt_pk_bf16(v1[2], v1[3]); *(u32x4*)rowp = w; }
                { const f32x4 v0 = acc[ai][1][m][0], v1 = acc[ai][1][m][1];
                  u32x4 w; w.x = cvt_pk_bf16(v0[0], v0[1]); w.y = cvt_pk_bf16(v0[2], v0[3]); w.z = cvt_pk_bf16(v1[0], v1[1]); w.w = cvt_pk_bf16(v1[2], v1[3]); *(u32x4*)(rowp + HALF) = w; } }
    }
};
struct EpiResid {
    static constexpr bool PERM = true, USE_RS = false;
    bf16* XB; float* OUT; float* RS4; LAS float* part; int ldc; float scale;
    __device__ __forceinline__ void operator()(const f32x4 (&acc)[2][2][4][2], const Unit& u, int wr, int wc, int fr, int fq, const LAS float*, const float*) const {
        const int row0 = u.pm * BM + wr * 64 + fr, col0 = u.pn * BM + wc * 32 + 8 * fq;
#pragma unroll
        for (int ai = 0; ai < 2; ++ai) {
            const size_t off = (size_t)(row0 + ai * HALF) * ldc + col0;
            u32x4 xv[4][2];
#pragma unroll
            for (int m = 0; m < 4; ++m)
#pragma unroll
                for (int bj = 0; bj < 2; ++bj) xv[m][bj] = *(const u32x4*)(XB + off + (size_t)(m * 16) * ldc + bj * HALF);
#pragma unroll
            for (int m = 0; m < 4; ++m) { float ss = 0.f;
#pragma unroll
                for (int bj = 0; bj < 2; ++bj) { const u32x4 w = xv[m][bj]; const size_t o2 = off + (size_t)(m * 16) * ldc + bj * HALF;
                    f32x4 n0, n1;
                    n0[0] = __uint_as_float(w.x << 16) + acc[ai][bj][m][0][0] * scale; n0[1] = __uint_as_float(w.x & 0xffff0000u) + acc[ai][bj][m][0][1] * scale;
                    n0[2] = __uint_as_float(w.y << 16) + acc[ai][bj][m][0][2] * scale; n0[3] = __uint_as_float(w.y & 0xffff0000u) + acc[ai][bj][m][0][3] * scale;
                    n1[0] = __uint_as_float(w.z << 16) + acc[ai][bj][m][1][0] * scale; n1[1] = __uint_as_float(w.z & 0xffff0000u) + acc[ai][bj][m][1][1] * scale;
                    n1[2] = __uint_as_float(w.w << 16) + acc[ai][bj][m][1][2] * scale; n1[3] = __uint_as_float(w.w & 0xffff0000u) + acc[ai][bj][m][1][3] * scale;
                    if (OUT) { *(f32x4*)(OUT + o2) = n0; *(f32x4*)(OUT + o2 + 4) = n1; }
                    else { u32x4 o; o.x = cvt_pk_bf16(n0[0], n0[1]); o.y = cvt_pk_bf16(n0[2], n0[3]); o.z = cvt_pk_bf16(n1[0], n1[1]); o.w = cvt_pk_bf16(n1[2], n1[3]); *(u32x4*)(XB + o2) = o;
                        ss += ((n0[0] * n0[0] + n0[1] * n0[1]) + (n0[2] * n0[2] + n0[3] * n0[3])) + ((n1[0] * n1[0] + n1[1] * n1[1]) + (n1[2] * n1[2] + n1[3] * n1[3])); } }
                if (!OUT) { ss += __shfl_xor(ss, 16); ss += __shfl_xor(ss, 32); if (fq == 0) part[(ai * HALF + wr * 64 + m * 16 + fr) * 4 + wc] = ss; } }
            asm volatile("" ::: "memory"); }
        if (!OUT) {
            asm volatile("s_waitcnt lgkmcnt(0)" ::: "memory"); __builtin_amdgcn_s_barrier(); asm volatile("" ::: "memory");
            const int t = (wr * 4 + wc) * 64 + fq * 16 + fr;
            if (t < 256) { const f32x4 pp = *(const LAS f32x4*)(part + t * 4); RS4[((size_t)u.pm * BM + t) * 4 + u.pn] = (pp.x + pp.y) + (pp.z + pp.w); }
        }
    }
};

template <class Epi, class Sched, bool ALIGN_EPI = false, bool SP2 = false>
__device__ __forceinline__ void gemm_phase(LAS unsigned char* lds, const Gemm g, const Sched& S, const Epi& E, const float* rs = nullptr, LAS unsigned char* rstab = nullptr, const bool skip_epi = false) {
    int tid_ = threadIdx.x; asm volatile("" : "+v"(tid_));
    const int tid = tid_, wid = __builtin_amdgcn_readfirstlane(tid >> 6), lane = tid & 63, wr = wid >> 2, wc = wid & 3, fr = lane & 15, fq = lane >> 4;
    const int K = g.K, nt = K / BK, lda = g.lda, ldb = g.ldb;
    unsigned voffA[2], voffB[2];
#pragma unroll
    for (int i = 0; i < 2; ++i) { int R, C; stage_rc(tid * 16 + i * 8192, R, C); const int Rb = Epi::PERM ? ((R & ~31) + perm32(R & 31)) : R;
        voffA[i] = (unsigned)(R * lda + C) * 2u; voffB[i] = (unsigned)(Rb * ldb + C) * 2u; }
    const size_t kstep = (size_t)(BK * 2);
    const size_t hstepA = (size_t)HALF * lda * 2, hstepB = (size_t)HALF * ldb * 2;
    const size_t tstepA = 2 * hstepA, tstepB = 2 * hstepB;
    const unsigned ldsw = (unsigned)wid * 1024u;
    const int aoff = lds_byte(wr * 64 + fr, fq * 8), boff = lds_byte(wc * 32 + fr, fq * 8);
#define PG8_SA(b, h) (((b) * 2 + (h)) * HTB)
#define PG8_SB(b, h) ((4 + (b) * 2 + (h)) * HTB)
#define PG8_STAGE(bufoff, gbase, voff) do { _Pragma("unroll") for (int _i = 0; _i < 2; ++_i) \
        __builtin_amdgcn_global_load_lds((const unsigned*)((const char*)(gbase) + (voff)[_i]), (LAS unsigned*)(lds + (bufoff) + ldsw + _i * 8192), 16, 0, 0); } while (0)
#define PG8_LDA(dst, b, h) do { _Pragma("unroll") for (int m = 0; m < 4; ++m) _Pragma("unroll") for (int k = 0; k < 2; ++k) dst[m][k] = *(const LAS bf16x8*)(lds + PG8_SA(b, h) + aoff + m * 2048 + k * 1024); } while (0)
#define PG8_LDB(dst, b, h) do { _Pragma("unroll") for (int n = 0; n < 2; ++n) _Pragma("unroll") for (int k = 0; k < 2; ++k) dst[n][k] = *(const LAS bf16x8*)(lds + PG8_SB(b, h) + boff + n * 2048 + k * 1024); } while (0)
#define PG8_MMA(ai, bj, At, Bt) do { __builtin_amdgcn_s_setprio(1); _Pragma("unroll") for (int m = 0; m < 4; ++m) _Pragma("unroll") for (int n = 0; n < 2; ++n) _Pragma("unroll") for (int k = 0; k < 2; ++k) \
        acc[ai][bj][m][n] = __builtin_amdgcn_mfma_f32_16x16x32_bf16(Bt[n][k], At[m][k], acc[ai][bj][m][n], 0, 0, 0); __builtin_amdgcn_s_setprio(0); } while (0)
#define PG8_WAIT_V(n) asm volatile("s_waitcnt vmcnt(" #n ")" ::: "memory")
#define PG8_WAIT_L(n) asm volatile("s_waitcnt lgkmcnt(" #n ")" ::: "memory")
#define PG8_BAR __builtin_amdgcn_s_barrier()
#define PG8_SCHED __builtin_amdgcn_sched_barrier(0)
    Unit cur, nxt; int ui = 0;
    if (!S.next(0, cur)) return;
    f32x4 acc[2][2][4][2];
#pragma unroll
    for (int a = 0; a < 2; ++a)
#pragma unroll
        for (int b = 0; b < 2; ++b)
#pragma unroll
            for (int m = 0; m < 4; ++m)
#pragma unroll
                for (int n = 0; n < 2; ++n) acc[a][b][m][n] = (f32x4){0.f, 0.f, 0.f, 0.f};
    bf16x8 At[4][2], B0[2][2], B1[2][2];
    const char* cA = (const char*)g.A + (size_t)cur.pm * tstepA; const char* cB = (const char*)g.Bt + (size_t)cur.pn * tstepB;
#define PG8_RSDMA(unit, par) do { if (Epi::USE_RS && wid < 4) __builtin_amdgcn_global_load_lds((const unsigned*)(rs + ((size_t)(unit).pm * BM + wid * 64 + lane) * 4), (LAS unsigned*)(rstab + (par) * 4096 + wid * 1024), 16, 0, 0); } while (0)
    PG8_RSDMA(cur, 0);
    if constexpr (SP2) {
        PG8_STAGE(PG8_SB(0, 0), cB, voffB); PG8_STAGE(PG8_SB(0, 1), cB + hstepB, voffB); PG8_STAGE(PG8_SA(0, 0), cA, voffA); PG8_STAGE(PG8_SA(0, 1), cA + hstepA, voffA);
        if (wr == 1) PG8_BAR;
        PG8_WAIT_V(2); PG8_BAR;
        PG8_STAGE(PG8_SB(1, 0), cB + kstep, voffB); PG8_STAGE(PG8_SA(1, 0), cA + kstep, voffA); PG8_STAGE(PG8_SB(1, 1), cB + hstepB + kstep, voffB);
        PG8_WAIT_V(6); PG8_BAR;
    } else {
        PG8_STAGE(PG8_SB(0, 0), cB, voffB); PG8_STAGE(PG8_SA(0, 0), cA, voffA); PG8_STAGE(PG8_SB(0, 1), cB + hstepB, voffB); PG8_STAGE(PG8_SA(0, 1), cA + hstepA, voffA);
        if (wr == 1) PG8_BAR;
        PG8_WAIT_V(4); PG8_BAR;
        PG8_STAGE(PG8_SB(1, 0), cB + kstep, voffB); PG8_STAGE(PG8_SA(1, 0), cA + kstep, voffA); PG8_STAGE(PG8_SB(1, 1), cB + hstepB + kstep, voffB);
        PG8_WAIT_V(6); PG8_BAR;
    }
    for (;;) {
        const bool has_next = S.next(ui + 1, nxt);
        const char* nA = has_next ? (const char*)g.A + (size_t)nxt.pm * tstepA : cA; const char* nB = has_next ? (const char*)g.Bt + (size_t)nxt.pn * tstepB : cB;
        for (int t = 0; t < nt; t += 2) {
            const bool last = (t == nt - 2);
            const char* a1 = cA + (size_t)(t + 1) * kstep;
            const char* a2 = last ? nA : cA + (size_t)(t + 2) * kstep; const char* b2 = last ? nB : cB + (size_t)(t + 2) * kstep;
            const char* a3 = a2 + kstep; const char* b3 = b2 + kstep;
            if (last && has_next) PG8_RSDMA(nxt, (ui + 1) & 1);
            if constexpr (SP2) {
            PG8_LDB(B0, 0, 0); PG8_LDB(B1, 0, 1); PG8_SCHED; PG8_LDA(At, 0, 0); PG8_STAGE(PG8_SA(1, 1), a1 + hstepA, voffA);
            PG8_WAIT_V(8); PG8_WAIT_L(0); PG8_BAR; PG8_MMA(0, 0, At, B0); PG8_MMA(0, 1, At, B1); PG8_BAR; PG8_SCHED;
            PG8_LDA(At, 0, 1); PG8_STAGE(PG8_SB(0, 0), b2, voffB); PG8_STAGE(PG8_SB(0, 1), b2 + hstepB, voffB); PG8_STAGE(PG8_SA(0, 0), a2, voffA);
            PG8_WAIT_V(8); PG8_WAIT_L(0); PG8_BAR; PG8_MMA(1, 0, At, B0); PG8_MMA(1, 1, At, B1); PG8_BAR; PG8_SCHED;
            PG8_LDB(B0, 1, 0); PG8_LDB(B1, 1, 1); PG8_SCHED; PG8_LDA(At, 1, 0); PG8_STAGE(PG8_SA(0, 1), a2 + hstepA, voffA);
            PG8_WAIT_V(8); PG8_WAIT_L(0); PG8_BAR; PG8_MMA(0, 0, At, B0); PG8_MMA(0, 1, At, B1); PG8_BAR; PG8_SCHED;
            PG8_LDA(At, 1, 1); PG8_STAGE(PG8_SB(1, 0), b3, voffB); PG8_STAGE(PG8_SB(1, 1), b3 + hstepB, voffB); PG8_STAGE(PG8_SA(1, 0), a3, voffA);
            PG8_WAIT_V(8); PG8_WAIT_L(0); PG8_BAR; PG8_MMA(1, 0, At, B0); PG8_MMA(1, 1, At, B1); PG8_BAR; PG8_SCHED;
            } else {
            PG8_LDB(B0, 0, 0); PG8_SCHED; PG8_LDA(At, 0, 0); PG8_STAGE(PG8_SA(1, 1), a1 + hstepA, voffA);
            PG8_WAIT_L(8); PG8_BAR; PG8_WAIT_L(0); PG8_MMA(0, 0, At, B0); PG8_BAR; PG8_SCHED;
            PG8_LDB(B1, 0, 1); PG8_STAGE(PG8_SB(0, 0), b2, voffB);
            PG8_BAR; PG8_WAIT_L(0); PG8_MMA(0, 1, At, B1); PG8_BAR;
            PG8_LDA(At, 0, 1); PG8_STAGE(PG8_SA(0, 0), a2, voffA);
            PG8_BAR; PG8_WAIT_L(0); PG8_MMA(1, 0, At, B0); PG8_BAR; PG8_SCHED;
            PG8_STAGE(PG8_SB(0, 1), b2 + hstepB, voffB);
            PG8_WAIT_V(6); PG8_BAR; PG8_MMA(1, 1, At, B1); PG8_BAR;
            PG8_LDB(B0, 1, 0); PG8_SCHED; PG8_LDA(At, 1, 0); PG8_STAGE(PG8_SA(0, 1), a2 + hstepA, voffA);
            PG8_WAIT_L(8); PG8_BAR; PG8_WAIT_L(0); PG8_MMA(0, 0, At, B0); PG8_BAR; PG8_SCHED;
            PG8_LDB(B1, 1, 1); PG8_STAGE(PG8_SB(1, 0), b3, voffB);
            PG8_BAR; PG8_WAIT_L(0); PG8_MMA(0, 1, At, B1); PG8_BAR;
            PG8_LDA(At, 1, 1); PG8_STAGE(PG8_SA(1, 0), a3, voffA);
            PG8_BAR; PG8_WAIT_L(0); PG8_MMA(1, 0, At, B0); PG8_BAR; PG8_SCHED;
            PG8_STAGE(PG8_SB(1, 1), b3 + hstepB, voffB);
            PG8_WAIT_V(6); PG8_BAR; PG8_MMA(1, 1, At, B1); PG8_BAR;
            }
        }
        if constexpr (ALIGN_EPI) { if (wr == 0) PG8_BAR; }
        if (!skip_epi) E(acc, cur, wr, wc, fr, fq, (const LAS float*)(rstab + (ui & 1) * 4096), rs + (size_t)cur.pm * BM * 4);
        if (!has_next) break;
#pragma unroll
        for (int a = 0; a < 2; ++a)
#pragma unroll
            for (int b = 0; b < 2; ++b)
#pragma unroll
                for (int m = 0; m < 4; ++m)
#pragma unroll
                    for (int n = 0; n < 2; ++n) { typedef double f64x2_ __attribute__((ext_vector_type(2))); double z0, z1;
                        asm volatile("v_mov_b64 %0, 0\n\tv_mov_b64 %1, 0" : "=v"(z0), "=v"(z1)); f64x2_ zz = {z0, z1}; acc[a][b][m][n] = __builtin_bit_cast(f32x4, zz); }
        cur = nxt; cA = nA; cB = nB; ++ui;
        if constexpr (ALIGN_EPI) { if (wr == 1) PG8_BAR; }
    }
    PG8_WAIT_V(0);
    if constexpr (!ALIGN_EPI) { if (wr == 0) PG8_BAR; }
    PG8_BAR;
#undef PG8_RSDMA
#undef PG8_SA
#undef PG8_SB
#undef PG8_STAGE
#undef PG8_LDA
#undef PG8_LDB
#undef PG8_MMA
#undef PG8_WAIT_V
#undef PG8_WAIT_L
#undef PG8_BAR
#undef PG8_SCHED
}
}
#ifndef PG8_SP2
#define PG8_SP2 true
#endif
#ifndef PG8_ALIGN
#define PG8_ALIGN true
#endif

#define XB_TMO      128
#define XB_XCNT(j)  (256  + 64 * (j))
#define XB_XSUB(j)  (1280 + 64 * (j))
#define XB_XGEN(j)  (2304 + 64 * (j))
#define XB_TOP      3328
#define XB_TOPGEN   3392
#define XCD_BAR_WORDS 3456
#define XB_SPIN_CAP (1u << 18)
__device__ __forceinline__ unsigned xb_ld(unsigned* p)              { return __hip_atomic_load(p, __ATOMIC_RELAXED, __HIP_MEMORY_SCOPE_AGENT); }
__device__ __forceinline__ unsigned xb_add(unsigned* p, unsigned v) { return __hip_atomic_fetch_add(p, v, __ATOMIC_RELAXED, __HIP_MEMORY_SCOPE_AGENT); }
__device__ __forceinline__ unsigned xb_xcc_id() { return (unsigned)__builtin_amdgcn_s_getreg((3 << 11) | 20) & 0xFu; }
#define XB_SPIN(cond, bar) do { unsigned _sp = 0; while (cond) { __builtin_amdgcn_s_sleep(1); \
    if ((++_sp & 255u) == 0u) { if (xb_ld(&(bar)[XB_TMO])) break; if (_sp > XB_SPIN_CAP) { atomicAdd(&(bar)[XB_TMO], 1u); break; } } } } while (0)
struct XcdBarrier { unsigned* bar; unsigned x; volatile LAS unsigned* st; };
__device__ __forceinline__ XcdBarrier xcd_barrier_post(unsigned* bar, volatile LAS unsigned* st) {
    XcdBarrier b; b.bar = bar; b.x = xb_xcc_id(); b.st = st;
    if (threadIdx.x == 0) (void)xb_add(&bar[XB_XCNT(b.x)], 1u);
    return b;
}
__device__ __forceinline__ void xcd_barrier_complete(unsigned* bar, unsigned x, unsigned& nloc, unsigned& nx) {
    const unsigned G = gridDim.x * gridDim.y * gridDim.z;
    unsigned sum, cnt, mine, sp = 0u;
    for (;;) {
        sum = 0u; cnt = 0u; mine = 0u;
#pragma unroll
        for (unsigned j = 0; j < 16; ++j) { const unsigned c = xb_ld(&bar[XB_XCNT(j)]); sum += c; cnt += (c > 0u) ? 1u : 0u; mine = (j == x) ? c : mine; }
        if (sum == G) break;
        __builtin_amdgcn_s_sleep(1);
        if ((++sp & 255u) == 0u) { if (xb_ld(&bar[XB_TMO])) break; if (sp > XB_SPIN_CAP) { atomicAdd(&bar[XB_TMO], 1u); break; } }
    }
    nloc = mine > 0u ? mine : 1u; nx = cnt > 0u ? cnt : 1u;
}
__device__ __forceinline__ void xcd_barrier(const XcdBarrier& b) {
    asm volatile("s_waitcnt vmcnt(0)" ::: "memory");
    __syncthreads();
    if (threadIdx.x == 0) {
        unsigned* bar = b.bar;
        __builtin_amdgcn_s_waitcnt(0);
        unsigned nloc = b.st[0], nx = b.st[1];
        if (nloc == 0u) { xcd_barrier_complete(bar, b.x, nloc, nx); b.st[0] = nloc; b.st[1] = nx; }
        const unsigned old = xb_add(&bar[XB_XSUB(b.x)], 1u);
        const unsigned gen = old / nloc;
        if (old + 1u == (gen + 1u) * nloc) {
            __builtin_amdgcn_fence(__ATOMIC_RELEASE, "agent");
            asm volatile("s_waitcnt vmcnt(0)" ::: "memory");
            const unsigned og = xb_add(&bar[XB_TOP], 1u);
            const unsigned tg = og / nx;
            if (og + 1u == (tg + 1u) * nx) xb_add(&bar[XB_TOPGEN], 1u);
            else XB_SPIN(xb_ld(&bar[XB_TOPGEN]) == tg, bar);
            __builtin_amdgcn_fence(__ATOMIC_ACQUIRE, "agent");
            xb_add(&bar[XB_XGEN(b.x)], 1u);
            asm volatile("s_waitcnt vmcnt(0)" ::: "memory");
        } else {
            XB_SPIN(xb_ld(&bar[XB_XGEN(b.x)]) == gen, bar);
            __builtin_amdgcn_fence(__ATOMIC_ACQUIRE, "agent");
            asm volatile("s_waitcnt vmcnt(0)" ::: "memory");
        }
    }
    __syncthreads();
}
namespace att {
typedef float f32x16 __attribute__((ext_vector_type(16)));
typedef short s16x4 __attribute__((ext_vector_type(4)));
constexpr int SHM_V = 16384, SHM_KN = 16384, SHM_KR = 8192;
constexpr int NKS = 3, NVS = 4;
constexpr int L_KN = 0, L_KR = L_KN + NKS * SHM_KN, L_V = L_KR + NKS * SHM_KR, L_WS = L_V + NVS * SHM_V, L_END = L_WS + 8 * 64 * 4;
static_assert(L_END <= 160 * 1024 - 1024, "attention LDS map");
constexpr float THR = 8.f;
#define KSWZ(row, chunk) ((row) * 256 + ((((chunk) ^ (row)) & 15) << 4))
#define KRSWZ(row, chunk) ((row) * 128 + ((((chunk) ^ ((row) >> 1)) & 7) << 4))
#define SBAR() __builtin_amdgcn_sched_barrier(0)
__device__ __forceinline__ int v_st(int k, int c) { const int kk = (k & ~0xC) | ((k & 4) << 1) | ((k & 8) >> 1); return ((kk >> 3) * 4 + (c >> 5)) * 512 + ((kk & 7) * 32 + (c & 31)) * 2; }
__device__ __forceinline__ int v_rd_base(int lane) { return ((lane & 3) << 3) | (((lane >> 2) & 3) << 6) | (((lane >> 4) & 1) << 5) | (((lane >> 5) & 1) << 8); }
constexpr int v_rd_off(int d0, int ks, int half) { return d0 * 512 + ks * 4096 + half * 2048; }
__device__ __forceinline__ int crow(int r, int hi) { return (r & 3) + 8 * (r >> 2) + 4 * hi; }
__device__ __forceinline__ bf16x8 pack8(f32x4 a, f32x4 b) { u32x4 w = {cvt_pk_bf16(a[0], a[1]), cvt_pk_bf16(a[2], a[3]), cvt_pk_bf16(b[0], b[1]), cvt_pk_bf16(b[2], b[3])}; return __builtin_bit_cast(bf16x8, w); }
__device__ __forceinline__ void mask_tile(f32x16& p0, f32x16& p1, int dq) {
    const float NEG = -__builtin_inff();
#pragma unroll
    for (int r = 0; r < 16; ++r) { const int c = (r & 3) + 8 * (r >> 2); if (dq - c < 0) p0[r] = NEG; if (dq - c - 32 < 0) p1[r] = NEG; }
}
__device__ __forceinline__ void partialSM(f32x16& p0, f32x16& p1, float& m_reg, float& mn, float& alpha, const float SCALE) {
    float pmax = p0[0];
#pragma unroll
    for (int r = 1; r < 16; ++r) pmax = fmaxf(pmax, p0[r]);
#pragma unroll
    for (int r = 0; r < 16; ++r) pmax = fmaxf(pmax, p1[r]);
    { auto rr = __builtin_amdgcn_permlane32_swap(__float_as_uint(pmax), __float_as_uint(pmax), false, false);
      pmax = fmaxf(__uint_as_float(rr[0]), __uint_as_float(rr[1])); }
    const float C2 = 1.4426950408889634f * SCALE;
    if (__builtin_expect(__all((pmax - m_reg) * SCALE <= THR), 1)) { mn = m_reg; alpha = 1.f; }
    else { mn = fmaxf(m_reg, pmax); alpha = __builtin_amdgcn_exp2f((m_reg - mn) * C2); m_reg = mn; }
    const float mnL = -mn * C2;
#pragma unroll
    for (int r = 0; r < 16; ++r) p0[r] = fmaf(p0[r], C2, mnL);
#pragma unroll
    for (int r = 0; r < 16; ++r) p1[r] = fmaf(p1[r], C2, mnL);
#pragma unroll
    for (int r = 0; r < 16; ++r) p0[r] = __builtin_amdgcn_exp2f(p0[r]);
}
__device__ __forceinline__ void finishSM(f32x16& p0, f32x16& p1, float alpha, float& l_reg, bf16x8& pa0, bf16x8& pa1, bf16x8& pa2, bf16x8& pa3) {
#pragma unroll
    for (int r = 0; r < 16; ++r) p1[r] = __builtin_amdgcn_exp2f(p1[r]);
    float ps = 0;
#pragma unroll
    for (int r = 0; r < 16; ++r) ps += p0[r];
#pragma unroll
    for (int r = 0; r < 16; ++r) ps += p1[r];
    { auto rr = __builtin_amdgcn_permlane32_swap(__float_as_uint(ps), __float_as_uint(ps), false, false);
      ps = __uint_as_float(rr[0]) + __uint_as_float(rr[1]); }
    l_reg = l_reg * alpha + ps;
#define PK4(P, B_, OUT) do { unsigned a0 = cvt_pk_bf16(P[B_+0], P[B_+1]), a1 = cvt_pk_bf16(P[B_+2], P[B_+3]);                          \
        unsigned b0 = cvt_pk_bf16(P[B_+4], P[B_+5]), b1 = cvt_pk_bf16(P[B_+6], P[B_+7]);                                             \
        auto r0 = __builtin_amdgcn_permlane32_swap(a0, b0, false, false); auto r1 = __builtin_amdgcn_permlane32_swap(a1, b1, false, false); \
        u32x4 w = {r0[0], r1[0], r0[1], r1[1]}; OUT = __builtin_bit_cast(bf16x8, w); } while (0)
    PK4(p0, 0, pa0); PK4(p0, 8, pa1); PK4(p1, 0, pa2); PK4(p1, 8, pa3);
#undef PK4
}
__device__ __forceinline__ void staticSM(f32x16& p0, f32x16& p1, float& l_reg, bf16x8& pa0, bf16x8& pa1, bf16x8& pa2, bf16x8& pa3) {
#pragma unroll
    for (int r = 0; r < 16; ++r) p0[r] = __builtin_amdgcn_exp2f(p0[r]);
#pragma unroll
    for (int r = 0; r < 16; ++r) p1[r] = __builtin_amdgcn_exp2f(p1[r]);
    float ps = 0;
#pragma unroll
    for (int r = 0; r < 16; ++r) ps += p0[r];
#pragma unroll
    for (int r = 0; r < 16; ++r) ps += p1[r];
    { auto rr = __builtin_amdgcn_permlane32_swap(__float_as_uint(ps), __float_as_uint(ps), false, false);
      ps = __uint_as_float(rr[0]) + __uint_as_float(rr[1]); }
    l_reg += ps;
#define PK4(P, B_, OUT) do { unsigned a0 = cvt_pk_bf16(P[B_+0], P[B_+1]), a1 = cvt_pk_bf16(P[B_+2], P[B_+3]);                          \
        unsigned b0 = cvt_pk_bf16(P[B_+4], P[B_+5]), b1 = cvt_pk_bf16(P[B_+6], P[B_+7]);                                             \
        auto r0 = __builtin_amdgcn_permlane32_swap(a0, b0, false, false); auto r1 = __builtin_amdgcn_permlane32_swap(a1, b1, false, false); \
        u32x4 w = {r0[0], r1[0], r0[1], r1[1]}; OUT = __builtin_bit_cast(bf16x8, w); } while (0)
    PK4(p0, 0, pa0); PK4(p0, 8, pa1); PK4(p1, 0, pa2); PK4(p1, 8, pa3);
#undef PK4
}
template <int NR>
__device__ __forceinline__ void qkt(f32x16& p0, f32x16& p1, const int (&kaddr)[8], const int (&raddr)[4], const bf16x8* qr, const float init) {
#pragma unroll
    for (int r = 0; r < 16; ++r) { p0[r] = init; p1[r] = init; }
    bf16x8 a0, a1, a2, a3, b0, b1, b2, b3;
#define KRD(dst, addr, off) asm volatile("ds_read_b128 %0, %1 offset:%2" : "=&v"(dst) : "v"(addr), "i"(off) : "memory")
#define KLD(d, x0, x1) do { if ((d) < 8) { KRD(x0, kaddr[(d) & 7], 0); KRD(x1, kaddr[(d) & 7], 8192); } else { KRD(x0, raddr[((d) - 8) & 3], 0); KRD(x1, raddr[((d) - 8) & 3], 4096); } } while (0)
#define KWAIT(n) do { asm volatile("s_waitcnt lgkmcnt(" #n ")" : "+v"(a0), "+v"(a1), "+v"(a2), "+v"(a3), "+v"(b0), "+v"(b1), "+v"(b2), "+v"(b3) :: "memory"); SBAR(); } while (0)
#define KMMA(d, x0, x1) do { p0 = __builtin_amdgcn_mfma_f32_32x32x16_bf16(x0, qr[d], p0, 0, 0, 0); p1 = __builtin_amdgcn_mfma_f32_32x32x16_bf16(x1, qr[d], p1, 0, 0, 0); } while (0)
    constexpr int NS = 8 + NR;
    KLD(0, a0, a1); KLD(1, a2, a3); KLD(2, b0, b1); KLD(3, b2, b3);
    KWAIT(4); KMMA(0, a0, a1); KMMA(1, a2, a3); KLD(4, a0, a1); KLD(5, a2, a3);
    KWAIT(4); KMMA(2, b0, b1); KMMA(3, b2, b3); KLD(6, b0, b1); KLD(7, b2, b3);
    if constexpr (NS > 8) {
        KWAIT(4); KMMA(4, a0, a1); KMMA(5, a2, a3); KLD(8, a0, a1); KLD(9, a2, a3);
        KWAIT(4); KMMA(6, b0, b1); KMMA(7, b2, b3); KLD(10, b0, b1); KLD(11, b2, b3);
        KWAIT(4); KMMA(8, a0, a1); KMMA(9, a2, a3);
        KWAIT(0); KMMA(10, b0, b1); KMMA(11, b2, b3);
    } else {
        KWAIT(4); KMMA(4, a0, a1); KMMA(5, a2, a3);
        KWAIT(0); KMMA(6, b0, b1); KMMA(7, b2, b3);
    }
#undef KMMA
#undef KWAIT
#undef KLD
#undef KRD
}
__device__ __forceinline__ void pv_tile(f32x16* o, int vb0  , bf16x8 pa0, bf16x8 pa1, bf16x8 pa2, bf16x8 pa3) {
#define TRRD(dst, off) asm volatile("ds_read_b64_tr_b16 %0, %1 offset:%2" : "=&v"(dst) : "v"(vb0), "i"(off) : "memory")
#define PV_LOAD(L, H, ks) do { constexpr int b_ = (ks) * 4096; \
        TRRD(L[0], b_); TRRD(H[0], b_ + 2048); TRRD(L[1], b_ + 512); TRRD(H[1], b_ + 512 + 2048); TRRD(L[2], b_ + 1024); TRRD(H[2], b_ + 1024 + 2048); TRRD(L[3], b_ + 1536); TRRD(H[3], b_ + 1536 + 2048); } while (0)
#define PV_WAIT(n) do { asm volatile("s_waitcnt lgkmcnt(" #n ")" : "+v"(la[0]), "+v"(ha[0]), "+v"(la[1]), "+v"(ha[1]), "+v"(la[2]), "+v"(ha[2]), "+v"(la[3]), "+v"(ha[3]), "+v"(lb[0]), "+v"(hb[0]), "+v"(lb[1]), "+v"(hb[1]), "+v"(lb[2]), "+v"(hb[2]), "+v"(lb[3]), "+v"(hb[3]) :: "memory"); SBAR(); } while (0)
#define PV_MMA(pa, L, H) do { _Pragma("unroll") for (int d0 = 0; d0 < 4; ++d0) \
        o[d0] = __builtin_amdgcn_mfma_f32_32x32x16_bf16(pa, (bf16x8){L[d0][0], L[d0][1], L[d0][2], L[d0][3], H[d0][0], H[d0][1], H[d0][2], H[d0][3]}, o[d0], 0, 0, 0); } while (0)
    s16x4 la[4], ha[4], lb[4], hb[4];
    PV_LOAD(la, ha, 0); PV_LOAD(lb, hb, 1);
    PV_WAIT(8); PV_MMA(pa0, la, ha);
    PV_LOAD(la, ha, 2);
    PV_WAIT(8); PV_MMA(pa1, lb, hb);
    PV_LOAD(lb, hb, 3);
    PV_WAIT(8); PV_MMA(pa2, la, ha);
    PV_WAIT(0); PV_MMA(pa3, lb, hb);
#undef PV_MMA
#undef PV_WAIT
#undef PV_LOAD
#undef TRRD
}

struct ABlk { const bf16* Q; const bf16* Kn; const bf16* Kr; const bf16* V; bf16* O; int NT, P0; };
template <int NR, bool CAUSAL, int QMODE, class Get>
__device__ __forceinline__ void attn_blocks(LAS char* lds, const Get& get, const int nblk, int ldq, int ldk, int ldv, int ldo,
                                            const float SCALE, const float BND  , const float* qgain, const float* qgain2, const float* rope, const bool dry = false) {
    if (nblk <= 0) return;
    int tid_ = threadIdx.x; asm volatile("" : "+v"(tid_));
    const int tid = tid_, wid = __builtin_amdgcn_readfirstlane(tid >> 6), lane = tid & 63, r32 = lane & 31, hi = lane >> 5;
#ifndef ATT_STAGGER
#define ATT_STAGGER 1
#endif
    const bool late = ATT_STAGGER && wid >= 4;
#ifndef ABL
#define ABL 0
#endif
#ifndef ATT_PRIO
#define ATT_PRIO 1
#endif
    const int abl = dry ? ABL : 0;
    constexpr int NOPS = 4 + (NR > 0 ? 1 : 0);
    int so_k[2], so_v[2], so_r = 0;
#pragma unroll
    for (int i = 0; i < 2; ++i) {
        const int p = 2 * wid + i;
        { const int row = 4 * p + (lane >> 4), c = (lane ^ row) & 15; so_k[i] = row * ldk + c * 8; }
        { const int st = 2 * p + (lane >> 5), kk = (st >> 2) * 8 + ((lane & 31) >> 2), key = (kk & ~0xC) | ((kk & 4) << 1) | ((kk & 8) >> 1), col = (st & 3) * 32 + (lane & 3) * 8; so_v[i] = key * ldv + col; }
    }
    if constexpr (NR > 0) { const int row = 8 * wid + (lane >> 3), c = ((lane & 7) ^ (row >> 1)) & 7; so_r = row * 64 + c * 8; }
#define DMA16(gp, loff) __builtin_amdgcn_global_load_lds((const unsigned*)(gp), (LAS unsigned*)(lds + (loff)), 16, 0, 0)
#define ISSUE(Kn_, Kr_, V_, tile, ks_, vs_) do { const int k0_ = (tile) * 64; \
        DMA16((Kn_) + (size_t)k0_ * ldk + so_k[0], L_KN + (ks_) * SHM_KN + (2 * wid) * 1024); DMA16((Kn_) + (size_t)k0_ * ldk + so_k[1], L_KN + (ks_) * SHM_KN + (2 * wid + 1) * 1024); \
        if constexpr (NR > 0) DMA16((Kr_) + (size_t)k0_ * 64 + so_r, L_KR + (ks_) * SHM_KR + wid * 1024); \
        DMA16((V_) + (size_t)k0_ * ldv + so_v[0], L_V + (vs_) * SHM_V + (2 * wid) * 1024); DMA16((V_) + (size_t)k0_ * ldv + so_v[1], L_V + (vs_) * SHM_V + (2 * wid + 1) * 1024); } while (0)
#define LOADQ(Qp) do { _Pragma("unroll") for (int d0 = 0; d0 < 8 + NR; ++d0) qr[d0] = *(const bf16x8*)((Qp) + (size_t)(wid * 32 + r32) * ldq + d0 * 16 + hi * 8); } while (0)
    ABlk cur; get(0, cur);
    ISSUE(cur.Kn, cur.Kr, cur.V, 0, 0, 0); ISSUE(cur.Kn, cur.Kr, cur.V, 1, 1, 1);
    bf16x8 qr[8 + NR];
    LOADQ(cur.Q);
    int ks = 0, vs = 0;
    LAS float* ws = (LAS float*)(lds + L_WS) + wid * 64; LAS float* li_l = ws; LAS float* al_l = ws + 32;
    int kbase[8], krbase[4];
#pragma unroll
    for (int d0 = 0; d0 < 8; ++d0) kbase[d0] = KSWZ(r32, 2 * d0 + hi);
#pragma unroll
    for (int dr = 0; dr < 4; ++dr) krbase[dr] = KRSWZ(r32, 2 * dr + hi);
    const int vrd = (int)(uintptr_t)lds + L_V + v_rd_base(lane), kn0 = (int)(uintptr_t)lds + L_KN, kr0 = (int)(uintptr_t)lds + L_KR;
    for (int bn = 0; bn < nblk; ++bn) {
    const bool has_next = bn + 1 < nblk; ABlk nxt = cur; if (has_next) get(bn + 1, nxt);
    const int NT = cur.NT, P0 = cur.P0; bf16* const O = cur.O;
    asm volatile("s_waitcnt vmcnt(0)" ::: "memory");
    if constexpr (QMODE >= 1) {
        float ss = 0.f;
#pragma unroll
        for (int d0 = 0; d0 < 8; ++d0)
#pragma unroll
            for (int e = 0; e < 8; ++e) { const float v = bf2f((bf16)qr[d0][e]); ss += v * v; }
        { auto rr = __builtin_amdgcn_permlane32_swap(__float_as_uint(ss), __float_as_uint(ss), false, false); ss = __uint_as_float(rr[0]) + __uint_as_float(rr[1]); }
        const float rstdc = (1.0f / sqrtf(ss * (1.f / 128.f) + EPS)) * (1.4426950408889634f * SCALE);
#pragma unroll
        for (int d0 = 0; d0 < 8; ++d0) { const f32x4 g0 = *(const f32x4*)(qgain + d0 * 16 + hi * 8), g1 = *(const f32x4*)(qgain + d0 * 16 + hi * 8 + 4); f32x4 a, b;
#pragma unroll
            for (int e = 0; e < 4; ++e) { a[e] = bf2f((bf16)qr[d0][e]) * rstdc * g0[e]; b[e] = bf2f((bf16)qr[d0][4 + e]) * rstdc * g1[e]; }
            qr[d0] = pack8(a, b); }
    }
    if constexpr (QMODE == 2 && NR == 4) {
        float ss = 0.f;
#pragma unroll
        for (int d0 = 8; d0 < 12; ++d0)
#pragma unroll
            for (int e = 0; e < 8; ++e) { const float v = bf2f((bf16)qr[d0][e]); ss += v * v; }
        { auto rr = __builtin_amdgcn_permlane32_swap(__float_as_uint(ss), __float_as_uint(ss), false, false); ss = __uint_as_float(rr[0]) + __uint_as_float(rr[1]); }
        const float rstd = (1.0f / sqrtf(ss * (1.f / 64.f) + EPS)) * (1.4426950408889634f * SCALE);
        const int pos = P0 + wid * 32 + r32;
#pragma unroll
        for (int dd = 0; dd < 2; ++dd) {
            const float* cp = rope + pos * 32 + dd * 16 + hi * 8; const float* sp = cp + SEQ * 32;
            const float* g1 = qgain2 + dd * 16 + hi * 8; const float* g2 = g1 + 32;
            f32x4 a, b, c, d;
#pragma unroll
            for (int e = 0; e < 8; ++e) { const float t1 = bf2f((bf16)qr[8 + dd][e]) * rstd * g1[e], t2 = bf2f((bf16)qr[10 + dd][e]) * rstd * g2[e], cs = cp[e], sn = sp[e];
                const float n1 = t1 * cs - t2 * sn, n2 = t1 * sn + t2 * cs;
                if (e < 4) { a[e] = n1; c[e] = n2; } else { b[e - 4] = n1; d[e - 4] = n2; } }
            qr[8 + dd] = pack8(a, b); qr[10 + dd] = pack8(c, d); }
    }
    float m_reg = -1e30f, l_reg = 0.f; f32x16 o[4] = {};
    const int qlo = P0 + wid * 32, qm = qlo + r32 - 4 * hi;
#define RESC(a) do { if (__any((a) < 1.f)) { if (hi == 0) al_l[r32] = (a); asm volatile("s_waitcnt lgkmcnt(0)" ::: "memory");              \
        _Pragma("unroll") for (int d_ = 0; d_ < 4; ++d_) _Pragma("unroll") for (int r = 0; r < 16; ++r) o[d_][r] *= al_l[crow(r, hi)]; } } while (0)
    f32x16 p0, p1; float mn, al; bf16x8 pa0, pa1, pa2, pa3;
    const float pinit = 0.f;
    asm volatile("s_waitcnt vmcnt(0)" ::: "memory");
    for (int t = 0; t < NT; ++t) {
        if constexpr (NOPS == 5) asm volatile("s_waitcnt vmcnt(5)" ::: "memory"); else asm volatile("s_waitcnt vmcnt(4)" ::: "memory");
        asm volatile("s_waitcnt lgkmcnt(0)" ::: "memory"); if (abl != 4 && abl != 5) __builtin_amdgcn_s_barrier(); asm volatile("" ::: "memory");
        if (abl != 5) { int tn = t + 2; const bf16* kn_ = cur.Kn; const bf16* kr_ = cur.Kr; const bf16* v_ = cur.V;
          if (tn >= NT) { if (has_next) { tn -= NT; kn_ = nxt.Kn; kr_ = nxt.Kr; v_ = nxt.V; } else tn = NT - 1; }
          int ks2 = ks + 2; if (ks2 >= NKS) ks2 -= NKS; int vs2 = vs + 2; if (vs2 >= NVS) vs2 -= NVS;
          ISSUE(kn_, kr_, v_, tn, ks2, vs2); }
        const int kb_ = t * 64;
        if (late && t > 0 && abl != 2) { int vp = vs - 1; if (vp < 0) vp += NVS; SBAR(); __builtin_amdgcn_s_setprio(ATT_PRIO); pv_tile(o, vrd + vp * SHM_V, pa0, pa1, pa2, pa3); __builtin_amdgcn_s_setprio(0); }
        { int kaddr[8], raddr[4];
#pragma unroll
          for (int d0 = 0; d0 < 8; ++d0) kaddr[d0] = kn0 + ks * SHM_KN + kbase[d0];
#pragma unroll
          for (int dr = 0; dr < 4; ++dr) raddr[dr] = kr0 + ks * SHM_KR + krbase[dr];
          SBAR(); __builtin_amdgcn_s_setprio(ATT_PRIO); if (abl != 3) qkt<NR>(p0, p1, kaddr, raddr, qr, pinit); else { p0 = f32x16{}; p1 = f32x16{}; } __builtin_amdgcn_s_setprio(0); }
        if (CAUSAL && kb_ + 63 > qlo) mask_tile(p0, p1, qm - kb_);
        if (abl != 1) { if (BND > 0.f) staticSM(p0, p1, l_reg, pa0, pa1, pa2, pa3);
                        else { partialSM(p0, p1, m_reg, mn, al, 0.6931471805599453f); finishSM(p0, p1, al, l_reg, pa0, pa1, pa2, pa3); RESC(al); } }
        else { u32x4 w0 = {cvt_pk_bf16(p0[0], p0[1]), cvt_pk_bf16(p0[2], p0[3]), cvt_pk_bf16(p0[4], p0[5]), cvt_pk_bf16(p0[6], p0[7])}, w1 = {cvt_pk_bf16(p0[8], p0[9]), cvt_pk_bf16(p0[10], p0[11]), cvt_pk_bf16(p0[12], p0[13]), cvt_pk_bf16(p0[14], p0[15])},
                     w2 = {cvt_pk_bf16(p1[0], p1[1]), cvt_pk_bf16(p1[2], p1[3]), cvt_pk_bf16(p1[4], p1[5]), cvt_pk_bf16(p1[6], p1[7])}, w3 = {cvt_pk_bf16(p1[8], p1[9]), cvt_pk_bf16(p1[10], p1[11]), cvt_pk_bf16(p1[12], p1[13]), cvt_pk_bf16(p1[14], p1[15])};
               pa0 = __builtin_bit_cast(bf16x8, w0); pa1 = __builtin_bit_cast(bf16x8, w1); pa2 = __builtin_bit_cast(bf16x8, w2); pa3 = __builtin_bit_cast(bf16x8, w3); l_reg = 1.f; }
        SBAR();
        if (!late && abl != 2) { __builtin_amdgcn_s_setprio(ATT_PRIO); pv_tile(o, vrd + vs * SHM_V, pa0, pa1, pa2, pa3); __builtin_amdgcn_s_setprio(0); }
        if (++ks == NKS) ks = 0; if (++vs == NVS) vs = 0;
    }
    if (late) { int vp = vs - 1; if (vp < 0) vp += NVS; SBAR(); pv_tile(o, vrd + vp * SHM_V, pa0, pa1, pa2, pa3); }
    if (has_next) LOADQ(nxt.Q);
    if (hi == 0) li_l[r32] = l_reg;
    asm volatile("s_waitcnt lgkmcnt(0)" ::: "memory");
    { bf16* Ow = O + (size_t)(wid * 32) * ldo;
      const bool b0 = (r32 & 1) != 0, b1 = (r32 & 2) != 0;
#define QX1(v) __int_as_float(__builtin_amdgcn_update_dpp(0, __float_as_int(v), 0xB1, 0xf, 0xf, true))
#define QX2(v) __int_as_float(__builtin_amdgcn_update_dpp(0, __float_as_int(v), 0x4E, 0xf, 0xf, true))
#pragma unroll
      for (int rg = 0; rg < 4; ++rg) {
          float rl[4];
#pragma unroll
          for (int k = 0; k < 4; ++k) rl[k] = __builtin_amdgcn_rcpf(li_l[8 * rg + 4 * hi + k]);
          bf16* rowp = Ow + (size_t)(8 * rg + 4 * hi + (r32 & 3)) * ldo + (r32 & ~3);
#pragma unroll
          for (int d0 = 0; d0 < 4; ++d0) {
              float x0 = o[d0][4 * rg + 0] * rl[0], x1 = o[d0][4 * rg + 1] * rl[1], x2 = o[d0][4 * rg + 2] * rl[2], x3 = o[d0][4 * rg + 3] * rl[3];
              { const float s = b0 ? x0 : x1, rv = QX1(s); const float n0 = b0 ? rv : x0, n1 = b0 ? x1 : rv; x0 = n0; x1 = n1; }
              { const float s = b0 ? x2 : x3, rv = QX1(s); const float n2 = b0 ? rv : x2, n3 = b0 ? x3 : rv; x2 = n2; x3 = n3; }
              { const float s = b1 ? x0 : x2, rv = QX2(s); const float n0 = b1 ? rv : x0, n2 = b1 ? x2 : rv; x0 = n0; x2 = n2; }
              { const float s = b1 ? x1 : x3, rv = QX2(s); const float n1 = b1 ? rv : x1, n3 = b1 ? x3 : rv; x1 = n1; x3 = n3; }
              u32x2 w; w.x = cvt_pk_bf16(x0, x1); w.y = cvt_pk_bf16(x2, x3);
              if (!dry) *(u32x2*)(rowp + d0 * 32) = w; } }
#undef QX1
#undef QX2
    }
    cur = nxt;
    }
    asm volatile("s_waitcnt vmcnt(0) lgkmcnt(0)" ::: "memory"); __builtin_amdgcn_s_barrier(); asm volatile("" ::: "memory");
#undef LOADQ
#undef DMA16
#undef ISSUE
#undef RESC
}
}
constexpr int NWAVES = 8;
constexpr int RING_OFF = 0, RING_BYTES = 131072;
constexpr int XTRA_OFF = RING_BYTES, XTRA_BYTES = 32256;
constexpr int MISC_OFF = XTRA_OFF + XTRA_BYTES;
constexpr int LDS_BYTES = MISC_OFF + 512;
static_assert(LDS_BYTES == 163840, "LDS map");

constexpr size_t WB_GU0 = 0, WB_D0 = 11 * MiB, WB_GU1 = WB_D0 + (size_t)DM * FF * 2, WB_D1 = WB_GU1 + 11 * MiB, WB_WO = 33 * MiB, WB_IN = 36 * MiB, WB_UQ = 43 * MiB, WB_UKV = 45 * MiB;
static_assert(WB_D1 + (size_t)DM * FF * 2 <= WB_WO && WB_UKV + 1 * MiB <= 52 * MiB && WS_WB + 52 * MiB <= WS_XN, "weight map");
constexpr size_t WS_MEMW = WS_BIG;

constexpr int CW_BAR = 4096;
constexpr size_t WS_RS = 78 * MiB;
constexpr size_t CTL_ZERO_BYTES = 1 * MiB;
static_assert(WS_WB + 46 * MiB <= WS_RS && WS_RS + 12 * (size_t)M * 16 <= WS_XN, "row sums sit between the weight copies and XN");

struct MArgs { const float* in[29]; float* out; unsigned char* ws; int lo, hi, region, pad; };
static_assert(sizeof(MArgs) == 264, "no padding in the argument struct");

struct Frame {
    LAS unsigned char* lds;
    int vcu, G;
    float* X; unsigned char* ws; bf16* OC;
};
#define PH_IDS() int tid_ = threadIdx.x; asm volatile("" : "+v"(tid_)); const int tid = tid_, lane = tid & 63, wave = __builtin_amdgcn_readfirstlane(tid >> 6); (void)tid; (void)lane; (void)wave

__device__ __forceinline__ void tr_item(const float* W, int ldw, int scol, int k0, bf16* WT, int K, int drow, LAS float* scr, int lane, int nv, const float* gain) {
    const int c = lane & 7;
    if (nv == 0) {
#pragma unroll
        for (int j = 0; j < 4; ++j) { const int n = (lane >> 3) + 8 * j; *(GAS u32x4*)(WT + (size_t)(drow + n) * K + k0 + 8 * c) = (u32x4){0u, 0u, 0u, 0u}; }
        return;
    }
    const int n4 = (lane & 7) * 4, kq = lane >> 3;
    const GAS float* Wg = (const GAS float*)W + (size_t)(k0 + kq) * ldw + scol + n4;
    const bool val = n4 < nv;
    f32x4 wv[8];
#pragma unroll
    for (int i = 0; i < 8; ++i) wv[i] = val ? *(const GAS f32x4*)(Wg + (size_t)(8 * i) * ldw) : (f32x4){0.f, 0.f, 0.f, 0.f};
#pragma unroll
    for (int i = 0; i < 8; ++i) { LAS float* d = scr + (kq + 8 * i) * 33 + n4; d[0] = wv[i].x; d[1] = wv[i].y; d[2] = wv[i].z; d[3] = wv[i].w; }
    f32x4 g0 = (f32x4){1.f, 1.f, 1.f, 1.f}, g1 = g0;
    if (gain) { g0 = *(const GAS f32x4*)(gain + k0 + 8 * c); g1 = *(const GAS f32x4*)(gain + k0 + 8 * c + 4); }
    LDS_WAIT(); asm volatile("" ::: "memory");
#pragma unroll
    for (int j = 0; j < 4; ++j) { const int n = (lane >> 3) + 8 * j; const LAS float* s = scr + (8 * c) * 33 + n;
        u32x4 o; o.x = cvt_pk_bf16(s[0 * 33] * g0[0], s[1 * 33] * g0[1]); o.y = cvt_pk_bf16(s[2 * 33] * g0[2], s[3 * 33] * g0[3]); o.z = cvt_pk_bf16(s[4 * 33] * g1[0], s[5 * 33] * g1[1]); o.w = cvt_pk_bf16(s[6 * 33] * g1[2], s[7 * 33] * g1[3]);
        *(GAS u32x4*)(WT + (size_t)(drow + n) * K + k0 + 8 * c) = o; }
    LDS_WAIT(); asm volatile("" ::: "memory");
}

__device__ __forceinline__ void norm_row(const float* xrow, const f32x4 (&gg)[4], bf16* orow, int lane, f32x4 (&v)[4]) {
    const GAS f32x4* xr = (const GAS f32x4*)xrow + lane; float s = 0.f;
#pragma unroll
    for (int j = 0; j < 4; ++j) { v[j] = xr[64 * j]; s += (v[j].x * v[j].x + v[j].y * v[j].y) + (v[j].z * v[j].z + v[j].w * v[j].w); }
    const float rstd = 1.0f / sqrtf(wave_sum(s) * (1.f / DM) + EPS);
    GAS u32x2* o8 = (GAS u32x2*)orow + lane;
#pragma unroll
    for (int j = 0; j < 4; ++j) { v[j] = v[j] * rstd * gg[j]; u32x2 w; w.x = cvt_pk_bf16(v[j].x, v[j].y); w.y = cvt_pk_bf16(v[j].z, v[j].w); o8[64 * j] = w; }
}

__device__ __forceinline__ void raw_row(const float* xrow, bf16* orow, float* rs_out, int lane) {
    const GAS f32x4* xr = (const GAS f32x4*)xrow + lane; f32x4 v[4]; float s = 0.f;
#pragma unroll
    for (int j = 0; j < 4; ++j) { v[j] = xr[64 * j]; s += (v[j].x * v[j].x + v[j].y * v[j].y) + (v[j].z * v[j].z + v[j].w * v[j].w); }
    s = wave_sum(s);
    GAS u32x2* o8 = (GAS u32x2*)orow + lane;
#pragma unroll
    for (int j = 0; j < 4; ++j) { u32x2 w; w.x = cvt_pk_bf16(v[j].x, v[j].y); w.y = cvt_pk_bf16(v[j].z, v[j].w); o8[64 * j] = w; }
    if (lane == 0) *(GAS f32x4*)rs_out = (f32x4){s, 0.f, 0.f, 0.f};
}
__device__ __forceinline__ void ph_prologue(Frame& F, const float* x, const float* mem, const float* mn, const float* memw) {
    PH_IDS();
    const int gt = F.vcu * 512 + tid, NT = F.G * 512, gw = F.vcu * NWAVES + wave, NGW = F.G * NWAVES;
    { bf16* XB = (bf16*)(F.ws + WS_XN); float* RS0 = (float*)(F.ws + WS_RS);
      for (int m = gw; m < M; m += NGW) raw_row(x + (size_t)m * DM, XB + (size_t)m * DM, RS0 + (size_t)m * 4, lane); }
    { float* cs = (float*)(F.ws + WS_ROPE);
      const int f = gt & 31; const float ex = (float)(2 * f) / 64.0f; const float inv = (float)(1.0 / pow(10000.0, (double)ex));
      for (int i = gt; i < SEQ * 32; i += NT) { const int pos = i >> 5; const float ang = (float)pos * inv; float sn, cn; sincosf(ang, &sn, &cn);
          cs[i] = cn; cs[SEQ * 32 + i] = sn; } }
    { bf16* MEMH = (bf16*)(F.ws + WS_MEMH);
      for (int r = gw; r < 4 * 1024; r += NGW) { const int l = r >> 10, row = r & 1023; f32x4 gg[4], v[4];
#pragma unroll
          for (int j = 0; j < 4; ++j) gg[j] = ((const f32x4*)(mn + l * DM))[lane + 64 * j];
          norm_row(mem + (size_t)row * DM, gg, MEMH + (size_t)r * DM, lane, v); } }
    { LAS float* scr = (LAS float*)(F.lds + RING_OFF + wave * 16384); bf16* MW = (bf16*)(F.ws + WS_MEMW);
      for (int it = gw; it < 4 * 512; it += NGW) { const int l = it >> 9, r = it & 511, kb = r >> 5, nb = r & 31;
          tr_item(memw + (size_t)l * DM * DM, DM, 32 * nb, 64 * kb, MW + (size_t)l * DM * DM, DM, 32 * nb, scr, lane, 32, nullptr); } }
}
__device__ __forceinline__ void ph_memknorm(Frame& F, const float* memk_norm) {
    PH_IDS();
    const int gw = F.vcu * NWAVES + wave, NGW = F.G * NWAVES; bf16* KVm = (bf16*)(F.ws + WS_MEMKV);
    for (int idx = gw; idx < 4096 * 4; idx += NGW) { const int row = idx >> 2, h = idx & 3, l = row >> 10;
        bf16* p = KVm + (size_t)row * 1024 + h * 128 + lane * 2; const float* g = memk_norm + l * 128;
        const float a = bf2f(p[0]), b = bf2f(p[1]);
        const float rstd = 1.0f / sqrtf(wave_sum(a * a + b * b) * (1.f / 128.f) + EPS);
        *(GAS unsigned*)p = cvt_pk_bf16(a * rstd * g[lane * 2], b * rstd * g[lane * 2 + 1]); }
}
struct ConvPtrs { const float *g0, *u0, *d0, *g1, *u1, *d1, *wo, *gin, *min, *uq, *ukv, *n1, *n2, *nm; };
template <int MAP>
__device__ __forceinline__ void conv_job(Frame& F, const float* W, int ldw, int nkb, int nblk, bf16* dst, int K, int& rot, LAS float* scr, int wave, int lane, const float* gain) {
    const int NGW = F.G * NWAVES; int gw = F.vcu * NWAVES + wave - rot; if (gw < 0) gw += NGW;
    const int total = nkb * nblk;
    for (int r = gw; r < total; r += NGW) {
        const int kb = r / nblk, nb = r - kb * nblk; int scol = 32 * nb, drow = 32 * nb, nv = 32;
        if (MAP == 1) drow = 32 * ((nb >> 2) * 8 + (nb & 3));
        if (MAP == 2) drow = 32 * ((nb >> 2) * 8 + 4 + (nb & 3));
        if (MAP == 3) { scol = drow < 1024 ? drow : drow < 2048 ? drow + 1040 : drow < 3072 ? drow - 1024 : drow < 3584 ? drow + 16 : 2048; nv = drow < 3584 ? 32 : drow == 3584 ? 16 : 0; }
        if (MAP == 4) nv = drow >= MLA_IN ? 0 : 32;
        tr_item(W, ldw, scol, 64 * kb, dst, K, drow, scr, lane, nv, gain);
    }
    rot = (rot + total) % NGW;
}
__device__ __forceinline__ void conv_layer(Frame& F, int i, const ConvPtrs& cp) {
    PH_IDS();
    const int j = i >> 1; const bool gla = !(i & 1);
    LAS float* scr = (LAS float*)(F.lds + RING_OFF + wave * 16384);
    unsigned char* wb = F.ws + WS_WB; int rot = 0;
    conv_job<1>(F, cp.g0 + (size_t)i * DM * FF, FF, 16, 88, (bf16*)(wb + WB_GU0), DM, rot, scr, wave, lane, cp.n1 + i * DM);
    conv_job<2>(F, cp.u0 + (size_t)i * DM * FF, FF, 16, 88, (bf16*)(wb + WB_GU0), DM, rot, scr, wave, lane, cp.n1 + i * DM);
    conv_job<1>(F, cp.g1 + (size_t)i * DM * FF, FF, 16, 88, (bf16*)(wb + WB_GU1), DM, rot, scr, wave, lane, cp.n2 + i * DM);
    conv_job<2>(F, cp.u1 + (size_t)i * DM * FF, FF, 16, 88, (bf16*)(wb + WB_GU1), DM, rot, scr, wave, lane, cp.n2 + i * DM);
    conv_job<0>(F, cp.d0 + (size_t)i * FF * DM, DM, 44, 32, (bf16*)(wb + WB_D0), FF, rot, scr, wave, lane, nullptr);
    conv_job<0>(F, cp.d1 + (size_t)i * FF * DM, DM, 44, 32, (bf16*)(wb + WB_D1), FF, rot, scr, wave, lane, nullptr);
    conv_job<0>(F, cp.wo + (size_t)i * 1536 * DM, DM, 24, 32, (bf16*)(wb + WB_WO), 1536, rot, scr, wave, lane, nullptr);
    if (gla) conv_job<3>(F, cp.gin + (size_t)j * DM * GLA_IN, GLA_IN, 16, 120, (bf16*)(wb + WB_IN), DM, rot, scr, wave, lane, cp.nm + i * DM);
    else {
        conv_job<4>(F, cp.min + (size_t)j * DM * MLA_IN, MLA_IN, 16, 40, (bf16*)(wb + WB_IN), DM, rot, scr, wave, lane, cp.nm + i * DM);
        conv_job<0>(F, cp.uq + (size_t)j * 384 * QW, QW, 6, 48, (bf16*)(wb + WB_UQ), 384, rot, scr, wave, lane, nullptr);
        conv_job<0>(F, cp.ukv + (size_t)j * 256 * KVW, KVW, 4, 64, (bf16*)(wb + WB_UKV), 256, rot, scr, wave, lane, nullptr);
    }
}
__device__ __forceinline__ void ph_mla_rowprep(Frame& F, const float* gq, const float* gkv, const float* gkr, const bool dry = false) {
    PH_IDS();
    const int gw = F.vcu * NWAVES + wave, NGW = F.G * NWAVES;
    bf16* P = (bf16*)(F.ws + WS_PM); bf16* KR = (bf16*)(F.ws + WS_KR); const float* rope = (const float*)(F.ws + WS_ROPE);
    f32x4 ga[2], gb[2];
    { const float* g = lane < 48 ? gq + 8 * lane : gkv + 8 * (lane - 48); ga[0] = *(const f32x4*)g; ga[1] = *(const f32x4*)(g + 4); }
    { const float* g = lane < 16 ? gkv + 8 * (16 + lane) : gkr + 8 * ((lane - 16) & 7); gb[0] = *(const f32x4*)g; gb[1] = *(const f32x4*)(g + 4); }
    for (int m = gw; m < M; m += NGW) {
        bf16* p = P + (size_t)m * PM;
        const bf16x8 c0 = *(const bf16x8*)(p + 8 * lane);
        bf16x8 c1 = (bf16x8){0, 0, 0, 0, 0, 0, 0, 0}; if (lane < 24) c1 = *(const bf16x8*)(p + 512 + 8 * lane);
        float a[8], b[8]; float s0 = 0.f, s1 = 0.f;
#pragma unroll
        for (int e = 0; e < 8; ++e) { a[e] = bf2f((bf16)c0[e]); b[e] = bf2f((bf16)c1[e]); s0 += a[e] * a[e]; s1 += b[e] * b[e]; }
        const float sq = wave_sum(lane < 48 ? s0 : 0.f), skv = wave_sum((lane >= 48 ? s0 : 0.f) + (lane < 16 ? s1 : 0.f)), skr = wave_sum((lane >= 16 && lane < 24) ? s1 : 0.f);
        const float rq = 1.0f / sqrtf(sq * (1.f / 384.f) + EPS), rkv = 1.0f / sqrtf(skv * (1.f / 256.f) + EPS), rkr = 1.0f / sqrtf(skr * (1.f / 64.f) + EPS);
        const float r0 = lane < 48 ? rq : rkv, r1 = lane < 16 ? rkv : rkr;
        f32x4 x0, x1, y0, y1;
#pragma unroll
        for (int e = 0; e < 4; ++e) { x0[e] = a[e] * r0 * ga[0][e]; x1[e] = a[4 + e] * r0 * ga[1][e]; y0[e] = b[e] * r1 * gb[0][e]; y1[e] = b[4 + e] * r1 * gb[1][e]; }
        if (!dry) *(bf16x8*)(p + 8 * lane) = att::pack8(x0, x1);
        if (lane < 16 && !dry) *(bf16x8*)(p + 512 + 8 * lane) = att::pack8(y0, y1);
        const int ck = (lane - 16) & 7, pos = m % SEQ; const float* cp = rope + pos * 32 + 8 * (ck & 3); const float* sp = cp + SEQ * 32;
        const f32x4 cs0 = *(const f32x4*)cp, cs1 = *(const f32x4*)(cp + 4), sn0 = *(const f32x4*)sp, sn1 = *(const f32x4*)(sp + 4);
        f32x4 o0, o1;
#pragma unroll
        for (int e = 0; e < 4; ++e) { const float t0 = __shfl_xor(y0[e], 4), t1 = __shfl_xor(y1[e], 4);
            o0[e] = ck < 4 ? (y0[e] * cs0[e] - t0 * sn0[e]) : (t0 * sn0[e] + y0[e] * cs0[e]);
            o1[e] = ck < 4 ? (y1[e] * cs1[e] - t1 * sn1[e]) : (t1 * sn1[e] + y1[e] * cs1[e]); }
        if (lane >= 16 && lane < 24 && !dry) *(bf16x8*)(KR + (size_t)m * 64 + 8 * ck) = att::pack8(o0, o1);
    }
}
__device__ __forceinline__ void ph_mla_knorm(Frame& F, const float* gkn, const bool dry = false) {
    PH_IDS();
    const int gw = F.vcu * NWAVES + wave, NGW = F.G * NWAVES; bf16* KV = (bf16*)(F.ws + WS_KV);
    f32x4 g[4];
#pragma unroll
    for (int q = 0; q < 4; ++q) g[q] = *(const f32x4*)(gkn + (lane & 7) * 16 + 4 * q);
    for (int m = gw; m < M; m += NGW) {
        bf16* p = KV + (size_t)m * KVW + (lane >> 3) * 256 + (lane & 7) * 16;
        const bf16x8 c0 = *(const bf16x8*)p, c1 = *(const bf16x8*)(p + 8);
        float a[16]; float s = 0.f;
#pragma unroll
        for (int e = 0; e < 8; ++e) { a[e] = bf2f((bf16)c0[e]); a[8 + e] = bf2f((bf16)c1[e]); s += a[e] * a[e] + a[8 + e] * a[8 + e]; }
        s += __shfl_xor(s, 1); s += __shfl_xor(s, 2); s += __shfl_xor(s, 4);
        const float rstd = 1.0f / sqrtf(s * (1.f / 128.f) + EPS);
        f32x4 x[4];
#pragma unroll
        for (int q = 0; q < 4; ++q)
#pragma unroll
            for (int e = 0; e < 4; ++e) x[q][e] = a[4 * q + e] * rstd * g[q][e];
        if (!dry) { *(bf16x8*)p = att::pack8(x[0], x[1]); *(bf16x8*)(p + 8) = att::pack8(x[2], x[3]); }
    }
}
__device__ __forceinline__ float wave_absmax(const float* g, int n, int lane) {
    float m = fabsf(g[lane]); if (n > 64) m = fmaxf(m, fabsf(g[64 + lane]));
#pragma unroll
    for (int o = 1; o < 64; o <<= 1) m = fmaxf(m, __shfl_xor(m, o));
    return m;
}
__device__ __forceinline__ void ph_memattn(Frame& F, int layer, bool gla, const float* qgain, const float* kgain, const bool dry = false) {
    float bnd; { PH_IDS(); bnd = 0.08838834764831845f * 128.f * wave_absmax(qgain, 128, lane) * wave_absmax(kgain, 128, lane) * 1.03f; if (!(bnd < 40.f)) bnd = 0.f; }
    const bf16* memkv = (const bf16*)(F.ws + WS_MEMKV) + (size_t)layer * 1024 * 1024;
    const bf16* Qbase; bf16* Obase; int ldq, ldo;
    if (gla) { bf16* P = (bf16*)(F.ws + WS_PG); Qbase = P + PG_QM; Obase = P + PG_QM; ldq = PG; ldo = PG; }
    else { Qbase = (const bf16*)(F.ws + WS_PM) + PM_QM; Obase = F.OC + 1024; ldq = PM; ldo = OCW; }
    const int vcu = F.vcu, G = F.G, nblk = (512 - vcu + G - 1) / G;
    auto get = [=](int n, att::ABlk& d) { const int x = vcu + n * G, b = x >> 7, h = (x >> 5) & 3, qb = x & 31; const size_t row0 = (size_t)b * SEQ + 256 * qb;
        d.Q = Qbase + row0 * ldq + h * 128; d.O = Obase + row0 * ldo + h * 128; d.Kn = memkv + (size_t)b * NMEM * 1024 + h * 128; d.Kr = nullptr; d.V = d.Kn + 512; d.NT = 4; d.P0 = 0; };
    att::attn_blocks<0, false, 1>((LAS char*)F.lds, get, nblk, ldq, 1024, 1024, ldo, 0.08838834764831845f, bnd, qgain, nullptr, nullptr, dry);
}

__device__ __forceinline__ void ph_mla_attn(Frame& F, const float* gqn, const float* gqr, const float* gkn, const float* gkr, const bool dry = false) {
    float bnd; { PH_IDS(); bnd = 0.07216878364870322f * (128.f * wave_absmax(gqn, 128, lane) * wave_absmax(gkn, 128, lane) + 64.f * wave_absmax(gqr, 64, lane) * wave_absmax(gkr, 64, lane)) * 1.03f; if (!(bnd < 40.f)) bnd = 0.f; }
    const bf16* Qb = (const bf16*)(F.ws + WS_Q); const bf16* KVb = (const bf16*)(F.ws + WS_KV); const bf16* KRb = (const bf16*)(F.ws + WS_KR); bf16* OC = F.OC;
    const float* rope = (const float*)(F.ws + WS_ROPE);
    const int vcu = F.vcu, G = F.G, nblk = 2 * ((512 - vcu + G - 1) / G);
    auto get = [=](int n, att::ABlk& d) { const int x = vcu + (n >> 1) * G, pass = n & 1, bh = x >> 4, y = x & 15, b = bh >> 3, h = bh & 7, qb = pass ? y : 31 - y;
        const size_t row0 = (size_t)b * SEQ + 256 * qb;
        d.Q = Qb + row0 * QW + h * 192; d.Kn = KVb + (size_t)b * SEQ * KVW + h * 256; d.Kr = KRb + (size_t)b * SEQ * 64; d.V = d.Kn + 128; d.O = OC + row0 * OCW + h * 128; d.NT = 4 * (qb + 1); d.P0 = 256 * qb; };
    att::attn_blocks<4, true, 2>((LAS char*)F.lds, get, nblk, QW, KVW, KVW, OCW, 0.07216878364870322f, bnd, gqn, gqr, rope, dry);
}

constexpr int GCH = 128, GNU = 1024;
__device__ __forceinline__ void ph_gla_prep(Frame& F, const float* wa  , const float* ba  , const bool dry = false) {
    PH_IDS();
    const int u4 = wave >> 1, c = tid & 127;
    bf16* P = (bf16*)(F.ws + WS_PG); const float* ALOW = (const float*)(F.ws + WS_ALOW); float* GV = (float*)(F.ws + WS_GV);
    LAS float* EQ = (LAS float*)F.lds;
    LAS float* AL = (LAS float*)(F.lds + 131072);
    for (int ub = F.vcu * 4; ub < GNU; ub += F.G * 4) {
        const int unit = ub + u4, h = unit & 3; const size_t row0 = (size_t)(unit >> 2) * GCH;
        ((LAS f32x4*)AL)[tid] = ((const f32x4*)(ALOW + (size_t)(ub >> 2) * GCH * 16))[tid];
        float w[16];
#pragma unroll
        for (int k = 0; k < 16; ++k) w[k] = wa[k * 512 + h * 128 + c];
        const float bias = ba[h * 128 + c];
        float run = 0.f, bref = 0.f;
        __syncthreads();
#pragma unroll 1
        for (int hf = 0; hf < 2; ++hf) {
            float bc[64];
            const LAS float* al = AL + (64 * hf) * 16;
#pragma unroll
            for (int r = 0; r < 64; ++r) { float z = bias;
#pragma unroll
                for (int k = 0; k < 16; ++k) z += al[r * 16 + k] * w[k];
                const float ls = fminf(z, 0.f) - 0.6931471805599453f * __builtin_amdgcn_logf(1.0f + __builtin_amdgcn_exp2f(-1.4426950408889634f * fabsf(z)));
                run += ls * (1.f / 16.f); bc[r] = run; }
            if (hf == 0) bref = bc[63];
            LAS float* eqp = EQ + (size_t)(u4 * 64) * 128 + c;
#pragma unroll
            for (int r = 0; r < 64; ++r) eqp[r * 128] = __builtin_amdgcn_exp2f(1.4426950408889634f * (bc[r] - bref));
            __syncthreads();
            int tl = tid; asm volatile("" : "+v"(tl));
#pragma unroll
            for (int q8 = 0; q8 < 8; ++q8) { const int idx = tl + 512 * q8, us = idx >> 10, row = (idx >> 4) & 63, ch = idx & 15;
                const int un2 = ub + us, h2 = un2 & 3; const size_t rw = (size_t)(un2 >> 2) * GCH + 64 * hf + row;
                bf16* qp = P + rw * PG + PG_Q + h2 * 128 + ch * 8; bf16* kp = P + rw * PG + PG_K + h2 * 128 + ch * 8;
                const u32x4 qv = *(const u32x4*)qp, kv = *(const u32x4*)kp;
                const f32x4 e0 = *(const LAS f32x4*)(EQ + (size_t)(us * 64 + row) * 128 + ch * 8), e1 = *(const LAS f32x4*)(EQ + (size_t)(us * 64 + row) * 128 + ch * 8 + 4);
                u32x4 qo, ko;
#define GP2(xw, ea, eb, OUTQ) cvt_pk_bf16(__uint_as_float((xw) << 16) * (ea) * (OUTQ ? 0.08838834764831845f : 1.f), __uint_as_float((xw) & 0xffff0000u) * (eb) * (OUTQ ? 0.08838834764831845f : 1.f))
                qo.x = GP2(qv.x, e0[0], e0[1], true); qo.y = GP2(qv.y, e0[2], e0[3], true); qo.z = GP2(qv.z, e1[0], e1[1], true); qo.w = GP2(qv.w, e1[2], e1[3], true);
                const f32x4 i0 = {__builtin_amdgcn_rcpf(e0[0]), __builtin_amdgcn_rcpf(e0[1]), __builtin_amdgcn_rcpf(e0[2]), __builtin_amdgcn_rcpf(e0[3])}, i1 = {__builtin_amdgcn_rcpf(e1[0]), __builtin_amdgcn_rcpf(e1[1]), __builtin_amdgcn_rcpf(e1[2]), __builtin_amdgcn_rcpf(e1[3])};
                ko.x = GP2(kv.x, i0[0], i0[1], false); ko.y = GP2(kv.y, i0[2], i0[3], false); ko.z = GP2(kv.z, i1[0], i1[1], false); ko.w = GP2(kv.w, i1[2], i1[3], false);
#undef GP2
                if (!dry) { *(u32x4*)qp = qo; *(u32x4*)kp = ko; } }
            __syncthreads();
        }
        const float blast = run;
        float* gv = GV + (size_t)unit * 384 + c;
        if (!dry) { gv[0] = __builtin_amdgcn_exp2f(1.4426950408889634f * blast); gv[128] = __builtin_amdgcn_exp2f(1.4426950408889634f * (blast - bref)); gv[256] = __builtin_amdgcn_exp2f(1.4426950408889634f * bref); }
    }
}
#define GL_TRRD(dst, base, off) asm volatile("ds_read_b64_tr_b16 %0, %1 offset:%2" : "=&v"(dst) : "v"(base), "i"(off) : "memory")
#define GL_FRAG(out, base, d0, ks) do { att::s16x4 l_, h_; GL_TRRD(l_, base, (d0) * 512 + (ks) * 4096); GL_TRRD(h_, base, (d0) * 512 + (ks) * 4096 + 2048); \
        asm volatile("s_waitcnt lgkmcnt(0)" ::: "memory"); __builtin_amdgcn_sched_barrier(0); out = (bf16x8){l_[0], l_[1], l_[2], l_[3], h_[0], h_[1], h_[2], h_[3]}; } while (0)
#define GL_STAGE_V() do { const bf16* vp = P + (row0 + sr) * PG + PG_V + h * 256 + sc; \
        _Pragma("unroll") for (int q4 = 0; q4 < 4; ++q4) { const bf16x8 x0 = *(const bf16x8*)(vp + (size_t)(32 * q4) * PG), x1 = *(const bf16x8*)(vp + (size_t)(32 * q4) * PG + 128); \
            const int o_ = (q4 >> 1) * 32768 + ((q4 & 1) ? vst1 : vst0); *(LAS bf16x8*)(lds + o_) = x0; *(LAS bf16x8*)(lds + o_ + 16384) = x1; } } while (0)
__device__ __forceinline__ void ph_gla_u(Frame& F) {
    PH_IDS();
    const int r32 = lane & 31, hi = lane >> 5, sr = tid >> 4, sc = (tid & 15) * 8;
    const bf16* P = (const bf16*)(F.ws + WS_PG); bf16* US = (bf16*)(F.ws + WS_US); const float* GV = (const float*)(F.ws + WS_GV);
    LAS char* lds = (LAS char*)F.lds;
    const int vst0 = att::v_st(sr, sc), vst1 = att::v_st(32 + sr, sc);
    const int vbA = (int)(uintptr_t)lds + att::v_rd_base(lane) + (wave >> 2) * 16384 + (wave & 3) * 512, vbB = (int)(uintptr_t)lds + att::v_rd_base(lane) + 65536;
    for (int unit = F.vcu; unit < GNU; unit += F.G) {
        const int h = unit & 3; const size_t row0 = (size_t)(unit >> 2) * GCH;
        GL_STAGE_V();
        { const bf16* kp = P + (row0 + sr) * PG + PG_K + h * 128 + sc;
#pragma unroll
          for (int q4 = 0; q4 < 4; ++q4) { const bf16x8 x0 = *(const bf16x8*)(kp + (size_t)(32 * q4) * PG); *(LAS bf16x8*)(lds + 65536 + (q4 >> 1) * 16384 + ((q4 & 1) ? vst1 : vst0)) = x0; } }
        __syncthreads();
        att::f32x16 acc[4] = {};
#pragma unroll
        for (int jh = 0; jh < 2; ++jh)
#pragma unroll
            for (int ks = 0; ks < 4; ++ks) { bf16x8 a; GL_FRAG(a, vbA + jh * 32768, 0, ks);
#pragma unroll
                for (int nb = 0; nb < 4; ++nb) { bf16x8 b; GL_FRAG(b, vbB + jh * 16384, nb, ks); acc[nb] = __builtin_amdgcn_mfma_f32_32x32x16_bf16(a, b, acc[nb], 0, 0, 0); } }
        bf16* up = US + (size_t)unit * 32768 + (size_t)(wave * 32) * 128 + r32;
#pragma unroll
        for (int nb = 0; nb < 4; ++nb) { const float e2 = GV[(size_t)unit * 384 + 128 + nb * 32 + r32];
#pragma unroll
            for (int r = 0; r < 16; ++r) up[(size_t)att::crow(r, hi) * 128 + nb * 32] = f2bf(acc[nb][r] * e2); }
        __syncthreads();
    }
}
__device__ __forceinline__ void ph_gla_scan(Frame& F, const bool dry = false) {
    PH_IDS();
    bf16* US = (bf16*)(F.ws + WS_US); const float* GV = (const float*)(F.ws + WS_GV);
    for (int e = F.vcu * 512 + tid; e < 131072; e += F.G * 512) {
        const int dkq = e & 31, dv = (e >> 5) & 255, bh = e >> 13, b = bh >> 2, h = bh & 3;
        f32x4 S = (f32x4){0.f, 0.f, 0.f, 0.f};
        const size_t ustride = (size_t)4 * 32768;
        bf16* up = US + ((size_t)(b * 64) * 4 + h) * 32768 + (size_t)dv * 128 + dkq * 4;
        const float* gp = GV + ((size_t)(b * 64) * 4 + h) * 384 + dkq * 4;
        for (int n = 0; n < 64; n += 4) {
            u32x2 uu[4]; f32x4 dc[4], e1[4];
#pragma unroll
            for (int q = 0; q < 4; ++q) { uu[q] = *(const GAS u32x2*)(up + (size_t)(n + q) * ustride); dc[q] = *(const GAS f32x4*)(gp + (size_t)(n + q) * 4 * 384); e1[q] = *(const GAS f32x4*)(gp + (size_t)(n + q) * 4 * 384 + 256); }
#pragma unroll
            for (int q = 0; q < 4; ++q) {
                const f32x4 s1 = S * e1[q]; u32x2 w; w.x = cvt_pk_bf16(s1.x, s1.y); w.y = cvt_pk_bf16(s1.z, s1.w);
                if (!dry) *(GAS u32x2*)(up + (size_t)(n + q) * ustride) = w;
                f32x4 u; u.x = __uint_as_float(uu[q].x << 16); u.y = __uint_as_float(uu[q].x & 0xffff0000u); u.z = __uint_as_float(uu[q].y << 16); u.w = __uint_as_float(uu[q].y & 0xffff0000u);
                S = S * dc[q] + u; }
        }
    }
}
template <int B_> __device__ __forceinline__ bf16x8 gl_pk4(const att::f32x16& P) {
    const unsigned a0 = cvt_pk_bf16(P[B_ + 0], P[B_ + 1]), a1 = cvt_pk_bf16(P[B_ + 2], P[B_ + 3]), b0 = cvt_pk_bf16(P[B_ + 4], P[B_ + 5]), b1 = cvt_pk_bf16(P[B_ + 6], P[B_ + 7]);
    auto r0 = __builtin_amdgcn_permlane32_swap(a0, b0, false, false); auto r1 = __builtin_amdgcn_permlane32_swap(a1, b1, false, false);
    u32x4 w = {r0[0], r1[0], r0[1], r1[1]}; return __builtin_bit_cast(bf16x8, w);
}
__device__ __forceinline__ void ph_gla_out(Frame& F, const float* gout  , const bool dry = false) {
    PH_IDS();
    const int r32 = lane & 31, hi = lane >> 5, sr = tid >> 4, sc = (tid & 15) * 8, it = wave & 3, grp = wave >> 2;
    bf16* P = (bf16*)(F.ws + WS_PG); const bf16* US = (const bf16*)(F.ws + WS_US);
    constexpr int L_K = 65536, L_PART = 135168, L_RSTD = 136192, TP = 1040;
    LAS char* lds = (LAS char*)F.lds; LAS float* part = (LAS float*)(lds + L_PART); LAS float* rstd_l = (LAS float*)(lds + L_RSTD);
    const int vst0 = att::v_st(sr, sc), vst1 = att::v_st(32 + sr, sc);
    const int vb = (int)(uintptr_t)lds + att::v_rd_base(lane) + grp * 16384;
    int kbase[8];
#pragma unroll
    for (int d0 = 0; d0 < 8; ++d0) kbase[d0] = (int)(uintptr_t)lds + L_K + KSWZ(r32, 2 * d0 + hi);
    float g4[4];
#pragma unroll
    for (int blk = 0; blk < 4; ++blk) g4[blk] = gout[grp * 128 + blk * 32 + r32];
    for (int unit = F.vcu; unit < GNU; unit += F.G) {
        const int h = unit & 3; const size_t row0 = (size_t)(unit >> 2) * GCH;
        GL_STAGE_V();
        { const bf16* kp = P + (row0 + sr) * PG + PG_K + h * 128 + sc;
#pragma unroll
          for (int q4 = 0; q4 < 4; ++q4) { const bf16x8 x0 = *(const bf16x8*)(kp + (size_t)(32 * q4) * PG); const int row = sr + 32 * q4; *(LAS bf16x8*)(lds + L_K + KSWZ(row, tid & 15)) = x0; } }
        bf16x8 qr[8];
        { const bf16* qp = P + (row0 + 32 * it + r32) * PG + PG_Q + h * 128 + hi * 8;
#pragma unroll
          for (int d0 = 0; d0 < 8; ++d0) qr[d0] = *(const bf16x8*)(qp + d0 * 16); }
        const bf16* sp = US + (size_t)unit * 32768 + (size_t)(grp * 128 + r32) * 128 + hi * 8;
        bf16x8 ub[8];
#pragma unroll
        for (int ks = 0; ks < 2; ++ks)
#pragma unroll
            for (int blk = 0; blk < 4; ++blk) ub[ks * 4 + blk] = *(const bf16x8*)(sp + (size_t)(blk * 32) * 128 + ks * 16);
        __syncthreads();
        att::f32x16 o[4] = {};
#define GL_KRD(dst, addr, off) asm volatile("ds_read_b128 %0, %1 offset:%2" : "=&v"(dst) : "v"(addr), "i"(off) : "memory")
#define GL_JT(jt) do { att::f32x16 p = {}; bf16x8 kf[8]; \
            _Pragma("unroll") for (int d0 = 0; d0 < 8; ++d0) GL_KRD(kf[d0], kbase[d0], (jt) * 8192); \
            asm volatile("s_waitcnt lgkmcnt(0)" : "+v"(kf[0]), "+v"(kf[1]), "+v"(kf[2]), "+v"(kf[3]), "+v"(kf[4]), "+v"(kf[5]), "+v"(kf[6]), "+v"(kf[7]) :: "memory"); __builtin_amdgcn_sched_barrier(0); \
            _Pragma("unroll") for (int d0 = 0; d0 < 8; ++d0) p = __builtin_amdgcn_mfma_f32_32x32x16_bf16(kf[d0], qr[d0], p, 0, 0, 0); \
            __builtin_amdgcn_sched_barrier(0); \
            att::s16x4 vl[8], vh[8]; \
            _Pragma("unroll") for (int f = 0; f < 8; ++f) { GL_TRRD(vl[f], vb + ((jt) >> 1) * 32768, (f >> 1) * 512 + (2 * ((jt) & 1) + (f & 1)) * 4096); GL_TRRD(vh[f], vb + ((jt) >> 1) * 32768, (f >> 1) * 512 + (2 * ((jt) & 1) + (f & 1)) * 4096 + 2048); } \
            if ((jt) == it) { _Pragma("unroll") for (int r = 0; r < 16; ++r) if (att::crow(r, hi) > r32) p[r] = 0.f; } \
            const bf16x8 paA = gl_pk4<0>(p), paB = gl_pk4<8>(p); \
            asm volatile("s_waitcnt lgkmcnt(0)" : "+v"(vl[0]), "+v"(vh[0]), "+v"(vl[1]), "+v"(vh[1]), "+v"(vl[2]), "+v"(vh[2]), "+v"(vl[3]), "+v"(vh[3]), "+v"(vl[4]), "+v"(vh[4]), "+v"(vl[5]), "+v"(vh[5]), "+v"(vl[6]), "+v"(vh[6]), "+v"(vl[7]), "+v"(vh[7]) :: "memory"); __builtin_amdgcn_sched_barrier(0); \
            _Pragma("unroll") for (int blk = 0; blk < 4; ++blk) { \
                o[blk] = __builtin_amdgcn_mfma_f32_32x32x16_bf16(paA, (bf16x8){vl[2 * blk][0], vl[2 * blk][1], vl[2 * blk][2], vl[2 * blk][3], vh[2 * blk][0], vh[2 * blk][1], vh[2 * blk][2], vh[2 * blk][3]}, o[blk], 0, 0, 0); \
                o[blk] = __builtin_amdgcn_mfma_f32_32x32x16_bf16(paB, (bf16x8){vl[2 * blk + 1][0], vl[2 * blk + 1][1], vl[2 * blk + 1][2], vl[2 * blk + 1][3], vh[2 * blk + 1][0], vh[2 * blk + 1][1], vh[2 * blk + 1][2], vh[2 * blk + 1][3]}, o[blk], 0, 0, 0); } } while (0)
        GL_JT(0);
        if (it >= 1) GL_JT(1);
        if (it >= 2) GL_JT(2);
        if (it >= 3) GL_JT(3);
#undef GL_JT
#undef GL_KRD
#pragma unroll
        for (int kp = 0; kp < 4; ++kp) {
            bf16x8 un[8];
            if (kp < 3) {
#pragma unroll
                for (int ks = 0; ks < 2; ++ks)
#pragma unroll
                    for (int blk = 0; blk < 4; ++blk) un[ks * 4 + blk] = *(const bf16x8*)(sp + (size_t)(blk * 32) * 128 + (2 * kp + 2 + ks) * 16);
            }
#pragma unroll
            for (int ks = 0; ks < 2; ++ks)
#pragma unroll
                for (int blk = 0; blk < 4; ++blk) o[blk] = __builtin_amdgcn_mfma_f32_32x32x16_bf16(qr[2 * kp + ks], ub[ks * 4 + blk], o[blk], 0, 0, 0);
            if (kp < 3) {
#pragma unroll
                for (int e = 0; e < 8; ++e) ub[e] = un[e];
            }
        }
        int tl = tid; asm volatile("" : "+v"(tl));
        const int lnb = tl & 63, r32b = tl & 31, hib = (tl >> 5) & 1;
        u32x4 rg[8];
#pragma unroll
        for (int q8 = 0; q8 < 8; ++q8) { const int idx = tl + 512 * q8; rg[q8] = *(const u32x4*)(P + (row0 + (idx >> 5)) * PG + PG_R + h * 256 + (idx & 31) * 8); }
        float v16[16];
#pragma unroll
        for (int r = 0; r < 16; ++r) v16[r] = (o[0][r] * o[0][r] + o[1][r] * o[1][r]) + (o[2][r] * o[2][r] + o[3][r] * o[3][r]);
        float w8[8], w4[4], w2[2], w1;
        { const bool up = (lnb & 16) != 0;
#pragma unroll
          for (int q = 0; q < 8; ++q) { const float keep = up ? v16[8 + q] : v16[q], send = up ? v16[q] : v16[8 + q]; w8[q] = keep + __shfl_xor(send, 16); } }
        { const bool up = (lnb & 8) != 0;
#pragma unroll
          for (int q = 0; q < 4; ++q) { const float keep = up ? w8[4 + q] : w8[q], send = up ? w8[q] : w8[4 + q]; w4[q] = keep + __shfl_xor(send, 8); } }
        { const bool up = (lnb & 4) != 0;
#pragma unroll
          for (int q = 0; q < 2; ++q) { const float keep = up ? w4[2 + q] : w4[q], send = up ? w4[q] : w4[2 + q]; w2[q] = keep + __shfl_xor(send, 4); } }
        { const bool up = (lnb & 2) != 0; const float keep = up ? w2[1] : w2[0], send = up ? w2[0] : w2[1]; w1 = keep + __shfl_xor(send, 2); }
        w1 += __shfl_xor(w1, 1);
        if ((lnb & 1) == 0) part[(it * 32 + att::crow(r32b >> 1, hib)) * 2 + grp] = w1;
        __syncthreads();
        if (tl < 128) rstd_l[tl] = 1.0f / sqrtf((part[tl * 2] + part[tl * 2 + 1]) * (1.f / 256.f) + EPS);
        __syncthreads();
#pragma unroll
        for (int r = 0; r < 16; ++r) { const int i = 32 * it + att::crow(r, hib); const float rs = rstd_l[i];
            LAS float* tp = (LAS float*)(lds + i * TP) + grp * 128 + r32b;
#pragma unroll
            for (int blk = 0; blk < 4; ++blk) tp[blk * 32] = o[blk][r] * rs * g4[blk]; }
        __syncthreads();
#pragma unroll
        for (int q8 = 0; q8 < 8; ++q8) { const int idx = tl + 512 * q8, row = idx >> 5, ch = idx & 31;
            const f32x4 t0 = *(const LAS f32x4*)(lds + row * TP + ch * 32), t1 = *(const LAS f32x4*)(lds + row * TP + ch * 32 + 16); const u32x4 gv = rg[q8]; u32x4 w;
#define GL_O2(ta, tb, gw) cvt_pk_bf16((ta) * fast_silu(__uint_as_float((gw) << 16)), (tb) * fast_silu(__uint_as_float((gw) & 0xffff0000u)))
            w.x = GL_O2(t0[0], t0[1], gv.x); w.y = GL_O2(t0[2], t0[3], gv.y); w.z = GL_O2(t1[0], t1[1], gv.z); w.w = GL_O2(t1[2], t1[3], gv.w);
#undef GL_O2
            if (!dry) *(u32x4*)(P + (row0 + row) * PG + PG_V + h * 256 + ch * 8) = w; }
        __syncthreads();
    }
}
#undef GL_STAGE_V

constexpr int PID_END = 16 * 9;
#ifndef PROBE_PID
#define PROBE_PID (-1)
#endif
#ifndef PROBE_N
#define PROBE_N 1
#endif
#ifndef PROBE_PID2
#define PROBE_PID2 (-1)
#endif
#ifndef PROBE_PID3
#define PROBE_PID3 (-1)
#endif
#define NREP(k) ((((k) == PROBE_PID) || ((k) == PROBE_PID2) || ((k) == PROBE_PID3)) ? PROBE_N : 1)
#ifndef GU_ALIGN
#define GU_ALIGN true
#endif
#ifndef REV_GU
#define REV_GU 0
#endif
#ifndef REV_DOWN
#define REV_DOWN 1
#endif
#ifndef REV_OUT
#define REV_OUT 1
#endif
#ifndef REV_IN
#define REV_IN 0
#endif
#define REP(k) for (int rep_ = 0; rep_ < NREP(k); ++rep_)
#define DRY(k) (rep_ + 1 < NREP(k))
__global__ void __launch_bounds__(NWAVES * 64, 2) mk_fwd(MArgs args) {
    extern __shared__ __attribute__((aligned(16))) unsigned char lds_raw[];
    Frame F;
    F.lds = (LAS unsigned char*)lds_raw;
    F.G = gridDim.x; { const int bx = blockIdx.x; F.vcu = (F.G % 8 == 0) ? (bx % 8) * (F.G / 8) + bx / 8 : bx; }
    F.X = args.out; F.ws = args.ws; F.OC = (bf16*)args.out;
    volatile LAS unsigned* MISC = (volatile LAS unsigned*)(F.lds + MISC_OFF);
    for (int u = threadIdx.x; u < 128; u += NWAVES * 64) MISC[u] = 0u;
    __syncthreads();
    XcdBarrier bar = xcd_barrier_post((unsigned*)(F.ws + WS_CTL) + CW_BAR + args.region * XCD_BAR_WORDS, MISC + 8);
    const int lo = args.lo, hi = args.hi;
#define IN(k) (lo <= (k) && (k) < hi)
#ifdef TGRP
    unsigned long long tph_prev = __builtin_amdgcn_s_memrealtime(), tph_acc = 0; int tph_gla = 0;
#define TSLOT(k) ((k) < 16 ? 16 + (k) : ((k) & 15))
#define TSEL(k) (TGRP == 1 ? (tph_gla && TSLOT(k) >= 2 && TSLOT(k) <= 5) : TGRP == 2 ? (!tph_gla && (TSLOT(k) == 2 || TSLOT(k) == 4)) : TGRP == 3 ? (TSLOT(k) >= 16 || TSLOT(k) == 7) : TGRP == 4 ? (!tph_gla && TSLOT(k) == 5) : \
                 TGRP == 5 ? (TSLOT(k) == 1 || TSLOT(k) == 6 || (!tph_gla && TSLOT(k) == 3)) : TGRP == 6 ? (TSLOT(k) == 9 || TSLOT(k) == 10) : TGRP >= 32 ? (TSLOT(k) == TGRP - 32 && (TGLA < 0 || tph_gla == TGLA)) : false)
#ifndef TGLA
#define TGLA (-1)
#endif
#define SEAM(k) do { if ((k) + 1 < hi) xcd_barrier(bar); { const unsigned long long tn_ = __builtin_amdgcn_s_memrealtime(); if (TSEL(k)) tph_acc += tn_ - tph_prev; tph_prev = tn_; } } while (0)
#else
#define SEAM(k) do { if ((k) + 1 < hi) xcd_barrier(bar); } while (0)
#endif
    unsigned char* ws = F.ws; unsigned char* wb = ws + WS_WB;

    LAS unsigned char* rstab = F.lds + XTRA_OFF;
    float* RS = (float*)(ws + WS_RS); LAS float* rspart = (LAS float*)(F.lds + XTRA_OFF + 8192);
#define OPQ(k) ({ const float* p_ = args.in[k]; asm volatile("" : "+s"(p_)); p_; })
#define CONV(layer) do { const ConvPtrs cp{OPQ(3), OPQ(4), OPQ(5), OPQ(7), OPQ(8), OPQ(9), OPQ(11), OPQ(16), OPQ(20), OPQ(23), OPQ(24), OPQ(2), OPQ(6), OPQ(10)}; conv_layer(F, (layer), cp); } while (0)

    if (IN(0)) { REP(0) { ph_prologue(F, args.in[0], args.in[1], args.in[12], args.in[13]); CONV(0); } SEAM(0); }
    if (IN(1)) {
        pg8::Gemm g{(const bf16*)(ws + WS_MEMH), (const bf16*)(ws + WS_MEMW), 4096, 4096, DM, DM, DM}; pg8::DiagOrder S{F.G, (int)blockIdx.x, 4};
        pg8::EpiBf16<false> E{(bf16*)(ws + WS_MEMKV), 1024, 3};
        pg8::gemm_phase<pg8::EpiBf16<false>, pg8::DiagOrder, PG8_ALIGN, PG8_SP2>(F.lds + RING_OFF, g, S, E);
        SEAM(1);
    }
    if (IN(2)) { ph_memknorm(F, args.in[15]); SEAM(2); }

    for (int it = 0; it < 8; ++it) {
        const int pb = 16 * (it + 1), i = it >> 1, half = it & 1, j = i >> 1;
        if (pb + 16 <= lo || pb >= hi) continue;
        if (half) {
            const bool gla = !(i & 1);
#ifdef TGRP
            tph_gla = gla ? 1 : 0;
#endif
            if (IN(pb + 1)) REP(pb + 1) {
                if (gla) {
                    pg8::Gemm g{(const bf16*)(ws + WS_XN), (const bf16*)(wb + WB_IN), M, 3840, DM, DM, DM}; pg8::StaticOrder S; S.init(M, 3840, F.G, (int)blockIdx.x, REV_IN);
                    pg8::EpiGlaIn E{(bf16*)(ws + WS_PG), (float*)(ws + WS_ALOW)};
                    pg8::gemm_phase<pg8::EpiGlaIn, pg8::StaticOrder, PG8_ALIGN, PG8_SP2>(F.lds + RING_OFF, g, S, E, RS + (size_t)(3 * i + 1) * 4 * M, rstab);
                } else {
                    pg8::Gemm g{(const bf16*)(ws + WS_XN), (const bf16*)(wb + WB_IN), M, PM, DM, DM, DM}; pg8::StaticOrder S; S.init(M, PM, F.G, (int)blockIdx.x, REV_IN);
                    pg8::EpiBf16<true> E{(bf16*)(ws + WS_PM), PM, 0x7fffffff};
                    pg8::gemm_phase<pg8::EpiBf16<true>, pg8::StaticOrder, PG8_ALIGN, PG8_SP2>(F.lds + RING_OFF, g, S, E, RS + (size_t)(3 * i + 1) * 4 * M, rstab);
                }
                if (rep_ + 1 == NREP(pb + 1)) SEAM(pb + 1);
            }
            if (gla) {
                if (IN(pb + 2)) { REP(pb + 2) { ph_gla_prep(F, args.in[17] + (size_t)j * 16 * 512, args.in[18] + j * 512, DRY(pb + 2)); ph_memattn(F, i, true, args.in[14] + i * 128, args.in[15] + i * 128, DRY(pb + 2)); } SEAM(pb + 2); }
                if (IN(pb + 3)) { REP(pb + 3) ph_gla_u(F); SEAM(pb + 3); }
                if (IN(pb + 4)) { REP(pb + 4) ph_gla_scan(F, DRY(pb + 4)); SEAM(pb + 4); }
                if (IN(pb + 5)) { REP(pb + 5) ph_gla_out(F, args.in[19] + j * 256, DRY(pb + 5)); SEAM(pb + 5); }
            }
            if (IN(pb + 2) && !gla) { REP(pb + 2) { ph_mla_rowprep(F, args.in[21] + j * 384, args.in[22] + j * 256, args.in[28] + j * 64, DRY(pb + 2)); ph_memattn(F, i, false, args.in[14] + i * 128, args.in[15] + i * 128, DRY(pb + 2)); } SEAM(pb + 2); }
            if (IN(pb + 3) && !gla) REP(pb + 3) {
                int kq_ = 384, kkv_ = 256; asm volatile("" : "+s"(kq_), "+s"(kkv_));
                { pg8::Gemm g{(const bf16*)(ws + WS_PM) + PM_CQ, (const bf16*)(wb + WB_UQ), M, QW, kq_, PM, 384}; pg8::StaticOrder S; S.init(M, QW, F.G, (int)blockIdx.x);
                  pg8::EpiBf16<false> E{(bf16*)(ws + WS_Q), QW, 0x7fffffff};
                  pg8::gemm_phase<pg8::EpiBf16<false>, pg8::StaticOrder, PG8_ALIGN, PG8_SP2>(F.lds + RING_OFF, g, S, E); }
                { pg8::Gemm g{(const bf16*)(ws + WS_PM) + PM_CKV, (const bf16*)(wb + WB_UKV), M, KVW, kkv_, PM, 256}; pg8::StaticOrder S; S.init(M, KVW, F.G, (int)blockIdx.x);
#ifdef KV_FUSED
                  pg8::EpiKV E{(bf16*)(ws + WS_KV), KVW, args.in[27] + j * 128, rspart};
                  pg8::gemm_phase<pg8::EpiKV, pg8::StaticOrder, true, PG8_SP2>(F.lds + RING_OFF, g, S, E); }
#else
                  pg8::EpiBf16<false> E{(bf16*)(ws + WS_KV), KVW, 0x7fffffff};
                  pg8::gemm_phase<pg8::EpiBf16<false>, pg8::StaticOrder, PG8_ALIGN, PG8_SP2>(F.lds + RING_OFF, g, S, E); }
#endif
                if (rep_ + 1 == NREP(pb + 3)) SEAM(pb + 3);
            }
#ifndef KV_FUSED
            if (IN(pb + 4) && !gla) { REP(pb + 4) ph_mla_knorm(F, args.in[27] + j * 128, DRY(pb + 4)); SEAM(pb + 4); }
#endif
            if (IN(pb + 5) && !gla) { REP(pb + 5) ph_mla_attn(F, args.in[25] + j * 128, args.in[26] + j * 64, args.in[27] + j * 128, args.in[28] + j * 64, DRY(pb + 5)); SEAM(pb + 5); }
            if (IN(pb + 6)) {
                pg8::Gemm g{gla ? (const bf16*)(ws + WS_PG) + PG_V : (const bf16*)F.OC, (const bf16*)(wb + WB_WO), M, DM, 1536, gla ? PG : OCW, 1536};
                pg8::StaticOrder S; S.init(M, DM, F.G, (int)blockIdx.x, REV_OUT);
                REP(pb + 6) { pg8::EpiResid E{(bf16*)(ws + WS_XN), nullptr, RS + (size_t)(3 * i + 2) * 4 * M, rspart, DM, rep_ ? 0.0f : 1.0f};
                pg8::gemm_phase<pg8::EpiResid, pg8::StaticOrder, PG8_ALIGN, PG8_SP2>(F.lds + RING_OFF, g, S, E); }
                SEAM(pb + 6);
            }
        }
        if (IN(pb + 7) && !half && it > 0) { REP(pb + 7) CONV(i); SEAM(pb + 7); }
        if (IN(pb + 9)) {
            pg8::Gemm g{(const bf16*)(ws + WS_XN), (const bf16*)(wb + (half ? WB_GU1 : WB_GU0)), M, 2 * FF, DM, DM, DM}; pg8::StaticOrder S; S.init(M, 2 * FF, F.G, (int)blockIdx.x, REV_GU);
            pg8::EpiSwiGLU E{(bf16*)(ws + WS_H), FF};
#ifndef DN_SKIP
#define DN_SKIP 0
#endif
#ifdef GU_PK
#ifndef GU_SKIP
#define GU_SKIP 0
#endif
            REP(pb + 9) { pg8::Gemm g2 = g; if (DRY(pb + 9)) g2.K = GU_PK; pg8::gemm_phase<pg8::EpiSwiGLU, pg8::StaticOrder, GU_ALIGN, PG8_SP2>(F.lds + RING_OFF, g2, S, E, RS + (size_t)(3 * i + (half ? 2 : 0)) * 4 * M, rstab, GU_SKIP && DRY(pb + 9)); }
#else
            REP(pb + 9) pg8::gemm_phase<pg8::EpiSwiGLU, pg8::StaticOrder, GU_ALIGN, PG8_SP2>(F.lds + RING_OFF, g, S, E, RS + (size_t)(3 * i + (half ? 2 : 0)) * 4 * M, rstab);
#endif
            SEAM(pb + 9);
        }
        if (IN(pb + 10)) {
            pg8::Gemm g{(const bf16*)(ws + WS_H), (const bf16*)(wb + (half ? WB_D1 : WB_D0)), M, DM, FF, FF, FF}; pg8::StaticOrder S; S.init(M, DM, F.G, (int)blockIdx.x, REV_DOWN);
            const bool lastp = (it == 7);
            REP(pb + 10) { pg8::EpiResid E{(bf16*)(ws + WS_XN), lastp ? F.X : nullptr, RS + (size_t)(half ? 3 * (i + 1) : 3 * i + 1) * 4 * M, rspart, DM, rep_ ? 0.0f : 0.5f};
            pg8::gemm_phase<pg8::EpiResid, pg8::StaticOrder, PG8_ALIGN, PG8_SP2>(F.lds + RING_OFF, g, S, E, nullptr, nullptr, DN_SKIP && rep_ > 0); }
            SEAM(pb + 10);
        }
    }
#ifdef TGRP
    if (blockIdx.x == 0 && threadIdx.x == 0) { const unsigned long long s0 = __builtin_amdgcn_s_memrealtime(); while (__builtin_amdgcn_s_memrealtime() - s0 < 4ull * tph_acc) __builtin_amdgcn_s_sleep(8); }
#endif
#undef OPQ
#undef CONV
#undef IN
#undef SEAM
}
#ifndef FAST_GLA
#define FAST_GLA 0
#endif
#ifndef FAST_MLA_PREP
#define FAST_MLA_PREP 0
#endif
#ifndef FAST_MLA_ATT
#define FAST_MLA_ATT 0
#endif
extern "C" void kernel_launch(void* const* d_in, const int* in_sizes, int n_in, void* d_out, int out_size, void* d_ws, size_t ws_size, hipStream_t stream) {
    static int grid = 0;
    if (grid == 0) {
        if (n_in != 29 || out_size != M * DM || ws_size < WS_END) { fprintf(stderr, "kernel_launch: unexpected shapes (n_in %d out %d ws %zu)\n", n_in, out_size, ws_size); grid = -1; return; }
        int dev = 0, cus = 0, per_cu = 0;
        if (hipGetDevice(&dev) != hipSuccess || hipDeviceGetAttribute(&cus, hipDeviceAttributeMultiprocessorCount, dev) != hipSuccess) { grid = -1; return; }
        if (hipFuncSetAttribute((const void*)mk_fwd, hipFuncAttributeMaxDynamicSharedMemorySize, LDS_BYTES) != hipSuccess) { fprintf(stderr, "kernel_launch: hipFuncSetAttribute failed\n"); grid = -1; return; }
        if (hipOccupancyMaxActiveBlocksPerMultiprocessor(&per_cu, (const void*)mk_fwd, NWAVES * 64, LDS_BYTES) != hipSuccess || per_cu < 1)
            fprintf(stderr, "kernel_launch: note: occupancy query reports %d workgroups per CU\n", per_cu);
        (void)hipGetLastError();
        grid = cus;
    }
    if (grid < 0) return;
    const float* mem = (const float*)d_in[1]; (void)mem;
    const float* memq_norm = (const float*)d_in[14];
    const float* gla_w_alpha = (const float*)d_in[17]; const float* gla_b_alpha = (const float*)d_in[18]; const float* gla_out_norm = (const float*)d_in[19];
    const float* mla_q_norm = (const float*)d_in[21]; const float* mla_kv_norm = (const float*)d_in[22];
    const float* mla_qn = (const float*)d_in[25]; const float* mla_qr = (const float*)d_in[26]; const float* mla_kn = (const float*)d_in[27]; const float* mla_kr = (const float*)d_in[28];
    unsigned char* ws = (unsigned char*)d_ws;
    float* ROPE = (float*)(ws + WS_ROPE); bf16* MEMKV = (bf16*)(ws + WS_MEMKV); float* ALOW = (float*)(ws + WS_ALOW);
    bf16* KR = (bf16*)(ws + WS_KR); bf16* PGb = (bf16*)(ws + WS_PG); float* ALPHA = (float*)(ws + WS_US);
    bf16* OC = (bf16*)d_out; bf16* PMb = (bf16*)(ws + WS_PM); bf16* Qb = (bf16*)(ws + WS_Q); bf16* KVb = (bf16*)(ws + WS_KV);

    (void)hipMemsetAsync(ws + WS_CTL, 0, CTL_ZERO_BYTES, stream);
    MArgs a{};
    for (int k = 0; k < 29; ++k) a.in[k] = (const float*)d_in[k];
    a.out = (float*)d_out; a.ws = ws;
    int region = 0;
    auto mk = [&](int lo, int hi) { if (lo >= hi) return; a.lo = lo; a.hi = hi; a.region = region++; a.pad = 0; hipLaunchKernelGGL(mk_fwd, dim3(grid), dim3(NWAVES * 64), LDS_BYTES, stream, a); };
    int cur_lo = 0;
    for (int it = 1; it < 8; it += 2) {
        const int pb = 16 * (it + 1), i = it >> 1, j = i >> 1; const bool gla = !(i & 1);
        const bf16* memkv = MEMKV + (size_t)i * 1024 * 1024;
        if (gla) {
            if (!FAST_GLA) {
                mk(cur_lo, pb + 2);
                nv_gla_alpha<<<M * 512 / 256, 256, 0, stream>>>(ALOW, gla_w_alpha + (size_t)j * 16 * 512, gla_b_alpha + j * 512, ALPHA);
                nv_attn<128, false><<<dim3(SEQ / 64, 4, BATCH), 64, 0, stream>>>(PGb + PG_QM, PG, 128, memkv, 1024, 128, nullptr, 0, memkv + 512, 1024, 128, PGb + PG_QM, PG, 128, 4, SEQ, NMEM, 0.08838834764831845f, memq_norm + i * 128);
                nv_gla_rec<<<16, 256, 0, stream>>>(PGb, ALPHA, gla_out_norm + j * 256);
                cur_lo = pb + 6;
            }
        } else {
            if (!FAST_MLA_PREP) {
                mk(cur_lo, pb + 2);
                nv_attn<128, false><<<dim3(SEQ / 64, 4, BATCH), 64, 0, stream>>>(PMb + PM_QM, PM, 128, memkv, 1024, 128, nullptr, 0, memkv + 512, 1024, 128, OC + 1024, OCW, 128, 4, SEQ, NMEM, 0.08838834764831845f, memq_norm + i * 128);
                nv_mla_rowprep<<<M / 4, 256, 0, stream>>>(PMb, mla_q_norm + j * 384, mla_kv_norm + j * 256, mla_kr + j * 64, ROPE, KR);
                cur_lo = pb + 3;
            }
            if (!FAST_MLA_ATT) {
                mk(cur_lo, pb + 4);
                nv_mla_headprep<<<M * 8 / 4, 256, 0, stream>>>(Qb, KVb, mla_qn + j * 128, mla_qr + j * 64, mla_kn + j * 128, ROPE);
                nv_attn<192, true><<<dim3(SEQ / 64, 8, BATCH), 64, 0, stream>>>(Qb, QW, 192, KVb, KVW, 256, KR, 64, KVb + 128, KVW, 256, OC, OCW, 128, 8, SEQ, SEQ, 0.07216878364870322f, nullptr);
                cur_lo = pb + 6;
            }
        }
    }
    mk(cur_lo, PID_END);
}
```
